# Optimizing an MI355X kernel written in HIP

```python
import math
import jax, jax.numpy as jnp
from jax import lax
import numpy as np

D_MODEL = 1024
BATCH = 4
SEQ = 4096
DEPTH = 2

D_MIX = 2 * D_MODEL
EPS = 1e-6

A_WIDTH = D_MIX // 2
A_HEAD_DIM = 64
A_Q_HEADS = A_WIDTH // A_HEAD_DIM
A_KV_HEADS = 4
A_GROUP = A_Q_HEADS // A_KV_HEADS
A_KV_WIDTH = A_KV_HEADS * A_HEAD_DIM
WINDOW = 128
A_BLOCK = 128

B_WIDTH = D_MIX // 4
B_HEADS = 4
B_DK = B_WIDTH // (2 * B_HEADS)
B_DV = B_WIDTH // B_HEADS
B_QK_WIDTH = B_HEADS * B_DK
B_GATE_RANK = 16
B_GATE_TAU = 16.0
B_CHUNK = 16

C_WIDTH = D_MIX // 4
C_GROUP_CH = 16
C_GROUPS = C_WIDTH // C_GROUP_CH
C_STATE = 64

PROJ_SIZES = (A_WIDTH, A_KV_WIDTH, A_KV_WIDTH, A_WIDTH,
              B_QK_WIDTH, B_QK_WIDTH, B_WIDTH, B_GATE_RANK, B_WIDTH,
              C_WIDTH, C_WIDTH)
PROJ_COLS = sum(PROJ_SIZES)

kernel_name = "hybrid_swa_gla_s5_parallel_heads"


def rmsnorm(x, g):
    xf = x.astype(jnp.float32)
    y = xf * lax.rsqrt(jnp.mean(xf * xf, axis=-1, keepdims=True) + EPS)
    return (y * g.astype(jnp.float32)).astype(x.dtype)


def alibi_slopes(n):
    return jnp.exp2(-8.0 * jnp.arange(1, n + 1, dtype=jnp.float32) / n)


def sliding_window_attention(q, k, v, sinks):
    bsz, s_len = q.shape[:2]
    nb = s_len // A_BLOCK
    q = q.reshape(bsz, nb, A_BLOCK, A_KV_HEADS, A_GROUP, A_HEAD_DIM)
    k = k.reshape(bsz, s_len, A_KV_HEADS, A_HEAD_DIM)
    v = v.reshape(bsz, s_len, A_KV_HEADS, A_HEAD_DIM)
    pad = ((0, 0), (A_BLOCK, 0), (0, 0), (0, 0))
    blk_shape = (bsz, nb, A_BLOCK, A_KV_HEADS, A_HEAD_DIM)
    kk = jnp.concatenate([jnp.pad(k, pad)[:, :s_len].reshape(blk_shape), k.reshape(blk_shape)], axis=2)
    vv = jnp.concatenate([jnp.pad(v, pad)[:, :s_len].reshape(blk_shape), v.reshape(blk_shape)], axis=2)
    s = jnp.einsum('bnqkgd,bnskd->bnkgqs', q, kk).astype(jnp.float32) * (A_HEAD_DIM ** -0.5)
    i = jnp.arange(A_BLOCK)[:, None]
    j = jnp.arange(2 * A_BLOCK)[None, :]
    dist = i + A_BLOCK - j
    key_pos = jnp.arange(nb)[:, None, None] * A_BLOCK - A_BLOCK + j[None]
    valid = (dist >= 0)[None] & (dist < WINDOW)[None] & (key_pos >= 0)
    slopes = alibi_slopes(A_Q_HEADS).reshape(A_KV_HEADS, A_GROUP)
    s = s - slopes[:, :, None, None] * dist.astype(jnp.float32)
    s = jnp.where(valid[None, :, None, None], s, -jnp.inf)
    sink = sinks.astype(jnp.float32).reshape(A_KV_HEADS, A_GROUP)[:, :, None, None]
    m = jnp.maximum(jnp.max(s, axis=-1, keepdims=True), sink)
    p = jnp.exp(s - m)
    probs = (p / (jnp.sum(p, axis=-1, keepdims=True) + jnp.exp(sink - m))).astype(vv.dtype)
    o = jnp.einsum('bnkgqs,bnskd->bnqkgd', probs, vv)
    return o.reshape(bsz, s_len, A_WIDTH)


def gated_linear_attention(q, k, v, log_a):
    bsz, s_len = q.shape[:2]
    nc = s_len // B_CHUNK
    cshape = (bsz, nc, B_CHUNK, B_HEADS)
    q = (q.astype(jnp.float32) * (B_DK ** -0.5)).reshape(cshape + (B_DK,))
    k = k.astype(jnp.float32).reshape(cshape + (B_DK,))
    v = v.astype(jnp.float32).reshape(cshape + (B_DV,))
    b = jnp.cumsum(log_a.astype(jnp.float32).reshape(cshape + (B_DK,)), axis=2)
    causal = jnp.tril(jnp.ones((B_CHUNK, B_CHUNK), dtype=bool))[None, None, :, :, None, None]
    decay = jnp.exp(jnp.where(causal, b[:, :, :, None] - b[:, :, None, :], -jnp.inf))
    attn = jnp.einsum('bnihd,bnjhd,bnijhd->bnhij', q, k, decay)
    o_intra = jnp.einsum('bnhij,bnjhv->bnihv', attn, v)
    b_last = b[:, :, -1]
    u = jnp.einsum('bnjhd,bnjhv->bnhdv', k * jnp.exp(b_last[:, :, None] - b), v)
    chunk_decay = jnp.exp(b_last)

    def step(state, inp):
        dec, uu = inp
        return dec[..., None] * state + uu, state

    init = jnp.zeros((bsz, B_HEADS, B_DK, B_DV), jnp.float32)
    _, s_prev = lax.scan(step, init, (jnp.moveaxis(chunk_decay, 1, 0), jnp.moveaxis(u, 1, 0)))
    s_prev = jnp.moveaxis(s_prev, 0, 1)
    o_inter = jnp.einsum('bnihd,bnhdv->bnihv', q * jnp.exp(b), s_prev)
    return (o_intra + o_inter).reshape(bsz, s_len, B_HEADS, B_DV)


def _complex_affine_combine(e1, e2):
    a1r, a1i, b1r, b1i = e1
    a2r, a2i, b2r, b2i = e2
    return (a2r * a1r - a2i * a1i,
            a2r * a1i + a2i * a1r,
            a2r * b1r - a2i * b1i + b2r,
            a2r * b1i + a2i * b1r + b2i)


def s5_ssm(u, a_re, a_im, log_dt, b_re, b_im, c_re, c_im, d):
    bsz, s_len = u.shape[:2]
    uf = u.astype(jnp.float32).reshape(bsz, s_len, C_GROUPS, C_GROUP_CH)
    ar = a_re.astype(jnp.float32)
    ai = a_im.astype(jnp.float32)
    dt = jnp.exp(log_dt.astype(jnp.float32))[:, None]
    mag = jnp.exp(ar * dt)
    abar_re = mag * jnp.cos(ai * dt)
    abar_im = mag * jnp.sin(ai * dt)
    den = ar * ar + ai * ai
    num_re = abar_re - 1.0
    f_re = (num_re * ar + abar_im * ai) / den
    f_im = (abar_im * ar - num_re * ai) / den
    bu_re = jnp.einsum('blgh,gph->blgp', uf, b_re.astype(jnp.float32))
    bu_im = jnp.einsum('blgh,gph->blgp', uf, b_im.astype(jnp.float32))
    in_re = f_re * bu_re - f_im * bu_im
    in_im = f_re * bu_im + f_im * bu_re
    _, _, h_re, h_im = lax.associative_scan(
        _complex_affine_combine,
        (jnp.broadcast_to(abar_re, in_re.shape), jnp.broadcast_to(abar_im, in_re.shape), in_re, in_im),
        axis=1)
    y = (jnp.einsum('blgp,ghp->blgh', h_re, c_re.astype(jnp.float32))
         - jnp.einsum('blgp,ghp->blgh', h_im, c_im.astype(jnp.float32)))
    return y.reshape(bsz, s_len, C_WIDTH) + d.astype(jnp.float32) * uf.reshape(bsz, s_len, C_WIDTH)


def hybrid_layer(x, c, w_mod, b_mod, g_pre, g_post, w_in, sinks, w_alpha, b_alpha, g_gla,
                 a_re, a_im, log_dt, b_re, b_im, c_re, c_im, d, w_glu, b_glu, w_out):
    bsz, s_len = x.shape[:2]
    mod = jax.nn.silu(c) @ w_mod + b_mod
    shift, scale, gate = jnp.split(mod, 3, axis=-1)
    h = rmsnorm(x, g_pre) * (1.0 + scale[:, None]) + shift[:, None]
    proj = h @ w_in
    pieces = []
    off = 0
    for size in PROJ_SIZES:
        pieces.append(proj[..., off:off + size])
        off += size
    a_q, a_k, a_v, a_g, b_q, b_k, b_v, b_lr, b_g, c_u, c_g = pieces

    o_a = sliding_window_attention(a_q, a_k, a_v, sinks) * jax.nn.silu(a_g)

    gate_logits = (b_lr @ w_alpha + b_alpha).astype(jnp.float32)
    log_a = (jax.nn.log_sigmoid(gate_logits) / B_GATE_TAU).reshape(bsz, s_len, B_HEADS, B_DK)
    o_b = gated_linear_attention(b_q.reshape(bsz, s_len, B_HEADS, B_DK),
                                 b_k.reshape(bsz, s_len, B_HEADS, B_DK),
                                 b_v.reshape(bsz, s_len, B_HEADS, B_DV), log_a)
    o_b = rmsnorm(o_b, g_gla.reshape(B_HEADS, B_DV)).reshape(bsz, s_len, B_WIDTH)
    o_b = o_b.astype(x.dtype) * jax.nn.silu(b_g)

    y = jax.nn.gelu(s5_ssm(c_u, a_re, a_im, log_dt, b_re, b_im, c_re, c_im, d)).astype(x.dtype)
    y = y * jax.nn.sigmoid(y @ w_glu + b_glu)
    o_c = y * jax.nn.silu(c_g)

    mix = jnp.concatenate([o_a, o_b, o_c], axis=-1)
    out = rmsnorm(mix @ w_out, g_post)
    return x + gate[:, None] * out


def setup_inputs(seed: int = 0) -> dict:
    key = jax.random.key(seed)
    ks = jax.random.split(key, 24)
    L, D = DEPTH, D_MODEL
    nrm = lambda k, shape, s: jax.random.normal(k, shape, jnp.float32) * s
    n_idx = jnp.arange(C_STATE, dtype=jnp.float32)
    return {
        "x": nrm(ks[0], (BATCH, SEQ, D), 1.0),
        "c": nrm(ks[1], (BATCH, D), 1.0),
        "w_mod": nrm(ks[2], (L, D, 3 * D), D ** -0.5),
        "b_mod": nrm(ks[3], (L, 3 * D), 0.02),
        "g_pre": 1.0 + nrm(ks[4], (L, D), 0.02),
        "g_post": 1.0 + nrm(ks[5], (L, D), 0.02),
        "w_in": nrm(ks[6], (L, D, PROJ_COLS), D ** -0.5),
        "attn_sinks": nrm(ks[7], (L, A_Q_HEADS), 0.5),
        "gla_w_alpha": nrm(ks[8], (L, B_GATE_RANK, B_QK_WIDTH), B_GATE_RANK ** -0.5),
        "gla_b_alpha": nrm(ks[9], (L, B_QK_WIDTH), 0.1),
        "gla_norm_g": 1.0 + nrm(ks[10], (L, B_WIDTH), 0.02),
        "s5_a_re": -0.5 + nrm(ks[11], (L, C_GROUPS, C_STATE), 0.01),
        "s5_a_im": math.pi * n_idx + nrm(ks[12], (L, C_GROUPS, C_STATE), 0.01),
        "s5_log_dt": jax.random.uniform(ks[13], (L, C_GROUPS), jnp.float32, math.log(1e-3), math.log(1e-1)),
        "s5_b_re": nrm(ks[14], (L, C_GROUPS, C_STATE, C_GROUP_CH), (2 * C_GROUP_CH) ** -0.5),
        "s5_b_im": nrm(ks[15], (L, C_GROUPS, C_STATE, C_GROUP_CH), (2 * C_GROUP_CH) ** -0.5),
        "s5_c_re": nrm(ks[16], (L, C_GROUPS, C_GROUP_CH, C_STATE), (2 * C_STATE) ** -0.5),
        "s5_c_im": nrm(ks[17], (L, C_GROUPS, C_GROUP_CH, C_STATE), (2 * C_STATE) ** -0.5),
        "s5_d": nrm(ks[18], (L, C_WIDTH), 1.0),
        "s5_w_glu": nrm(ks[19], (L, C_WIDTH, C_WIDTH), C_WIDTH ** -0.5),
        "s5_b_glu": nrm(ks[20], (L, C_WIDTH), 0.02),
        "w_out": nrm(ks[21], (L, D_MIX, D), D_MIX ** -0.5),
    }


def reference(x, c, w_mod, b_mod, g_pre, g_post, w_in, attn_sinks, gla_w_alpha, gla_b_alpha,
              gla_norm_g, s5_a_re, s5_a_im, s5_log_dt, s5_b_re, s5_b_im, s5_c_re, s5_c_im,
              s5_d, s5_w_glu, s5_b_glu, w_out):
    for l in range(DEPTH):
        x = hybrid_layer(x, c, w_mod[l], b_mod[l], g_pre[l], g_post[l], w_in[l], attn_sinks[l],
                         gla_w_alpha[l], gla_b_alpha[l], gla_norm_g[l],
                         s5_a_re[l], s5_a_im[l], s5_log_dt[l], s5_b_re[l], s5_b_im[l],
                         s5_c_re[l], s5_c_im[l], s5_d[l], s5_w_glu[l], s5_b_glu[l], w_out[l])
    return x
```

```cpp
#include <hip/hip_runtime.h>
#include <cstdio>
#include <cstdint>
#include <cmath>
#define MK_MULTI 0
namespace pg8 {
#define PG8_LAS __attribute__((address_space(3)))
typedef unsigned short bf16_t;
typedef short bf16x8 __attribute__((ext_vector_type(8)));
typedef float f32x4 __attribute__((ext_vector_type(4)));
typedef unsigned u32x4 __attribute__((ext_vector_type(4)));
constexpr int BM = 256, BK = 64, HALF = 128, HTB = HALF * BK * 2  , STAGE_BYTES = 8 * HTB, NXCD = 8, WGM = 8;

__host__ __device__ __forceinline__ int lds_byte(int r, int c) { const int st = (r >> 4) * 2 + (c >> 5), rr = r & 15, cc = c & 31, ob = rr * 64 + cc * 2; return st * 1024 + (ob ^ (((ob >> 9) & 1) << 5)); }
__host__ __device__ __forceinline__ void stage_rc(int b, int& R, int& C) { const int st = b / 1024, sb = b % 1024, swz = sb ^ (((sb >> 9) & 1) << 5); R = (st >> 1) * 16 + swz / 64; C = (st & 1) * 32 + (swz % 64) / 2; }
__host__ __device__ __forceinline__ int perm32(int rho) { const int n = rho >> 4, i = rho & 15; return 8 * (i >> 2) + 4 * n + (i & 3); }

struct Unit { int pm, pn; };
struct Gemm { const bf16_t* A; const bf16_t* Bt; int M, N, K, lda; };

struct StaticOrder {
    int nM, nN, nwg, G, c;
    __host__ __device__ void init(int M, int N, int G_, int c_) { nM = M / BM; nN = N / BM; nwg = nM * nN; G = G_; c = c_; }
    __host__ __device__ bool next(int i, Unit& u) const {
        const long L = (long)i * G + c; if (L >= nwg) return false;
        int wgid = (int)L; { const int q = nwg / NXCD, r = nwg % NXCD, xcd = wgid % NXCD, off = wgid / NXCD; wgid = (xcd < r ? xcd * (q + 1) : r * (q + 1) + (xcd - r) * q) + off; }
        const int nig = WGM * nN, gid = wgid / nig, fm = gid * WGM, gsz = (nM - fm) < WGM ? (nM - fm) : WGM;
        u.pm = fm + ((wgid % nig) % gsz); u.pn = (wgid % nig) / gsz; return true;
    }
    __device__ __forceinline__ void a_ready(const Unit&) const {}
    __device__ __forceinline__ void done(const Unit&) const {}
};

__device__ __forceinline__ unsigned cvt_pk_bf16(float lo, float hi) { unsigned r; asm volatile("v_cvt_pk_bf16_f32 %0, %1, %2" : "=v"(r) : "v"(lo), "v"(hi)); return r; }
typedef float f32x2 __attribute__((ext_vector_type(2)));
__device__ __forceinline__ f32x2 gelu_pk(f32x2 v) {
    const f32x2 av = __builtin_elementwise_abs(v), d = av * 0.2316418882f + 1.0f;
    f32x2 t; t.x = __builtin_amdgcn_rcpf(d.x); t.y = __builtin_amdgcn_rcpf(d.y);
    f32x2 q = t * 0.5307027145f + (-0.7265760135f); q = q * t + 0.7107068705f; q = q * t + (-0.142248368f); q = q * t + 0.127414796f; q = q * t;
    const f32x2 s = (v * v) * (-0.72134752044f);
    f32x2 e; e.x = __builtin_amdgcn_exp2f(s.x); e.y = __builtin_amdgcn_exp2f(s.y);
    const f32x2 m = v * (q * e), r = v - m;
    f32x2 o; o.x = v.x < 0.f ? m.x : r.x; o.y = v.y < 0.f ? m.y : r.y; return o;
}

template <int ACT  > struct EpiBf16 {
    static constexpr bool PERM = true, AFTER_DRAIN = false; static_assert(ACT == 0 || ACT == 1, "EpiBf16: ACT is 0 (none) or 1 (gelu_pk)");
    bf16_t* O; int ldc; const float* bias; int split_cols; size_t split_stride; float scale0;
    __device__ __forceinline__ void operator()(const f32x4 (&acc)[2][2][4][2], const Unit& u, int wr, int wc, int fr, int fq) const {
        const int row0 = u.pm * BM + wr * 64 + fr; int colt = u.pn * BM; bf16_t* base = O;
        float sc = 1.f; if (split_cols) { const int t = colt / split_cols; base += (size_t)t * split_stride; colt -= t * split_cols; if (t == 0) sc = scale0; }
        const int col0 = colt + wc * 32 + 8 * fq, bcol0 = u.pn * BM + wc * 32 + 8 * fq;
        f32x4 bv[2][2];
#pragma unroll
        for (int bj = 0; bj < 2; ++bj)
#pragma unroll
            for (int n = 0; n < 2; ++n) bv[bj][n] = bias ? *(const f32x4*)(bias + bcol0 + bj * HALF + 4 * n) : (f32x4){0.f, 0.f, 0.f, 0.f};
#pragma unroll
        for (int ai = 0; ai < 2; ++ai)
#pragma unroll
            for (int m = 0; m < 4; ++m) { bf16_t* rowp = base + (size_t)(row0 + ai * HALF + m * 16) * ldc + col0;
#pragma unroll
                for (int bj = 0; bj < 2; ++bj) { f32x4 v0 = acc[ai][bj][m][0] + bv[bj][0], v1 = acc[ai][bj][m][1] + bv[bj][1];
                    if (ACT == 1) { f32x2 a = gelu_pk((f32x2){v0[0], v0[1]}), b = gelu_pk((f32x2){v0[2], v0[3]}), c = gelu_pk((f32x2){v1[0], v1[1]}), d = gelu_pk((f32x2){v1[2], v1[3]});
                        v0 = (f32x4){a.x, a.y, b.x, b.y}; v1 = (f32x4){c.x, c.y, d.x, d.y}; }
                    v0 = v0 * sc; v1 = v1 * sc; u32x4 w; w.x = cvt_pk_bf16(v0[0], v0[1]); w.y = cvt_pk_bf16(v0[2], v0[3]); w.z = cvt_pk_bf16(v1[0], v1[1]); w.w = cvt_pk_bf16(v1[2], v1[3]);
                    *(u32x4*)(rowp + bj * HALF) = w; } }
    }
};
struct EpiGlu {
    static constexpr bool PERM = true, AFTER_DRAIN = false;
    bf16_t* P; int ldp, col_y, col_g; const float* bglu;
    __device__ __forceinline__ void operator()(const f32x4 (&acc)[2][2][4][2], const Unit& u, int wr, int wc, int fr, int fq) const {
        const int row0 = u.pm * BM + wr * 64 + fr; const int col0 = u.pn * BM + wc * 32 + 8 * fq;
#pragma unroll
        for (int ai = 0; ai < 2; ++ai)
#pragma unroll
            for (int m = 0; m < 4; ++m) { bf16_t* rowp = P + (size_t)(row0 + ai * HALF + m * 16) * ldp;
#pragma unroll
                for (int bj = 0; bj < 2; ++bj) { const int col = col0 + bj * HALF;
                    const f32x4 b0 = *(const f32x4*)(bglu + col), b1 = *(const f32x4*)(bglu + col + 4);
                    const u32x4 yv = *(const u32x4*)(rowp + col_y + col), gv = *(const u32x4*)(rowp + col_g + col);
                    const f32x4 z0 = acc[ai][bj][m][0] + b0, z1 = acc[ai][bj][m][1] + b1;
                    float z[8] = {z0[0], z0[1], z0[2], z0[3], z1[0], z1[1], z1[2], z1[3]}; float o[8];
#pragma unroll
                    for (int e = 0; e < 8; ++e) { const unsigned yw = yv[e >> 1], gw = gv[e >> 1];
                        const float y = __uint_as_float((e & 1) ? (yw & 0xffff0000u) : (yw << 16)), g = __uint_as_float((e & 1) ? (gw & 0xffff0000u) : (gw << 16));
                        const float sz = __builtin_amdgcn_rcpf(1.0f + __expf(-z[e])), sg = __builtin_amdgcn_rcpf(1.0f + __expf(-g));
                        o[e] = y * sz * g * sg; }
                    u32x4 w; w.x = cvt_pk_bf16(o[0], o[1]); w.y = cvt_pk_bf16(o[2], o[3]); w.z = cvt_pk_bf16(o[4], o[5]); w.w = cvt_pk_bf16(o[6], o[7]);
                    *(u32x4*)(rowp + col_g + col) = w; } }
    }
};
template <class Epi, class Sched, bool ALIGN_EPI = false, bool SP2 = false>
__device__ __forceinline__ void gemm_phase(PG8_LAS unsigned char* lds, const Gemm g, const Sched& S, const Epi& E, int tid_in) {
    const int tid = tid_in, wid = __builtin_amdgcn_readfirstlane(tid >> 6), lane = tid & 63, wr = wid >> 2, wc = wid & 3, fr = lane & 15, fq = lane >> 4;
    const int K = g.K, nt = K / BK;
    unsigned voffA[2], voffB[2];
#pragma unroll
    for (int i = 0; i < 2; ++i) { int R, C; stage_rc(tid * 16 + i * 8192, R, C); const int Rb = Epi::PERM ? ((R & ~31) + perm32(R & 31)) : R;
        voffA[i] = (unsigned)(R * g.lda + C) * 2u; voffB[i] = (unsigned)(Rb * K + C) * 2u; }
    const size_t kstep = (size_t)(BK * 2);
    const size_t hstepB = (size_t)HALF * K * 2, hstepA = (size_t)HALF * g.lda * 2;
    const size_t tstepB = 2 * hstepB, tstepA = 2 * hstepA;
    const unsigned ldsw = (unsigned)wid * 1024u;
    const int aoff = lds_byte(wr * 64 + fr, fq * 8), boff = lds_byte(wc * 32 + fr, fq * 8);
#define PG8_SA(b, h) (((b) * 2 + (h)) * HTB)
#define PG8_SB(b, h) ((4 + (b) * 2 + (h)) * HTB)
#define PG8_STAGE(bufoff, gbase, voff) do { _Pragma("unroll") for (int _i = 0; _i < 2; ++_i) \
        __builtin_amdgcn_global_load_lds((const unsigned*)((const char*)(gbase) + (voff)[_i]), (PG8_LAS unsigned*)(lds + (bufoff) + ldsw + _i * 8192), 16, 0, 0); } while (0)
#define PG8_LDA(dst, b, h) do { _Pragma("unroll") for (int m = 0; m < 4; ++m) _Pragma("unroll") for (int k = 0; k < 2; ++k) dst[m][k] = *(const PG8_LAS bf16x8*)(lds + PG8_SA(b, h) + aoff + m * 2048 + k * 1024); } while (0)
#define PG8_LDB(dst, b, h) do { _Pragma("unroll") for (int n = 0; n < 2; ++n) _Pragma("unroll") for (int k = 0; k < 2; ++k) dst[n][k] = *(const PG8_LAS bf16x8*)(lds + PG8_SB(b, h) + boff + n * 2048 + k * 1024); } while (0)
#define PG8_MMA(ai, bj, At, Bt) do { __builtin_amdgcn_s_setprio(1); _Pragma("unroll") for (int m = 0; m < 4; ++m) _Pragma("unroll") for (int n = 0; n < 2; ++n) _Pragma("unroll") for (int k = 0; k < 2; ++k) \
        acc[ai][bj][m][n] = __builtin_amdgcn_mfma_f32_16x16x32_bf16(Bt[n][k], At[m][k], acc[ai][bj][m][n], 0, 0, 0); __builtin_amdgcn_s_setprio(0); } while (0)
#define PG8_WAIT_V(n) asm volatile("s_waitcnt vmcnt(" #n ")" ::: "memory")
#define PG8_WAIT_L(n) asm volatile("s_waitcnt lgkmcnt(" #n ")" ::: "memory")
#define PG8_BAR __builtin_amdgcn_s_barrier()
#define PG8_SCHED __builtin_amdgcn_sched_barrier(0)
    Unit cur, nxt; int ui = 0;
    if (!S.next(0, cur)) return;
    f32x4 acc[2][2][4][2];
#pragma unroll
    for (int a = 0; a < 2; ++a)
#pragma unroll
        for (int b = 0; b < 2; ++b)
#pragma unroll
            for (int m = 0; m < 4; ++m)
#pragma unroll
                for (int n = 0; n < 2; ++n) acc[a][b][m][n] = (f32x4){0.f, 0.f, 0.f, 0.f};
    bf16x8 At[4][2], B0[2][2], B1[2][2];
    const char* cA = (const char*)g.A + (size_t)cur.pm * tstepA; const char* cB = (const char*)g.Bt + (size_t)cur.pn * tstepB;
    S.a_ready(cur);
    if constexpr (SP2) {
        PG8_STAGE(PG8_SB(0, 0), cB, voffB); PG8_STAGE(PG8_SB(0, 1), cB + hstepB, voffB); PG8_STAGE(PG8_SA(0, 0), cA, voffA); PG8_STAGE(PG8_SA(0, 1), cA + hstepA, voffA);
        if (wr == 1) PG8_BAR;
        PG8_WAIT_V(2); PG8_BAR;
        PG8_STAGE(PG8_SB(1, 0), cB + kstep, voffB); PG8_STAGE(PG8_SA(1, 0), cA + kstep, voffA); PG8_STAGE(PG8_SB(1, 1), cB + hstepB + kstep, voffB);
        PG8_WAIT_V(6); PG8_BAR;
    } else {
        PG8_STAGE(PG8_SB(0, 0), cB, voffB); PG8_STAGE(PG8_SA(0, 0), cA, voffA); PG8_STAGE(PG8_SB(0, 1), cB + hstepB, voffB); PG8_STAGE(PG8_SA(0, 1), cA + hstepA, voffA);
        if (wr == 1) PG8_BAR;
        PG8_WAIT_V(4); PG8_BAR;
        PG8_STAGE(PG8_SB(1, 0), cB + kstep, voffB); PG8_STAGE(PG8_SA(1, 0), cA + kstep, voffA); PG8_STAGE(PG8_SB(1, 1), cB + hstepB + kstep, voffB);
        PG8_WAIT_V(6); PG8_BAR;
    }
    for (;;) {
        const bool has_next = S.next(ui + 1, nxt);
        const char* nA = has_next ? (const char*)g.A + (size_t)nxt.pm * tstepA : cA; const char* nB = has_next ? (const char*)g.Bt + (size_t)nxt.pn * tstepB : cB;
        for (int t = 0; t < nt; t += 2) {
            const bool last = (t == nt - 2);
            const char* a1 = cA + (size_t)(t + 1) * kstep;
            const char* a2 = last ? nA : cA + (size_t)(t + 2) * kstep; const char* b2 = last ? nB : cB + (size_t)(t + 2) * kstep;
            const char* a3 = a2 + kstep; const char* b3 = b2 + kstep;
            if (last && has_next) S.a_ready(nxt);
            if constexpr (SP2) {
            PG8_LDB(B0, 0, 0); PG8_LDB(B1, 0, 1); PG8_SCHED; PG8_LDA(At, 0, 0); PG8_STAGE(PG8_SA(1, 1), a1 + hstepA, voffA);
            PG8_WAIT_V(8); PG8_WAIT_L(0); PG8_BAR; PG8_MMA(0, 0, At, B0); PG8_MMA(0, 1, At, B1); PG8_BAR; PG8_SCHED;
            PG8_LDA(At, 0, 1); PG8_STAGE(PG8_SB(0, 0), b2, voffB); PG8_STAGE(PG8_SB(0, 1), b2 + hstepB, voffB); PG8_STAGE(PG8_SA(0, 0), a2, voffA);
            PG8_WAIT_V(8); PG8_WAIT_L(0); PG8_BAR; PG8_MMA(1, 0, At, B0); PG8_MMA(1, 1, At, B1); PG8_BAR; PG8_SCHED;
            PG8_LDB(B0, 1, 0); PG8_LDB(B1, 1, 1); PG8_SCHED; PG8_LDA(At, 1, 0); PG8_STAGE(PG8_SA(0, 1), a2 + hstepA, voffA);
            PG8_WAIT_V(8); PG8_WAIT_L(0); PG8_BAR; PG8_MMA(0, 0, At, B0); PG8_MMA(0, 1, At, B1); PG8_BAR; PG8_SCHED;
            PG8_LDA(At, 1, 1); PG8_STAGE(PG8_SB(1, 0), b3, voffB); PG8_STAGE(PG8_SB(1, 1), b3 + hstepB, voffB); PG8_STAGE(PG8_SA(1, 0), a3, voffA);
            PG8_WAIT_V(8); PG8_WAIT_L(0); PG8_BAR; PG8_MMA(1, 0, At, B0); PG8_MMA(1, 1, At, B1); PG8_BAR; PG8_SCHED;
            } else {
            PG8_LDB(B0, 0, 0); PG8_SCHED; PG8_LDA(At, 0, 0); PG8_STAGE(PG8_SA(1, 1), a1 + hstepA, voffA);
            PG8_WAIT_L(8); PG8_BAR; PG8_WAIT_L(0); PG8_MMA(0, 0, At, B0); PG8_BAR; PG8_SCHED;
            PG8_LDB(B1, 0, 1); PG8_STAGE(PG8_SB(0, 0), b2, voffB);
            PG8_BAR; PG8_WAIT_L(0); PG8_MMA(0, 1, At, B1); PG8_BAR;
            PG8_LDA(At, 0, 1); PG8_STAGE(PG8_SA(0, 0), a2, voffA);
            PG8_BAR; PG8_WAIT_L(0); PG8_MMA(1, 0, At, B0); PG8_BAR; PG8_SCHED;
            PG8_STAGE(PG8_SB(0, 1), b2 + hstepB, voffB);
            PG8_WAIT_V(6); PG8_BAR; PG8_MMA(1, 1, At, B1); PG8_BAR;
            PG8_LDB(B0, 1, 0); PG8_SCHED; PG8_LDA(At, 1, 0); PG8_STAGE(PG8_SA(0, 1), a2 + hstepA, voffA);
            PG8_WAIT_L(8); PG8_BAR; PG8_WAIT_L(0); PG8_MMA(0, 0, At, B0); PG8_BAR; PG8_SCHED;
            PG8_LDB(B1, 1, 1); PG8_STAGE(PG8_SB(1, 0), b3, voffB);
            PG8_BAR; PG8_WAIT_L(0); PG8_MMA(0, 1, At, B1); PG8_BAR;
            PG8_LDA(At, 1, 1); PG8_STAGE(PG8_SA(1, 0), a3, voffA);
            PG8_BAR; PG8_WAIT_L(0); PG8_MMA(1, 0, At, B0); PG8_BAR; PG8_SCHED;
            PG8_STAGE(PG8_SB(1, 1), b3 + hstepB, voffB);
            PG8_WAIT_V(6); PG8_BAR; PG8_MMA(1, 1, At, B1); PG8_BAR;
            }
        }
        if constexpr (ALIGN_EPI) { if (wr == 0) PG8_BAR; }
        if constexpr (!Epi::AFTER_DRAIN) { E(acc, cur, wr, wc, fr, fq); S.done(cur); }
        if (!has_next) break;
#pragma unroll
        for (int a = 0; a < 2; ++a)
#pragma unroll
            for (int b = 0; b < 2; ++b)
#pragma unroll
                for (int m = 0; m < 4; ++m)
#pragma unroll
                    for (int n = 0; n < 2; ++n) acc[a][b][m][n] = (f32x4){0.f, 0.f, 0.f, 0.f};
        cur = nxt; cA = nA; cB = nB; ++ui;
        if constexpr (ALIGN_EPI) { if (wr == 1) PG8_BAR; }
    }
    PG8_WAIT_V(0);
    if constexpr (!ALIGN_EPI) { if (wr == 0) PG8_BAR; }
    PG8_BAR;
    if constexpr (Epi::AFTER_DRAIN) { E.fused(acc, cur, wr, wc, fr, fq, lds, wid, lane); S.done(cur); }
#undef PG8_SA
#undef PG8_SB
#undef PG8_STAGE
#undef PG8_LDA
#undef PG8_LDB
#undef PG8_MMA
#undef PG8_WAIT_V
#undef PG8_WAIT_L
#undef PG8_BAR
#undef PG8_SCHED
}
}
#define GAS __attribute__((address_space(1)))
#define LAS __attribute__((address_space(3)))
typedef unsigned short bf16;
typedef short bf16x8 __attribute__((ext_vector_type(8)));
typedef float f32x4 __attribute__((ext_vector_type(4)));
typedef float f32x16 __attribute__((ext_vector_type(16)));
typedef unsigned u32x4 __attribute__((ext_vector_type(4)));
typedef unsigned u32x2 __attribute__((ext_vector_type(2)));
typedef short s16x4 __attribute__((ext_vector_type(4)));
typedef GAS unsigned gu32;
constexpr int NWAVES = 8;
constexpr int NBATCH = 4, SEQ = 4096, DM = 1024, TOK = NBATCH * SEQ, NLAYER = 2;
constexpr int LDP = 5376, WIN_COLS = 5136;
constexpr int C_AQ = 0, C_BV = 1024, C_CG = 1536, C_AK = 2048, C_AV = 2304, C_AG = 2560, C_BQ = 3584, C_BK = 3840, C_GL = 4096, C_BG = 4352, C_CU = 4864;
constexpr float EPS = 1e-6f, LOG2E = 1.4426950408889634f;
constexpr size_t MiB = 1u << 20;
constexpr size_t WS_CTL = 0, CTL_ZERO_BYTES = 64 * 1024;
constexpr int CW_BAR = 1024;
constexpr size_t WS_MOD = 1 * MiB;
constexpr size_t WS_TAB = 1 * MiB + 256 * 1024;
constexpr size_t WS_WIN = 2 * MiB, WIN_BYTES = (size_t)LDP * DM * 2;
constexpr size_t WS_WOUT = 23 * MiB, WOUT_BYTES = (size_t)DM * 2048 * 2;
constexpr size_t WS_WGLU = 31 * MiB, WGLU_BYTES = (size_t)512 * 512 * 2;
constexpr size_t WS_S5M = 32 * MiB, S5M_BYTES = 8 * MiB;
constexpr size_t S5M_TZ = 0, S5M_BZ = 4 * MiB, S5M_CZ = 6 * MiB;
constexpr size_t WS_H = 48 * MiB;
constexpr size_t WS_GLAE = 48 * MiB;
constexpr size_t WS_GLAD = 56 * MiB;
constexpr size_t WS_S5E = 57 * MiB;
constexpr size_t WS_P = 80 * MiB;
constexpr size_t WS_END = 248 * MiB;
static_assert(WS_WIN + 2 * WIN_BYTES <= WS_WOUT && WS_WOUT + 2 * WOUT_BYTES <= WS_WGLU && WS_WGLU + 2 * WGLU_BYTES <= WS_S5M && WS_S5M + 2 * S5M_BYTES <= WS_H, "ws map");
static_assert(WS_H + (size_t)TOK * DM * 2 <= WS_P && WS_P + (size_t)TOK * LDP * 2 <= WS_END && WS_S5E + 2048 * 128 * 4 <= WS_P, "ws map 2");
constexpr int RING_BYTES = 143360, LDSCTL_OFF = RING_BYTES, MISC_OFF = LDSCTL_OFF + 320, LDS_BYTES = 147456;

#define RLX_AGENT __ATOMIC_RELAXED, __HIP_MEMORY_SCOPE_AGENT
#define LDS_WAIT() asm volatile("s_waitcnt lgkmcnt(0)" ::: "memory")
typedef float f32x2_t __attribute__((ext_vector_type(2))); typedef __bf16 bf16x2_t __attribute__((ext_vector_type(2)));
__device__ __forceinline__ unsigned pk2(float lo, float hi) { f32x2_t v = {lo, hi}; bf16x2_t b = __builtin_convertvector(v, bf16x2_t); return __builtin_bit_cast(unsigned, b); }
__device__ __forceinline__ bf16 f2bf(float f) { return (bf16)(pk2(f, 0.f) & 0xffffu); }
__device__ __forceinline__ float bf2f(bf16 b) { return __uint_as_float((unsigned)b << 16); }
__device__ __forceinline__ float bflo(unsigned w) { return __uint_as_float(w << 16); }
__device__ __forceinline__ float bfhi(unsigned w) { return __uint_as_float(w & 0xffff0000u); }
__device__ __forceinline__ float sigmoidf_(float x) { return __builtin_amdgcn_rcpf(1.0f + __expf(-x)); }
__device__ __forceinline__ float wave_sum(float v) {
#pragma unroll
    for (int o = 1; o < 64; o <<= 1) v += __shfl_xor(v, o);
    return v;
}
#define MFMA16(a, b, c) __builtin_amdgcn_mfma_f32_16x16x32_bf16((a), (b), (c), 0, 0, 0)
#define MFMA32(a, b, c) __builtin_amdgcn_mfma_f32_32x32x16_bf16((a), (b), (c), 0, 0, 0)
#define XB_TMO      128
#define XB_XCNT(j)  (256  + 64 * (j))
#define XB_XSUB(j)  (1280 + 64 * (j))
#define XB_XGEN(j)  (2304 + 64 * (j))
#define XB_TOP      3328
#define XB_TOPGEN   3392
#define XCD_BAR_WORDS 3456
#define XB_SPIN_CAP (1u << 18)

__device__ __forceinline__ unsigned xb_ld(unsigned* p)              { return __hip_atomic_load(p, __ATOMIC_RELAXED, __HIP_MEMORY_SCOPE_AGENT); }
__device__ __forceinline__ unsigned xb_add(unsigned* p, unsigned v) { return __hip_atomic_fetch_add(p, v, __ATOMIC_RELAXED, __HIP_MEMORY_SCOPE_AGENT); }
__device__ __forceinline__ unsigned xb_xcc_id() { return (unsigned)__builtin_amdgcn_s_getreg((3 << 11) | 20) & 0xFu; }
#define XB_SPIN(cond, bar) do { unsigned _sp = 0; while (cond) { __builtin_amdgcn_s_sleep(1); \
    if ((++_sp & 255u) == 0u) { if (xb_ld(&(bar)[XB_TMO])) break; if (_sp > XB_SPIN_CAP) { atomicAdd(&(bar)[XB_TMO], 1u); break; } } } } while (0)

struct XcdBarrier {
    unsigned* bar; unsigned x;
    volatile LAS unsigned* st;
};

__device__ __forceinline__ XcdBarrier xcd_barrier_post(unsigned* bar, volatile LAS unsigned* st) {
    XcdBarrier b; b.bar = bar; b.x = xb_xcc_id(); b.st = st;
    if (threadIdx.x == 0) (void)xb_add(&bar[XB_XCNT(b.x)], 1u);
    return b;
}
__device__ __forceinline__ void xcd_barrier_complete(unsigned* bar, unsigned x, unsigned& nloc, unsigned& nx) {
    const unsigned G = gridDim.x * gridDim.y * gridDim.z;
    unsigned sum, cnt, mine, sp = 0u;
    for (;;) {
        sum = 0u; cnt = 0u; mine = 0u;
#pragma unroll
        for (unsigned j = 0; j < 16; ++j) { const unsigned c = xb_ld(&bar[XB_XCNT(j)]); sum += c; cnt += (c > 0u) ? 1u : 0u; mine = (j == x) ? c : mine; }
        if (sum == G) break;
        __builtin_amdgcn_s_sleep(1);
        if ((++sp & 255u) == 0u) { if (xb_ld(&bar[XB_TMO])) break; if (sp > XB_SPIN_CAP) { atomicAdd(&bar[XB_TMO], 1u); break; } }
    }
    nloc = mine > 0u ? mine : 1u; nx = cnt > 0u ? cnt : 1u;
}

__device__ __forceinline__ void xcd_barrier(const XcdBarrier& b) {
    asm volatile("s_waitcnt vmcnt(0)" ::: "memory");
    __syncthreads();
    if (threadIdx.x == 0) {
        unsigned* bar = b.bar;
        __builtin_amdgcn_s_waitcnt(0);
        unsigned nloc = b.st[0], nx = b.st[1];
        if (nloc == 0u) { xcd_barrier_complete(bar, b.x, nloc, nx); b.st[0] = nloc; b.st[1] = nx; }
        const unsigned old = xb_add(&bar[XB_XSUB(b.x)], 1u);
        const unsigned gen = old / nloc;
        if (old + 1u == (gen + 1u) * nloc) {
            __builtin_amdgcn_fence(__ATOMIC_RELEASE, "agent");
            asm volatile("s_waitcnt vmcnt(0)" ::: "memory");
            const unsigned og = xb_add(&bar[XB_TOP], 1u);
            const unsigned tg = og / nx;
            if (og + 1u == (tg + 1u) * nx) xb_add(&bar[XB_TOPGEN], 1u);
            else XB_SPIN(xb_ld(&bar[XB_TOPGEN]) == tg, bar);
            __builtin_amdgcn_fence(__ATOMIC_ACQUIRE, "agent");
            xb_add(&bar[XB_XGEN(b.x)], 1u);
            asm volatile("s_waitcnt vmcnt(0)" ::: "memory");
        } else {
            XB_SPIN(xb_ld(&bar[XB_XGEN(b.x)]) == gen, bar);
            __builtin_amdgcn_fence(__ATOMIC_ACQUIRE, "agent");
            asm volatile("s_waitcnt vmcnt(0)" ::: "memory");
        }
    }
    __syncthreads();
}
__device__ __forceinline__ int win_srccol(int n0) {
    if (n0 < 1024) return n0;
    if (n0 < 1536) return 3072 + (n0 - 1024);
    if (n0 < 2048) return 4624 + (n0 - 1536);
    if (n0 < 2304) return 1024 + (n0 - 2048);
    if (n0 < 2560) return 1280 + (n0 - 2304);
    if (n0 < 3584) return 1536 + (n0 - 2560);
    if (n0 < 3840) return 2560 + (n0 - 3584);
    if (n0 < 4096) return 2816 + (n0 - 3840);
    if (n0 < 4352) return -1;
    if (n0 < 4864) return 3600 + (n0 - 4352);
    return 4112 + (n0 - 4864);
}
__device__ __forceinline__ void transpose_item(const float* W, int ldw, int srccol, bf16* WT, int K, int dstrow, LAS float* scr, int k0, int lane,
                                               const float* walpha  ) {
    if (walpha == nullptr) {
#pragma unroll 8
        for (int i = 0; i < 32; ++i) { const int kk = 2 * i + (lane >> 5); scr[kk * 33 + (lane & 31)] = W[(size_t)(k0 + kk) * ldw + srccol + (lane & 31)]; }
    } else {
        float wa[16];
#pragma unroll
        for (int r = 0; r < 16; ++r) wa[r] = walpha[r * 256 + srccol + (lane & 31)];
#pragma unroll 2
        for (int i = 0; i < 32; ++i) { const int kk = 2 * i + (lane >> 5); const float* wr = W + (size_t)(k0 + kk) * ldw + 3584; float s = 0.f;
#pragma unroll
            for (int r = 0; r < 16; ++r) s += wr[r] * wa[r];
            scr[kk * 33 + (lane & 31)] = s; }
    }
    LDS_WAIT(); asm volatile("" ::: "memory");
    const int c = lane & 7;
#pragma unroll
    for (int j = 0; j < 4; ++j) { const int n = (lane >> 3) + 8 * j; const LAS float* s = scr + (8 * c) * 33 + n;
        u32x4 o; o.x = pk2(s[0 * 33], s[1 * 33]); o.y = pk2(s[2 * 33], s[3 * 33]); o.z = pk2(s[4 * 33], s[5 * 33]); o.w = pk2(s[6 * 33], s[7 * 33]);
        *(u32x4*)(WT + (size_t)(dstrow + n) * K + k0 + 8 * c) = o; }
    LDS_WAIT(); asm volatile("" ::: "memory");
}

__device__ __forceinline__ void p0_mod_item(LAS unsigned char* lds, const float* c, const float* wmod, const float* bmod, float* mod, int it, int tid, int wid, int lane) {
    LAS float* sc = (LAS float*)lds; LAS float* part = (LAS float*)(lds + 16384);
    for (int i = tid; i < 4096; i += 512) { const float cv = c[i]; sc[i] = cv * sigmoidf_(cv); }
    __syncthreads();
    const int l = it / 96, nb = it % 96, col = nb * 32 + (lane & 31), ks = wid * 2 + (lane >> 5);
    const float* wp = wmod + (size_t)l * 1024 * 3072 + col;
    float a0 = 0.f, a1 = 0.f, a2 = 0.f, a3 = 0.f;
#pragma unroll 8
    for (int i = 0; i < 64; ++i) { const int k = ks * 64 + i; const float w = wp[(size_t)k * 3072]; a0 += sc[k] * w; a1 += sc[1024 + k] * w; a2 += sc[2048 + k] * w; a3 += sc[3072 + k] * w; }
    part[(ks * 4 + 0) * 32 + (lane & 31)] = a0; part[(ks * 4 + 1) * 32 + (lane & 31)] = a1; part[(ks * 4 + 2) * 32 + (lane & 31)] = a2; part[(ks * 4 + 3) * 32 + (lane & 31)] = a3;
    __syncthreads();
    if (tid < 128) { const int b = tid >> 5, n = tid & 31; float s = 0.f;
#pragma unroll
        for (int k = 0; k < 16; ++k) s += part[(k * 4 + b) * 32 + n];
        mod[(size_t)(l * 4 + b) * 3072 + nb * 32 + n] = s + bmod[l * 3072 + nb * 32 + n]; }
    __syncthreads();
}

__device__ __forceinline__ void p0_s5_item(LAS unsigned char* lds, const float* const* in, unsigned char* ws, int l, int g, int tid) {
    LAS float* PWr = (LAS float*)lds; LAS float* PWi = PWr + 17 * 64; LAS float* BTr = PWi + 17 * 64; LAS float* BTi = BTr + 1024;
    LAS float* CRr = BTi + 1024; LAS float* CRi = CRr + 1024; LAS float* KC = CRi + 1024;
    const float* are = in[11] + (size_t)(l * 32 + g) * 64; const float* aim = in[12] + (size_t)(l * 32 + g) * 64;
    const double dt = exp((double)in[13][l * 32 + g]);
    const float* bre = in[14] + (size_t)(l * 32 + g) * 1024; const float* bim = in[15] + (size_t)(l * 32 + g) * 1024;
    const float* cre = in[16] + (size_t)(l * 32 + g) * 1024; const float* cim = in[17] + (size_t)(l * 32 + g) * 1024;
    const float* dd = in[18] + (size_t)l * 512 + g * 16;
    float* tab = (float*)(ws + WS_TAB) + (size_t)(l * 32 + g) * 6 * 64;
    for (int idx = tid; idx < 17 * 64; idx += 512) { const int tau = idx >> 6, p = idx & 63; const double ar = are[p], ai = aim[p];
        const double mag = exp((double)tau * ar * dt), ang = (double)tau * ai * dt; PWr[idx] = (float)(mag * cos(ang)); PWi[idx] = (float)(mag * sin(ang)); }
    if (tid < 64) { const int p = tid; const double ar = are[p], ai = aim[p];
        const double mag = exp(ar * dt), abr = mag * cos(ai * dt), abi = mag * sin(ai * dt), den = ar * ar + ai * ai, nr = abr - 1.0;
        const double fr = (nr * ar + abi * ai) / den, fi = (abi * ar - nr * ai) / den;
#pragma unroll 4
        for (int h = 0; h < 16; ++h) { const double br = bre[p * 16 + h], bi = bim[p * 16 + h]; BTr[p * 16 + h] = (float)(fr * br - fi * bi); BTi[p * 16 + h] = (float)(fr * bi + fi * br); }
        const double m64 = exp(64.0 * ar * dt), a64 = 64.0 * ai * dt, m256 = exp(256.0 * ar * dt), a256 = 256.0 * ai * dt, m16 = exp(16.0 * ar * dt), a16 = 16.0 * ai * dt;
        tab[0 * 64 + p] = (float)(m16 * cos(a16)); tab[1 * 64 + p] = (float)(m16 * sin(a16));
        tab[2 * 64 + p] = (float)(m64 * cos(a64)); tab[3 * 64 + p] = (float)(m64 * sin(a64));
        tab[4 * 64 + p] = (float)(m256 * cos(a256)); tab[5 * 64 + p] = (float)(m256 * sin(a256)); }
    for (int idx = tid; idx < 1024; idx += 512) { CRr[idx] = cre[idx]; CRi[idx] = cim[idx]; }
    __syncthreads();
#pragma unroll 1
    for (int i = 0; i < 8; ++i) { const int idx = tid + 512 * i, tau = idx >> 8, h = (idx >> 4) & 15, hp = idx & 15; float s = 0.f;
#pragma unroll 8
        for (int p = 0; p < 64; ++p) { const float pr = PWr[tau * 64 + p], pi = PWi[tau * 64 + p], br = BTr[p * 16 + hp], bi = BTi[p * 16 + hp];
            const float zr = pr * br - pi * bi, zi = pr * bi + pi * br; s += CRr[h * 64 + p] * zr - CRi[h * 64 + p] * zi; }
        if (tau == 0 && h == hp) s += dd[h];
        KC[idx] = s; }
    __syncthreads();
    bf16* Tz = (bf16*)(ws + WS_S5M + (size_t)l * S5M_BYTES + S5M_TZ) + (size_t)g * 65536;
    bf16* Bz = (bf16*)(ws + WS_S5M + (size_t)l * S5M_BYTES + S5M_BZ) + (size_t)g * 32768;
    bf16* Cz = (bf16*)(ws + WS_S5M + (size_t)l * S5M_BYTES + S5M_CZ) + (size_t)g * 32768;
#pragma unroll 1
    for (int i = 0; i < 16; ++i) { const int idx = tid + 512 * i, n = idx >> 5, c = idx & 31, ii = n >> 4, h = n & 15, j = c >> 1, hp0 = 8 * (c & 1); float v[8];
#pragma unroll
        for (int e = 0; e < 8; ++e) v[e] = (j <= ii) ? KC[((ii - j) * 16 + h) * 16 + hp0 + e] : 0.f;
        u32x4 o; o.x = pk2(v[0], v[1]); o.y = pk2(v[2], v[3]); o.z = pk2(v[4], v[5]); o.w = pk2(v[6], v[7]); *(u32x4*)(Tz + (size_t)n * 256 + 8 * c) = o; }
#pragma unroll 1
    for (int i = 0; i < 8; ++i) { const int idx = tid + 512 * i, n = idx >> 5, c = idx & 31, p = n & 63, im = n >> 6, j = c >> 1, hp0 = 8 * (c & 1), tau = 15 - j; float v[8];
        const float pr = PWr[tau * 64 + p], pi = PWi[tau * 64 + p];
#pragma unroll
        for (int e = 0; e < 8; ++e) { const float br = BTr[p * 16 + hp0 + e], bi = BTi[p * 16 + hp0 + e]; v[e] = im ? (pr * bi + pi * br) : (pr * br - pi * bi); }
        u32x4 o; o.x = pk2(v[0], v[1]); o.y = pk2(v[2], v[3]); o.z = pk2(v[4], v[5]); o.w = pk2(v[6], v[7]); *(u32x4*)(Bz + (size_t)n * 256 + 8 * c) = o; }
#pragma unroll 1
    for (int i = 0; i < 8; ++i) { const int idx = tid + 512 * i, n = idx >> 4, c = idx & 15, ii = n >> 4, h = n & 15, im = c >> 3, tau = ii + 1; float v[8];
#pragma unroll
        for (int e = 0; e < 8; ++e) { const int p = (8 * c + e) & 63; const float cr = CRr[h * 64 + p], ci = CRi[h * 64 + p], pr = PWr[tau * 64 + p], pi = PWi[tau * 64 + p];
            v[e] = im ? -(cr * pi + ci * pr) : (cr * pr - ci * pi); }
        u32x4 o; o.x = pk2(v[0], v[1]); o.y = pk2(v[2], v[3]); o.z = pk2(v[4], v[5]); o.w = pk2(v[6], v[7]); *(u32x4*)(Cz + (size_t)n * 128 + 8 * c) = o; }
    __syncthreads();
}

__device__ __forceinline__ void p0_prologue(LAS unsigned char* lds, const float* const* in, unsigned char* ws, int vcu, int G, int tid, int wid, int lane) {
    for (int it = vcu; it < 64 + 192; it += G) {
        if (it < 64) p0_s5_item(lds, in, ws, it >> 5, it & 31, tid);
        else p0_mod_item(lds, in[1], in[2], in[3], (float*)(ws + WS_MOD), it - 64, tid, wid, lane);
    }
    LAS float* scr = (LAS float*)(lds + wid * 16384);
    const int gw = vcu * NWAVES + wid, NGW = G * NWAVES;
    constexpr int I_IN = 16 * 168, I_OUT = 32 * 32, I_GLU = 8 * 16, I_L = I_IN + I_OUT + I_GLU;
    for (int it = gw; it < NLAYER * I_L; it += NGW) {
        const int l = it / I_L; int r = it % I_L;
        if (r < I_IN) { const int nb = r % 168, kb = r / 168, n0 = nb * 32, sc = win_srccol(n0);
            const float* W = in[6] + (size_t)l * DM * WIN_COLS; bf16* WT = (bf16*)(ws + WS_WIN + (size_t)l * WIN_BYTES);
            if (sc >= 0) transpose_item(W, WIN_COLS, sc, WT, DM, n0, scr, kb * 64, lane, nullptr);
            else transpose_item(W, WIN_COLS, n0 - C_GL, WT, DM, n0, scr, kb * 64, lane, in[8] + (size_t)l * 16 * 256);
            continue; }
        r -= I_IN;
        if (r < I_OUT) { const int nb = r % 32, kb = r / 32;
            transpose_item(in[21] + (size_t)l * 2048 * DM, DM, nb * 32, (bf16*)(ws + WS_WOUT + (size_t)l * WOUT_BYTES), 2048, nb * 32, scr, kb * 64, lane, nullptr); continue; }
        r -= I_OUT;
        { const int nb = r % 16, kb = r / 16;
          transpose_item(in[19] + (size_t)l * 512 * 512, 512, nb * 32, (bf16*)(ws + WS_WGLU + (size_t)l * WGLU_BYTES), 512, nb * 32, scr, kb * 64, lane, nullptr); }
    }
}
__device__ __forceinline__ void prenorm_phase(const float* x, const float* gpre, const float* mod  , bf16* H, int vcu, int wid, int lane) {
    const int gw = vcu * NWAVES + wid;
    const int m0 = gw * 8, b = m0 / SEQ;
    if (m0 >= TOK) return;
    f32x4 ga[4], sh[4];
#pragma unroll
    for (int j = 0; j < 4; ++j) { const int col = 256 * j + 4 * lane; const f32x4 g = *(const f32x4*)(gpre + col), s = *(const f32x4*)(mod + (size_t)b * 3072 + 1024 + col);
        ga[j] = g * (s + 1.0f); sh[j] = *(const f32x4*)(mod + (size_t)b * 3072 + col); }
#pragma unroll 2
    for (int i = 0; i < 8; ++i) { const int m = m0 + i; const float* xr = x + (size_t)m * DM; f32x4 v[4]; float ss = 0.f;
#pragma unroll
        for (int j = 0; j < 4; ++j) { v[j] = *(const f32x4*)(xr + 256 * j + 4 * lane); ss += (v[j][0] * v[j][0] + v[j][1] * v[j][1]) + (v[j][2] * v[j][2] + v[j][3] * v[j][3]); }
        const float r = rsqrtf(wave_sum(ss) * (1.0f / DM) + EPS);
#pragma unroll
        for (int j = 0; j < 4; ++j) { const f32x4 o = v[j] * r * ga[j] + sh[j]; u32x2 w; w.x = pk2(o[0], o[1]); w.y = pk2(o[2], o[3]); *(u32x2*)(H + (size_t)m * DM + 256 * j + 4 * lane) = w; }
    }
}
__device__ __forceinline__ void post_phase(const float* xin, float* xout, const bf16* Y, const float* gpost, const float* mod  , bool do_next, const float* gpre_n, const float* mod_n, bf16* Hn,
                                           int vcu, int wid, int lane) {
    const int gw = vcu * NWAVES + wid; const int m0 = gw * 8, b = m0 / SEQ;
    if (m0 >= TOK) return;
    f32x4 gp[4], gt[4];
#pragma unroll
    for (int j = 0; j < 4; ++j) { const int col = 256 * j + 4 * lane; gp[j] = *(const f32x4*)(gpost + col); gt[j] = *(const f32x4*)(mod + (size_t)b * 3072 + 2048 + col); }
#pragma unroll 1
    for (int i = 0; i < 8; ++i) { const int m = m0 + i; f32x4 y[4], xv[4]; float ss = 0.f;
#pragma unroll
        for (int j = 0; j < 4; ++j) { const u32x2 w = *(const u32x2*)(Y + (size_t)m * DM + 256 * j + 4 * lane); y[j] = (f32x4){bflo(w.x), bfhi(w.x), bflo(w.y), bfhi(w.y)};
            xv[j] = *(const f32x4*)(xin + (size_t)m * DM + 256 * j + 4 * lane); ss += (y[j][0] * y[j][0] + y[j][1] * y[j][1]) + (y[j][2] * y[j][2] + y[j][3] * y[j][3]); }
        const float r = rsqrtf(wave_sum(ss) * (1.0f / DM) + EPS); float s2 = 0.f;
#pragma unroll
        for (int j = 0; j < 4; ++j) { xv[j] = xv[j] + gt[j] * (y[j] * r * gp[j]); *(f32x4*)(xout + (size_t)m * DM + 256 * j + 4 * lane) = xv[j];
            s2 += (xv[j][0] * xv[j][0] + xv[j][1] * xv[j][1]) + (xv[j][2] * xv[j][2] + xv[j][3] * xv[j][3]); }
        if (do_next) { const float r2 = rsqrtf(wave_sum(s2) * (1.0f / DM) + EPS);
#pragma unroll
            for (int j = 0; j < 4; ++j) { const int col = 256 * j + 4 * lane; const f32x4 g = *(const f32x4*)(gpre_n + col), s = *(const f32x4*)(mod_n + (size_t)b * 3072 + 1024 + col), sh = *(const f32x4*)(mod_n + (size_t)b * 3072 + col);
                const f32x4 o = xv[j] * r2 * (g * (s + 1.0f)) + sh; u32x2 w; w.x = pk2(o[0], o[1]); w.y = pk2(o[2], o[3]); *(u32x2*)(Hn + (size_t)m * DM + 256 * j + 4 * lane) = w; } }
    }
}
typedef short v4i16_t __attribute__((ext_vector_type(4)));
__device__ __forceinline__ s16x4 vtr(LAS unsigned char* p) { return __builtin_bit_cast(s16x4, __builtin_amdgcn_ds_read_tr16_b64_v4i16((LAS v4i16_t*)p)); }
__device__ __forceinline__ void attn_item(LAS unsigned char* lds, bf16* P, const float* sinks, int item, int tid, int wid, int lane) {
    const int r32 = lane & 31, hi = lane >> 5;
    const int qblk = item & 31, kvh = (item >> 5) & 3, b = item >> 7, q0 = qblk * 128;
    const size_t rowbase = (size_t)b * SEQ;
    LAS unsigned char* Ks = lds; LAS unsigned char* Vs = lds + 32768; LAS float* ost = (LAS float*)(lds + 65536 + wid * 8704);
    { const int kr = tid >> 1, hf = tid & 1, key = q0 - 128 + kr; u32x4 kv[4], vv[4];
      if (key >= 0) { const bf16* src = P + (rowbase + key) * LDP + kvh * 64 + hf * 32;
#pragma unroll
          for (int c = 0; c < 4; ++c) { kv[c] = *(const u32x4*)(src + C_AK + c * 8); vv[c] = *(const u32x4*)(src + C_AV + c * 8); } }
      else {
#pragma unroll
          for (int c = 0; c < 4; ++c) { kv[c] = (u32x4){0u, 0u, 0u, 0u}; vv[c] = (u32x4){0u, 0u, 0u, 0u}; } }
#pragma unroll
      for (int c = 0; c < 4; ++c) { const int ch = hf * 4 + c; *(LAS u32x4*)(Ks + kr * 128 + ((ch ^ (kr & 7)) << 4)) = kv[c]; *(LAS u32x4*)(Vs + kr * 128 + (ch << 4)) = vv[c]; } }
    __syncthreads();
    const int g = wid >> 1, half = wid & 1, head = kvh * 4 + g;
    const float slope2 = exp2f(-0.5f * (float)(head + 1)) * LOG2E, sink2 = sinks[head] * LOG2E, C2 = 0.125f * LOG2E;
    const int q16 = (lane & 15) >> 2, p16 = lane & 3, dblk = (lane >> 4) & 1;
#pragma unroll 1
    for (int sb = 0; sb < 2; ++sb) {
        const int qs = q0 + half * 64 + sb * 32, lrow0 = half * 64 + sb * 32;
        const bf16* qp = P + (rowbase + qs + r32) * LDP + C_AQ + head * 64 + hi * 8;
        bf16x8 qf[4];
#pragma unroll
        for (int kk = 0; kk < 4; ++kk) qf[kk] = *(const bf16x8*)(qp + kk * 16);
        f32x16 S[5]; float m = sink2; int e = r32 - 4 * hi; asm volatile("" : "+v"(e)); const float ef = (float)e;
#pragma unroll
        for (int kt = 0; kt < 5; ++kt) { f32x16 acc;
#pragma unroll
            for (int r = 0; r < 16; ++r) acc[r] = 0.f;
            const int krow = lrow0 + 32 * kt + r32;
#pragma unroll
            for (int kk = 0; kk < 4; ++kk) { const int ch = 2 * kk + hi; const bf16x8 kf = *(const LAS bf16x8*)(Ks + krow * 128 + ((ch ^ (krow & 7)) << 4)); acc = MFMA32(kf, qf[kk], acc); }
            { const bool tile_ok = (qs - 128 + 32 * kt) >= 0;
              const float base = -slope2 * ((float)(128 - 32 * kt) + ef);
#pragma unroll
              for (int r = 0; r < 16; ++r) { const int cr = (r & 3) + 8 * (r >> 2);
                  const float s = fmaf(acc[r], C2, fmaf(slope2, (float)cr, base));
                  bool ok = tile_ok; if (kt == 0) ok = ok && (e < cr); if (kt == 4) ok = ok && (e >= cr);
                  S[kt][r] = ok ? s : -INFINITY; m = fmaxf(m, S[kt][r]); } }
            __builtin_amdgcn_sched_barrier(0); }
        m = fmaxf(m, __shfl_xor(m, 32));
        float l = 0.f;
#pragma unroll
        for (int kt = 0; kt < 5; ++kt)
#pragma unroll
            for (int r = 0; r < 16; ++r) { const float p = __builtin_amdgcn_exp2f(S[kt][r] - m); S[kt][r] = p; l += p; }
        l += __shfl_xor(l, 32); l += __builtin_amdgcn_exp2f(sink2 - m);
        const float inv_l = 1.0f / l;
        f32x16 o0, o1;
#pragma unroll
        for (int r = 0; r < 16; ++r) { o0[r] = 0.f; o1[r] = 0.f; }
#pragma unroll
        for (int kt = 0; kt < 5; ++kt)
#pragma unroll
            for (int ks = 0; ks < 2; ++ks) { u32x4 pw; pw.x = pk2(S[kt][8 * ks + 0], S[kt][8 * ks + 1]); pw.y = pk2(S[kt][8 * ks + 2], S[kt][8 * ks + 3]); pw.z = pk2(S[kt][8 * ks + 4], S[kt][8 * ks + 5]); pw.w = pk2(S[kt][8 * ks + 6], S[kt][8 * ks + 7]);
                const bf16x8 pa = __builtin_bit_cast(bf16x8, pw);
                LAS unsigned char* vb = Vs + (lrow0 + 32 * kt + 16 * ks + 4 * hi + q16) * 128 + dblk * 32 + p16 * 8;
                const s16x4 a0 = vtr(vb), a1 = vtr(vb + 8 * 128), b0 = vtr(vb + 64), b1 = vtr(vb + 64 + 8 * 128);
                const bf16x8 v0 = __builtin_shufflevector(a0, a1, 0, 1, 2, 3, 4, 5, 6, 7), v1 = __builtin_shufflevector(b0, b1, 0, 1, 2, 3, 4, 5, 6, 7);
                o0 = MFMA32(pa, v0, o0); o1 = MFMA32(pa, v1, o1); __builtin_amdgcn_sched_barrier(0); }
#pragma unroll
        for (int r = 0; r < 16; ++r) { const int qr = (r & 3) + 8 * (r >> 2) + 4 * hi; ost[qr * 68 + r32] = o0[r]; ost[qr * 68 + 32 + r32] = o1[r]; }
        asm volatile("" ::: "memory");
        { const int row = lane >> 1, hf = lane & 1; const float sc = __shfl(inv_l, row);
          bf16* rp = P + (rowbase + qs + row) * LDP + head * 64 + hf * 32;
#pragma unroll
          for (int c = 0; c < 4; ++c) { const u32x4 gv = *(const u32x4*)(rp + C_AG + 8 * c);
              const f32x4 x0 = *(const LAS f32x4*)(ost + row * 68 + hf * 32 + 8 * c), x1 = *(const LAS f32x4*)(ost + row * 68 + hf * 32 + 8 * c + 4);
              float gg[8] = {bflo(gv.x), bfhi(gv.x), bflo(gv.y), bfhi(gv.y), bflo(gv.z), bfhi(gv.z), bflo(gv.w), bfhi(gv.w)};
              float xx[8] = {x0[0], x0[1], x0[2], x0[3], x1[0], x1[1], x1[2], x1[3]};
#pragma unroll
              for (int e = 0; e < 8; ++e) xx[e] = xx[e] * sc * gg[e] * sigmoidf_(gg[e]);
              u32x4 w; w.x = pk2(xx[0], xx[1]); w.y = pk2(xx[2], xx[3]); w.z = pk2(xx[4], xx[5]); w.w = pk2(xx[6], xx[7]);
              *(u32x4*)(rp + C_AQ + 8 * c) = w; } }
        asm volatile("" ::: "memory");
    }
    __syncthreads();
}
constexpr int GL_QT = 0, GL_KT = 9216, GL_KH = 18432, GL_AT = 27648, GL_VT = 36864, GL_ST = 55296, GL_PART = 73728, GL_BL = 75776, GL_SS = 76032, GL_RS = 78080, GL_LD = 72;
__device__ __forceinline__ bf16x8 ldsfrag(LAS unsigned char* base, int row, int kof) { return *(const LAS bf16x8*)(base + (row * GL_LD + kof) * 2); }
template <bool OUT>
__device__ __forceinline__ void gla_item(LAS unsigned char* lds, bf16* P, const float* balpha, const float* gnorm, float* GE, float* GD, int item, int tid, int wid, int lane) {
    const int c16 = lane & 15, q = lane >> 4;
    const int b = item >> 6, hd = (item >> 4) & 3, seg = item & 15;
    const size_t row0 = (size_t)b * SEQ + seg * 256;
    LAS bf16* QT = (LAS bf16*)(lds + GL_QT); LAS bf16* KT = (LAS bf16*)(lds + GL_KT); LAS bf16* AT = (LAS bf16*)(lds + GL_AT); LAS bf16* ST = (LAS bf16*)(lds + GL_ST);
    LAS float* PART = (LAS float*)(lds + GL_PART); LAS float* BL = (LAS float*)(lds + GL_BL); LAS float* SS = (LAS float*)(lds + GL_SS); LAS float* RS = (LAS float*)(lds + GL_RS);
    f32x4 S[4];
#pragma unroll
    for (int nt = 0; nt < 4; ++nt) S[nt] = (f32x4){0.f, 0.f, 0.f, 0.f};
    if (OUT) {
#pragma unroll 1
        for (int sp = 0; sp < seg; ++sp) { const float* e = GE + (size_t)(item - seg + sp) * 8192; const float* dd = GD + (size_t)(item - seg + sp) * 64;
#pragma unroll
            for (int nt = 0; nt < 4; ++nt) { const float dec = dd[16 * nt + c16];
#pragma unroll
                for (int r = 0; r < 4; ++r) S[nt][r] = S[nt][r] * dec + e[(16 * wid + 4 * q + r) * 64 + 16 * nt + c16]; } } }
    float dtot = 0.f;
    const int d = tid & 63, part = tid >> 6;
    const float ba = balpha[hd * 64 + d];
#pragma unroll 1
    for (int ch = 0; ch < 4; ++ch) {
        const size_t rowc = row0 + ch * 64;
        float bcs[8]; float run = 0.f;
#pragma unroll
        for (int i = 0; i < 8; ++i) { const float x = bf2f(P[(rowc + part * 8 + i) * LDP + C_GL + hd * 64 + d]) + ba;
            const float la = (fminf(x, 0.f) - log1pf(__expf(-fabsf(x)))) * 0.0625f; run += la; bcs[i] = run; }
        PART[part * 64 + d] = run;
        __syncthreads();
        float off = 0.f, tot = 0.f;
#pragma unroll
        for (int p = 0; p < 8; ++p) { const float v = PART[p * 64 + d]; tot += v; off += (p < part) ? v : 0.f; }
        if (part == 0) { BL[d] = tot; dtot += tot; }
        { float kh[8];
#pragma unroll
          for (int i = 0; i < 8; ++i) { const float bi = off + bcs[i]; const int tok = part * 8 + i; const float kx = bf2f(P[(rowc + tok) * LDP + C_BK + hd * 64 + d]);
              if (OUT) { const float qx = bf2f(P[(rowc + tok) * LDP + C_BQ + hd * 64 + d]); QT[tok * GL_LD + d] = f2bf(qx * 0.125f * __expf(bi)); KT[tok * GL_LD + d] = f2bf(kx * __expf(-bi)); }
              kh[i] = kx * __expf(tot - bi); }
          u32x4 w; w.x = pk2(kh[0], kh[1]); w.y = pk2(kh[2], kh[3]); w.z = pk2(kh[4], kh[5]); w.w = pk2(kh[6], kh[7]);
          *(LAS u32x4*)(lds + GL_KH + (d * GL_LD + part * 8) * 2) = w; }
        { const int v = tid & 127, tp = tid >> 7; float vv[16];
#pragma unroll
          for (int i = 0; i < 16; ++i) vv[i] = bf2f(P[(rowc + tp * 16 + i) * LDP + C_BV + hd * 128 + v]);
          u32x4 w0, w1; w0.x = pk2(vv[0], vv[1]); w0.y = pk2(vv[2], vv[3]); w0.z = pk2(vv[4], vv[5]); w0.w = pk2(vv[6], vv[7]);
          w1.x = pk2(vv[8], vv[9]); w1.y = pk2(vv[10], vv[11]); w1.z = pk2(vv[12], vv[13]); w1.w = pk2(vv[14], vv[15]);
          *(LAS u32x4*)(lds + GL_VT + (v * GL_LD + tp * 16) * 2) = w0; *(LAS u32x4*)(lds + GL_VT + (v * GL_LD + tp * 16 + 8) * 2) = w1; }
        if (OUT) {
#pragma unroll
            for (int nt = 0; nt < 4; ++nt)
#pragma unroll
                for (int r = 0; r < 4; ++r) ST[(16 * wid + 4 * q + r) * GL_LD + 16 * nt + c16] = f2bf(S[nt][r]); }
        __syncthreads();
        if (OUT) {
            { const int mt = wid >> 1;
#pragma unroll
              for (int t = 0; t < 2; ++t) { const int nt = 2 * (wid & 1) + t; f32x4 acc = (f32x4){0.f, 0.f, 0.f, 0.f};
                  if (nt <= mt) {
#pragma unroll
                      for (int kk = 0; kk < 2; ++kk) acc = MFMA16(ldsfrag(lds + GL_QT, 16 * mt + c16, 32 * kk + 8 * q), ldsfrag(lds + GL_KT, 16 * nt + c16, 32 * kk + 8 * q), acc); }
#pragma unroll
                  for (int r = 0; r < 4; ++r) { const int i = 16 * mt + 4 * q + r, j = 16 * nt + c16; AT[i * GL_LD + j] = f2bf((j <= i) ? acc[r] : 0.f); } } }
            __syncthreads();
            f32x4 o[4];
#pragma unroll
            for (int mt = 0; mt < 4; ++mt) { f32x4 acc = (f32x4){0.f, 0.f, 0.f, 0.f};
#pragma unroll
                for (int kk = 0; kk < 2; ++kk) if (kk == 0 || mt >= 2) acc = MFMA16(ldsfrag(lds + GL_AT, 16 * mt + c16, 32 * kk + 8 * q), ldsfrag(lds + GL_VT, 16 * wid + c16, 32 * kk + 8 * q), acc);
#pragma unroll
                for (int kk = 0; kk < 2; ++kk) acc = MFMA16(ldsfrag(lds + GL_QT, 16 * mt + c16, 32 * kk + 8 * q), ldsfrag(lds + GL_ST, 16 * wid + c16, 32 * kk + 8 * q), acc);
                o[mt] = acc; }
#pragma unroll
            for (int mt = 0; mt < 4; ++mt)
#pragma unroll
                for (int r = 0; r < 4; ++r) { float s = o[mt][r] * o[mt][r]; s += __shfl_xor(s, 1); s += __shfl_xor(s, 2); s += __shfl_xor(s, 4); s += __shfl_xor(s, 8);
                    if (c16 == 0) SS[wid * 64 + 16 * mt + 4 * q + r] = s; }
            __syncthreads();
            if (tid < 64) { float t = 0.f;
#pragma unroll
                for (int w = 0; w < 8; ++w) t += SS[w * 64 + tid];
                RS[tid] = rsqrtf(t * (1.0f / 128.0f) + EPS); }
            __syncthreads();
            const float gn = gnorm[hd * 128 + 16 * wid + c16];
#pragma unroll
            for (int mt = 0; mt < 4; ++mt)
#pragma unroll
                for (int r = 0; r < 4; ++r) { const int i = 16 * mt + 4 * q + r; bf16* rp = P + (rowc + i) * LDP + hd * 128 + 16 * wid + c16; const float bg = bf2f(rp[C_BG]);
                    rp[C_BV] = f2bf(o[mt][r] * RS[i] * gn * bg * sigmoidf_(bg)); }
        }
#pragma unroll
        for (int nt = 0; nt < 4; ++nt) { const float dec = __expf(BL[16 * nt + c16]); f32x4 acc = S[nt] * dec;
#pragma unroll
            for (int kk = 0; kk < 2; ++kk) acc = MFMA16(ldsfrag(lds + GL_VT, 16 * wid + c16, 32 * kk + 8 * q), ldsfrag(lds + GL_KH, 16 * nt + c16, 32 * kk + 8 * q), acc);
            S[nt] = acc; }
        __syncthreads();
    }
    if (!OUT) {
#pragma unroll
        for (int nt = 0; nt < 4; ++nt)
#pragma unroll
            for (int r = 0; r < 4; ++r) GE[(size_t)item * 8192 + (16 * wid + 4 * q + r) * 64 + 16 * nt + c16] = S[nt][r];
        if (part == 0) GD[(size_t)item * 64 + d] = __expf(dtot);
    }
}
#ifndef PH_MASK
#define PH_MASK 0xffff
#endif
__device__ __forceinline__ void cmul_acc(float& hr, float& hi, float ar, float ai, float gr, float gi) { const float nr = ar * hr - ai * hi + gr, ni = ar * hi + ai * hr + gi; hr = nr; hi = ni; }
template <bool OUT>
__device__ __forceinline__ void s5_item(LAS unsigned char* wscr, bf16* P, const bf16* TzT, const bf16* BzT, const bf16* CzT, const float* tab, float* SE, int id, int lane) {
    const int c16 = lane & 15, q = lane >> 4;
    const int b = id >> 9, g = (id >> 4) & 31, seg = id & 15;
    const size_t tok0 = (size_t)b * SEQ + seg * 256;
    bf16x8 uf[8];
#pragma unroll
    for (int kk = 0; kk < 8; ++kk) uf[kk] = *(const bf16x8*)(P + (tok0 + 16 * c16 + 2 * kk + (q >> 1)) * LDP + C_CU + 16 * g + 8 * (q & 1));
    f32x4 G[8];
    const bf16* bz = BzT + (size_t)g * 32768;
#pragma unroll
    for (int nt = 0; nt < 8; ++nt) { f32x4 acc = (f32x4){0.f, 0.f, 0.f, 0.f};
#pragma unroll
        for (int kk = 0; kk < 8; ++kk) acc = MFMA16(uf[kk], *(const bf16x8*)(bz + (size_t)(16 * nt + c16) * 256 + 32 * kk + 8 * q), acc);
        G[nt] = acc; if (nt & 1) __builtin_amdgcn_sched_barrier(0); }
    const float* tg = tab + (size_t)g * 6 * 64;
    float a16r[4], a16i[4], a64r[4], a64i[4];
#pragma unroll
    for (int n4 = 0; n4 < 4; ++n4) { const int p = 16 * n4 + c16; a16r[n4] = tg[0 * 64 + p]; a16i[n4] = tg[1 * 64 + p]; a64r[n4] = tg[2 * 64 + p]; a64i[n4] = tg[3 * 64 + p]; }
    float er[4], ei[4], ir[4], ii[4], cr[4], ci[4];
#pragma unroll
    for (int n4 = 0; n4 < 4; ++n4) { float hr = 0.f, hi = 0.f;
#pragma unroll
        for (int r = 0; r < 4; ++r) cmul_acc(hr, hi, a16r[n4], a16i[n4], G[n4][r], G[n4 + 4][r]);
        er[n4] = hr; ei[n4] = hi; ir[n4] = hr; ii[n4] = hi; }
#pragma unroll
    for (int s = 1; s < 4; ++s)
#pragma unroll
        for (int n4 = 0; n4 < 4; ++n4) { const float vr = __shfl(ir[n4], (lane - 16) & 63), vi = __shfl(ii[n4], (lane - 16) & 63);
            if (q == s) { ir[n4] = a64r[n4] * vr - a64i[n4] * vi + er[n4]; ii[n4] = a64r[n4] * vi + a64i[n4] * vr + ei[n4]; } }
#pragma unroll
    for (int n4 = 0; n4 < 4; ++n4) { const float vr = __shfl(ir[n4], (lane - 16) & 63), vi = __shfl(ii[n4], (lane - 16) & 63); cr[n4] = (q > 0) ? vr : 0.f; ci[n4] = (q > 0) ? vi : 0.f; }
    if (!OUT) {
        if (q == 3) {
#pragma unroll
            for (int n4 = 0; n4 < 4; ++n4) { SE[(size_t)id * 128 + 16 * n4 + c16] = ir[n4]; SE[(size_t)id * 128 + 64 + 16 * n4 + c16] = ii[n4]; } }
        return;
    }
    float hinr[4] = {0.f, 0.f, 0.f, 0.f}, hini[4] = {0.f, 0.f, 0.f, 0.f};
    { float a256r[4], a256i[4];
#pragma unroll
      for (int n4 = 0; n4 < 4; ++n4) { const int p = 16 * n4 + c16; a256r[n4] = tg[4 * 64 + p]; a256i[n4] = tg[5 * 64 + p]; }
#pragma unroll 1
      for (int sp = 0; sp < seg; ++sp) { const float* e = SE + (size_t)(id - seg + sp) * 128;
#pragma unroll
          for (int n4 = 0; n4 < 4; ++n4) cmul_acc(hinr[n4], hini[n4], a256r[n4], a256i[n4], e[16 * n4 + c16], e[64 + 16 * n4 + c16]); } }
    LAS bf16* Hs = (LAS bf16*)wscr;
#pragma unroll
    for (int n4 = 0; n4 < 4; ++n4) {
        float pr = 1.f, pi = 0.f;
#pragma unroll
        for (int i = 0; i < 3; ++i) if (i < q) { const float nr = pr * a64r[n4] - pi * a64i[n4], ni = pr * a64i[n4] + pi * a64r[n4]; pr = nr; pi = ni; }
        float hr = pr * hinr[n4] - pi * hini[n4] + cr[n4], hi = pr * hini[n4] + pi * hinr[n4] + ci[n4];
#pragma unroll
        for (int r = 0; r < 4; ++r) { Hs[(4 * q + r) * 136 + 16 * n4 + c16] = f2bf(hr); Hs[(4 * q + r) * 136 + 64 + 16 * n4 + c16] = f2bf(hi);
            cmul_acc(hr, hi, a16r[n4], a16i[n4], G[n4][r], G[n4 + 4][r]); } }
    bf16x8 hf[4];
#pragma unroll
    for (int kk = 0; kk < 4; ++kk) hf[kk] = *(const LAS bf16x8*)(wscr + (c16 * 136 + 32 * kk + 8 * q) * 2);
    const bf16* tz = TzT + (size_t)g * 65536; const bf16* cz = CzT + (size_t)g * 32768;
#pragma unroll
    for (int nt = 0; nt < 16; ++nt) { f32x4 acc = (f32x4){0.f, 0.f, 0.f, 0.f};
#pragma unroll
        for (int kk = 0; kk < 8; ++kk) if (kk <= (nt >> 1)) acc = MFMA16(uf[kk], *(const bf16x8*)(tz + (size_t)(16 * nt + c16) * 256 + 32 * kk + 8 * q), acc);
#pragma unroll
        for (int kk = 0; kk < 4; ++kk) acc = MFMA16(hf[kk], *(const bf16x8*)(cz + (size_t)(16 * nt + c16) * 128 + 32 * kk + 8 * q), acc);
#pragma unroll
        for (int r = 0; r < 4; ++r) { const float y = acc[r], u2 = 1.5957691216057308f * (y + 0.044715f * y * y * y);
            P[(tok0 + 16 * (4 * q + r) + nt) * LDP + C_CU + 16 * g + c16] = f2bf(y * sigmoidf_(u2)); }
        __builtin_amdgcn_sched_barrier(0); }
}

template <bool SECOND>
__device__ __forceinline__ void mixers_phase(LAS unsigned char* lds, const float* const* in, unsigned char* ws, bf16* P, int l, int vcu, int G, int tid, int wid, int lane) {
    if (!SECOND && (PH_MASK & 0x100)) for (int it = vcu; it < 256; it += G) attn_item(lds, P, in[7] + l * 16, it, tid, wid, lane);
    float* GE = (float*)(ws + WS_GLAE); float* GD = (float*)(ws + WS_GLAD); float* SE = (float*)(ws + WS_S5E);
    const float* balpha = in[9] + l * 256; const float* gnorm = in[10] + l * 512;
    int tid1 = tid; asm volatile("" : "+v"(tid1));
    if (PH_MASK & 0x200) for (int it = vcu; it < 256; it += G) gla_item<SECOND>(lds, P, balpha, gnorm, GE, GD, it, tid1, wid, tid1 & 63);
    const bf16* TzT = (const bf16*)(ws + WS_S5M + (size_t)l * S5M_BYTES + S5M_TZ); const bf16* BzT = (const bf16*)(ws + WS_S5M + (size_t)l * S5M_BYTES + S5M_BZ);
    const bf16* CzT = (const bf16*)(ws + WS_S5M + (size_t)l * S5M_BYTES + S5M_CZ); const float* tab = (const float*)(ws + WS_TAB) + (size_t)l * 32 * 6 * 64;
    int lane2 = lane; asm volatile("" : "+v"(lane2));
    if (PH_MASK & 0x400) for (int id = vcu * NWAVES + wid; id < 2048; id += G * NWAVES) s5_item<SECOND>(lds + wid * 4352, P, TzT, BzT, CzT, tab, SE, id, lane2);
}
#ifndef MK_MULTI
#define MK_MULTI 0
#endif
constexpr int N_PHASES = 2 + 6 * NLAYER;
struct Args { const float* in[22]; float* out; unsigned char* ws; int ph_lo, ph_hi; };
__global__ void __launch_bounds__(NWAVES * 64, 2) hybrid_fwd(Args args_) {
    extern __shared__ __attribute__((aligned(16))) unsigned char lds_raw[];
    const int G = gridDim.x; const int bx = blockIdx.x; const int vcu = (G % 8 == 0) ? (bx % 8) * (G / 8) + bx / 8 : bx;
    XcdBarrier bar;
    { LAS unsigned char* lds0 = (LAS unsigned char*)lds_raw;
      volatile LAS unsigned* MISC = (volatile LAS unsigned*)(lds0 + MISC_OFF);
      for (int u = threadIdx.x; u < (LDS_BYTES - LDSCTL_OFF) / 4; u += NWAVES * 64) ((LAS unsigned*)(lds0 + LDSCTL_OFF))[u] = 0u;
      __syncthreads();
      bar.bar = (unsigned*)(args_.ws + WS_CTL) + CW_BAR; bar.x = 0; bar.st = nullptr;
      if (!MK_MULTI) bar = xcd_barrier_post((unsigned*)(args_.ws + WS_CTL) + CW_BAR, MISC + 8); }
    const int lo = args_.ph_lo, hi = args_.ph_hi;
#define IN(k) (lo <= (k) && (k) < hi)
#if MK_MULTI
#define SEAM(k) do { } while (0)
#else
#define SEAM(k) do { if (IN(k) && IN((k) + 1)) xcd_barrier(bar); } while (0)
#endif
#define PHASE_IDS typedef const Args __attribute__((address_space(4)))* kargp_t; kargp_t ap = (kargp_t)__builtin_amdgcn_kernarg_segment_ptr(); asm volatile("" : "+s"(ap)); const Args& args = *(const Args*)ap; \
        int tid = threadIdx.x; asm volatile("" : "+v"(tid)); const int lane = tid & 63, wid = __builtin_amdgcn_readfirstlane(tid >> 6); (void)lane; (void)wid; \
        LAS unsigned char* lds = (LAS unsigned char*)lds_raw; asm volatile("" : "+s"(lds)); unsigned char* ws = args.ws; \
        bf16* const P = (bf16*)(ws + WS_P); bf16* const H = (bf16*)(ws + WS_H); float* const MOD = (float*)(ws + WS_MOD); (void)P; (void)H; (void)MOD;
#ifndef PH_MASK
#define PH_MASK 0xffff
#endif
    if (IN(0) && (PH_MASK & 1)) { PHASE_IDS p0_prologue(lds, args.in, ws, vcu, G, tid, wid, lane); }
    SEAM(0);
    if (IN(1) && (PH_MASK & 2)) { PHASE_IDS prenorm_phase(args.in[0], args.in[4], MOD, H, vcu, wid, lane); }
    SEAM(1);
#define LAYER(l, base) \
    if (IN(base + 0) && (PH_MASK & 4)) { PHASE_IDS \
        pg8::Gemm g{H, (const bf16*)(ws + WS_WIN + (size_t)l * WIN_BYTES), TOK, LDP, DM, DM}; pg8::StaticOrder S; S.init(TOK, LDP, G, bx); \
        pg8::EpiBf16<0> E{P, LDP, nullptr, 0, 0, 1.f}; \
        pg8::gemm_phase<pg8::EpiBf16<0>, pg8::StaticOrder, true, true>(lds, g, S, E, tid); } \
    SEAM(base + 0); \
    if (IN(base + 1) && (PH_MASK & 8)) { PHASE_IDS mixers_phase<false>(lds, args.in, ws, P, l, vcu, G, tid, wid, lane); } \
    SEAM(base + 1); \
    if (IN(base + 2) && (PH_MASK & 8)) { PHASE_IDS mixers_phase<true>(lds, args.in, ws, P, l, vcu, G, tid, wid, lane); } \
    SEAM(base + 2); \
    if (IN(base + 3) && (PH_MASK & 16)) { PHASE_IDS \
        pg8::Gemm g{P + C_CU, (const bf16*)(ws + WS_WGLU + (size_t)l * WGLU_BYTES), TOK, 512, 512, LDP}; pg8::StaticOrder S; S.init(TOK, 512, G, bx); \
        pg8::EpiGlu E{P, LDP, C_CU, C_CG, args.in[20] + l * 512}; \
        if (PH_MASK & 0x800) pg8::gemm_phase<pg8::EpiGlu, pg8::StaticOrder, true, true>(lds, g, S, E, tid); \
        if (!(PH_MASK & 0x1000)) {} else if (G == 256) { if (bx >= 128) { attn_item(lds, P, args.in[7] + l * 16, 256 + 2 * (bx - 128), tid, wid, lane); attn_item(lds, P, args.in[7] + l * 16, 257 + 2 * (bx - 128), tid, wid, lane); } } \
        else for (int it = 256 + vcu; it < 512; it += G) attn_item(lds, P, args.in[7] + l * 16, it, tid, wid, lane); } \
    SEAM(base + 3); \
    if (IN(base + 4) && (PH_MASK & 32)) { PHASE_IDS \
        pg8::Gemm g{P, (const bf16*)(ws + WS_WOUT + (size_t)l * WOUT_BYTES), TOK, DM, 2048, LDP}; pg8::StaticOrder S; S.init(TOK, DM, G, bx); \
        pg8::EpiBf16<0> E{H, DM, nullptr, 0, 0, 1.f}; \
        pg8::gemm_phase<pg8::EpiBf16<0>, pg8::StaticOrder, true, true>(lds, g, S, E, tid); } \
    SEAM(base + 4); \
    if (IN(base + 5) && (PH_MASK & 64)) { PHASE_IDS \
        post_phase(l == 0 ? args.in[0] : args.out, args.out, H, args.in[5] + l * DM, MOD + (size_t)l * 4 * 3072, (l + 1 < NLAYER), args.in[4] + (l + 1 < NLAYER ? l + 1 : l) * DM, MOD + (size_t)(l + 1 < NLAYER ? l + 1 : l) * 4 * 3072, H, vcu, wid, lane); } \
    SEAM(base + 5);
    LAYER(0, 2)
    LAYER(1, 8)
#undef LAYER
#undef IN
#undef SEAM
}

extern "C" void kernel_launch(void* const* d_in, const int* in_sizes, int n_in, void* d_out, int out_size, void* d_ws, size_t ws_size, hipStream_t stream) {
    static int grid = 0;
    if (grid == 0) {
        if (n_in != 22 || in_sizes[0] != TOK * DM || out_size != TOK * DM || ws_size < WS_END) { fprintf(stderr, "kernel_launch: unexpected shapes (n_in %d, in0 %d, out %d, ws %zu)\n", n_in, n_in > 0 ? in_sizes[0] : -1, out_size, ws_size); grid = -1; return; }
        int dev = 0, cus = 0;
        if (hipGetDevice(&dev) != hipSuccess || hipDeviceGetAttribute(&cus, hipDeviceAttributeMultiprocessorCount, dev) != hipSuccess) { grid = -1; return; }
        if (hipFuncSetAttribute((const void*)hybrid_fwd, hipFuncAttributeMaxDynamicSharedMemorySize, LDS_BYTES) != hipSuccess) { fprintf(stderr, "kernel_launch: hipFuncSetAttribute failed\n"); grid = -1; return; }
        (void)hipGetLastError();
        grid = cus;
    }
    if (grid < 0) return;
    if (hipMemsetAsync((char*)d_ws + WS_CTL, 0, CTL_ZERO_BYTES, stream) != hipSuccess) { fprintf(stderr, "kernel_launch: memset failed\n"); return; }
    Args a{};
    for (int i = 0; i < 22; ++i) a.in[i] = (const float*)d_in[i];
    a.out = (float*)d_out; a.ws = (unsigned char*)d_ws;
#if MK_MULTI
    for (int ph = 0; ph < N_PHASES; ++ph) { a.ph_lo = ph; a.ph_hi = ph + 1; hipLaunchKernelGGL(hybrid_fwd, dim3(grid), dim3(NWAVES * 64), LDS_BYTES, stream, a); }
#else
    a.ph_lo = 0; a.ph_hi = N_PHASES;
    hipLaunchKernelGGL(hybrid_fwd, dim3(grid), dim3(NWAVES * 64), LDS_BYTES, stream, a);
#endif
    const hipError_t le = hipPeekAtLastError();
    if (le != hipSuccess) fprintf(stderr, "kernel_launch: launch failed: %s\n", hipGetErrorName(le));
}
```

```cpp
#include <hip/hip_runtime.h>
#include <cstdio>
#include <cstdint>
#include <cmath>
#define MK_MULTI 0
namespace pg8 {
#define PG8_LAS __attribute__((address_space(3)))
typedef unsigned short bf16_t;
typedef short bf16x8 __attribute__((ext_vector_type(8)));
typedef float f32x4 __attribute__((ext_vector_type(4)));
typedef unsigned u32x4 __attribute__((ext_vector_type(4)));
constexpr int BM = 256, BK = 64, HALF = 128, HTB = HALF * BK * 2  , STAGE_BYTES = 8 * HTB, NXCD = 8, WGM = 8;

__host__ __device__ __forceinline__ int lds_byte(int r, int c) { const int st = (r >> 4) * 2 + (c >> 5), rr = r & 15, cc = c & 31, ob = rr * 64 + cc * 2; return st * 1024 + (ob ^ (((ob >> 9) & 1) << 5)); }
__host__ __device__ __forceinline__ void stage_rc(int b, int& R, int& C) { const int st = b / 1024, sb = b % 1024, swz = sb ^ (((sb >> 9) & 1) << 5); R = (st >> 1) * 16 + swz / 64; C = (st & 1) * 32 + (swz % 64) / 2; }
__host__ __device__ __forceinline__ int perm32(int rho) { const int n = rho >> 4, i = rho & 15; return 8 * (i >> 2) + 4 * n + (i & 3); }

struct Unit { int pm, pn; };
struct Gemm { const bf16_t* A; const bf16_t* Bt; int M, N, K, lda; };

struct StaticOrder {
    int nM, nN, nwg, G, c;
    __host__ __device__ void init(int M, int N, int G_, int c_) { nM = M / BM; nN = N / BM; nwg = nM * nN; G = G_; c = c_; }
    __host__ __device__ bool next(int i, Unit& u) const {
        const long L = (long)i * G + c; if (L >= nwg) return false;
        int wgid = (int)L; { const int q = nwg / NXCD, r = nwg % NXCD, xcd = wgid % NXCD, off = wgid / NXCD; wgid = (xcd < r ? xcd * (q + 1) : r * (q + 1) + (xcd - r) * q) + off; }
        const int nig = WGM * nN, gid = wgid / nig, fm = gid * WGM, gsz = (nM - fm) < WGM ? (nM - fm) : WGM;
        u.pm = fm + ((wgid % nig) % gsz); u.pn = (wgid % nig) / gsz; return true;
    }
    __device__ __forceinline__ void a_ready(const Unit&) const {}
    __device__ __forceinline__ void done(const Unit&) const {}
};

__device__ __forceinline__ unsigned cvt_pk_bf16(float lo, float hi) { unsigned r; asm volatile("v_cvt_pk_bf16_f32 %0, %1, %2" : "=v"(r) : "v"(lo), "v"(hi)); return r; }
typedef float f32x2 __attribute__((ext_vector_type(2)));
__device__ __forceinline__ f32x2 gelu_pk(f32x2 v) {
    const f32x2 av = __builtin_elementwise_abs(v), d = av * 0.2316418882f + 1.0f;
    f32x2 t; t.x = __builtin_amdgcn_rcpf(d.x); t.y = __builtin_amdgcn_rcpf(d.y);
    f32x2 q = t * 0.5307027145f + (-0.7265760135f); q = q * t + 0.7107068705f; q = q * t + (-0.142248368f); q = q * t + 0.127414796f; q = q * t;
    const f32x2 s = (v * v) * (-0.72134752044f);
    f32x2 e; e.x = __builtin_amdgcn_exp2f(s.x); e.y = __builtin_amdgcn_exp2f(s.y);
    const f32x2 m = v * (q * e), r = v - m;
    f32x2 o; o.x = v.x < 0.f ? m.x : r.x; o.y = v.y < 0.f ? m.y : r.y; return o;
}

template <int ACT  > struct EpiBf16 {
    static constexpr bool PERM = true, AFTER_DRAIN = false; static_assert(ACT == 0 || ACT == 1, "EpiBf16: ACT is 0 (none) or 1 (gelu_pk)");
    bf16_t* O; int ldc; const float* bias; int split_cols; size_t split_stride; float scale0;
    __device__ __forceinline__ void operator()(const f32x4 (&acc)[2][2][4][2], const Unit& u, int wr, int wc, int fr, int fq) const {
        const int row0 = u.pm * BM + wr * 64 + fr; int colt = u.pn * BM; bf16_t* base = O;
        float sc = 1.f; if (split_cols) { const int t = colt / split_cols; base += (size_t)t * split_stride; colt -= t * split_cols; if (t == 0) sc = scale0; }
        const int col0 = colt + wc * 32 + 8 * fq, bcol0 = u.pn * BM + wc * 32 + 8 * fq;
        f32x4 bv[2][2];
#pragma unroll
        for (int bj = 0; bj < 2; ++bj)
#pragma unroll
            for (int n = 0; n < 2; ++n) bv[bj][n] = bias ? *(const f32x4*)(bias + bcol0 + bj * HALF + 4 * n) : (f32x4){0.f, 0.f, 0.f, 0.f};
#pragma unroll
        for (int ai = 0; ai < 2; ++ai)
#pragma unroll
            for (int m = 0; m < 4; ++m) { bf16_t* rowp = base + (size_t)(row0 + ai * HALF + m * 16) * ldc + col0;
#pragma unroll
                for (int bj = 0; bj < 2; ++bj) { f32x4 v0 = acc[ai][bj][m][0] + bv[bj][0], v1 = acc[ai][bj][m][1] + bv[bj][1];
                    if (ACT == 1) { f32x2 a = gelu_pk((f32x2){v0[0], v0[1]}), b = gelu_pk((f32x2){v0[2], v0[3]}), c = gelu_pk((f32x2){v1[0], v1[1]}), d = gelu_pk((f32x2){v1[2], v1[3]});
                        v0 = (f32x4){a.x, a.y, b.x, b.y}; v1 = (f32x4){c.x, c.y, d.x, d.y}; }
                    v0 = v0 * sc; v1 = v1 * sc; u32x4 w; w.x = cvt_pk_bf16(v0[0], v0[1]); w.y = cvt_pk_bf16(v0[2], v0[3]); w.z = cvt_pk_bf16(v1[0], v1[1]); w.w = cvt_pk_bf16(v1[2], v1[3]);
                    *(u32x4*)(rowp + bj * HALF) = w; } }
    }
};
struct EpiGlu {
    static constexpr bool PERM = true, AFTER_DRAIN = false;
    bf16_t* P; int ldp, col_y, col_g; const float* bglu;
    __device__ __forceinline__ void operator()(const f32x4 (&acc)[2][2][4][2], const Unit& u, int wr, int wc, int fr, int fq) const {
        const int row0 = u.pm * BM + wr * 64 + fr; const int col0 = u.pn * BM + wc * 32 + 8 * fq;
#pragma unroll
        for (int ai = 0; ai < 2; ++ai)
#pragma unroll
            for (int m = 0; m < 4; ++m) { bf16_t* rowp = P + (size_t)(row0 + ai * HALF + m * 16) * ldp;
#pragma unroll
                for (int bj = 0; bj < 2; ++bj) { const int col = col0 + bj * HALF;
                    const f32x4 b0 = *(const f32x4*)(bglu + col), b1 = *(const f32x4*)(bglu + col + 4);
                    const u32x4 yv = *(const u32x4*)(rowp + col_y + col), gv = *(const u32x4*)(rowp + col_g + col);
                    const f32x4 z0 = acc[ai][bj][m][0] + b0, z1 = acc[ai][bj][m][1] + b1;
                    float z[8] = {z0[0], z0[1], z0[2], z0[3], z1[0], z1[1], z1[2], z1[3]}; float o[8];
#pragma unroll
                    for (int e = 0; e < 8; ++e) { const unsigned yw = yv[e >> 1], gw = gv[e >> 1];
                        const float y = __uint_as_float((e & 1) ? (yw & 0xffff0000u) : (yw << 16)), g = __uint_as_float((e & 1) ? (gw & 0xffff0000u) : (gw << 16));
                        const float sz = __builtin_amdgcn_rcpf(1.0f + __expf(-z[e])), sg = __builtin_amdgcn_rcpf(1.0f + __expf(-g));
                        o[e] = y * sz * g * sg; }
                    u32x4 w; w.x = cvt_pk_bf16(o[0], o[1]); w.y = cvt_pk_bf16(o[2], o[3]); w.z = cvt_pk_bf16(o[4], o[5]); w.w = cvt_pk_bf16(o[6], o[7]);
                    *(u32x4*)(rowp + col_g + col) = w; } }
    }
};
template <class Epi, class Sched, bool ALIGN_EPI = false, bool SP2 = false>
__device__ __forceinline__ void gemm_phase(PG8_LAS unsigned char* lds, const Gemm g, const Sched& S, const Epi& E, int tid_in) {
    const int tid = tid_in, wid = __builtin_amdgcn_readfirstlane(tid >> 6), lane = tid & 63, wr = wid >> 2, wc = wid & 3, fr = lane & 15, fq = lane >> 4;
    const int K = g.K, nt = K / BK;
    unsigned voffA[2], voffB[2];
#pragma unroll
    for (int i = 0; i < 2; ++i) { int R, C; stage_rc(tid * 16 + i * 8192, R, C); const int Rb = Epi::PERM ? ((R & ~31) + perm32(R & 31)) : R;
        voffA[i] = (unsigned)(R * g.lda + C) * 2u; voffB[i] = (unsigned)(Rb * K + C) * 2u; }
    const size_t kstep = (size_t)(BK * 2);
    const size_t hstepB = (size_t)HALF * K * 2, hstepA = (size_t)HALF * g.lda * 2;
    const size_t tstepB = 2 * hstepB, tstepA = 2 * hstepA;
    const unsigned ldsw = (unsigned)wid * 1024u;
    const int aoff = lds_byte(wr * 64 + fr, fq * 8), boff = lds_byte(wc * 32 + fr, fq * 8);
#define PG8_SA(b, h) (((b) * 2 + (h)) * HTB)
#define PG8_SB(b, h) ((4 + (b) * 2 + (h)) * HTB)
#define PG8_STAGE(bufoff, gbase, voff) do { _Pragma("unroll") for (int _i = 0; _i < 2; ++_i) \
        __builtin_amdgcn_global_load_lds((const unsigned*)((const char*)(gbase) + (voff)[_i]), (PG8_LAS unsigned*)(lds + (bufoff) + ldsw + _i * 8192), 16, 0, 0); } while (0)
#define PG8_LDA(dst, b, h) do { _Pragma("unroll") for (int m = 0; m < 4; ++m) _Pragma("unroll") for (int k = 0; k < 2; ++k) dst[m][k] = *(const PG8_LAS bf16x8*)(lds + PG8_SA(b, h) + aoff + m * 2048 + k * 1024); } while (0)
#define PG8_LDB(dst, b, h) do { _Pragma("unroll") for (int n = 0; n < 2; ++n) _Pragma("unroll") for (int k = 0; k < 2; ++k) dst[n][k] = *(const PG8_LAS bf16x8*)(lds + PG8_SB(b, h) + boff + n * 2048 + k * 1024); } while (0)
#define PG8_MMA(ai, bj, At, Bt) do { __builtin_amdgcn_s_setprio(1); _Pragma("unroll") for (int m = 0; m < 4; ++m) _Pragma("unroll") for (int n = 0; n < 2; ++n) _Pragma("unroll") for (int k = 0; k < 2; ++k) \
        acc[ai][bj][m][n] = __builtin_amdgcn_mfma_f32_16x16x32_bf16(Bt[n][k], At[m][k], acc[ai][bj][m][n], 0, 0, 0); __builtin_amdgcn_s_setprio(0); } while (0)
#define PG8_WAIT_V(n) asm volatile("s_waitcnt vmcnt(" #n ")" ::: "memory")
#define PG8_WAIT_L(n) asm volatile("s_waitcnt lgkmcnt(" #n ")" ::: "memory")
#define PG8_BAR __builtin_amdgcn_s_barrier()
#define PG8_SCHED __builtin_amdgcn_sched_barrier(0)
    Unit cur, nxt; int ui = 0;
    if (!S.next(0, cur)) return;
    f32x4 acc[2][2][4][2];
#pragma unroll
    for (int a = 0; a < 2; ++a)
#pragma unroll
        for (int b = 0; b < 2; ++b)
#pragma unroll
            for (int m = 0; m < 4; ++m)
#pragma unroll
                for (int n = 0; n < 2; ++n) acc[a][b][m][n] = (f32x4){0.f, 0.f, 0.f, 0.f};
    bf16x8 At[4][2], B0[2][2], B1[2][2];
    const char* cA = (const char*)g.A + (size_t)cur.pm * tstepA; const char* cB = (const char*)g.Bt + (size_t)cur.pn * tstepB;
    S.a_ready(cur);
    if constexpr (SP2) {
        PG8_STAGE(PG8_SB(0, 0), cB, voffB); PG8_STAGE(PG8_SB(0, 1), cB + hstepB, voffB); PG8_STAGE(PG8_SA(0, 0), cA, voffA); PG8_STAGE(PG8_SA(0, 1), cA + hstepA, voffA);
        if (wr == 1) PG8_BAR;
        PG8_WAIT_V(2); PG8_BAR;
        PG8_STAGE(PG8_SB(1, 0), cB + kstep, voffB); PG8_STAGE(PG8_SA(1, 0), cA + kstep, voffA); PG8_STAGE(PG8_SB(1, 1), cB + hstepB + kstep, voffB);
        PG8_WAIT_V(6); PG8_BAR;
    } else {
        PG8_STAGE(PG8_SB(0, 0), cB, voffB); PG8_STAGE(PG8_SA(0, 0), cA, voffA); PG8_STAGE(PG8_SB(0, 1), cB + hstepB, voffB); PG8_STAGE(PG8_SA(0, 1), cA + hstepA, voffA);
        if (wr == 1) PG8_BAR;
        PG8_WAIT_V(4); PG8_BAR;
        PG8_STAGE(PG8_SB(1, 0), cB + kstep, voffB); PG8_STAGE(PG8_SA(1, 0), cA + kstep, voffA); PG8_STAGE(PG8_SB(1, 1), cB + hstepB + kstep, voffB);
        PG8_WAIT_V(6); PG8_BAR;
    }
    for (;;) {
        const bool has_next = S.next(ui + 1, nxt);
        const char* nA = has_next ? (const char*)g.A + (size_t)nxt.pm * tstepA : cA; const char* nB = has_next ? (const char*)g.Bt + (size_t)nxt.pn * tstepB : cB;
        for (int t = 0; t < nt; t += 2) {
            const bool last = (t == nt - 2);
            const char* a1 = cA + (size_t)(t + 1) * kstep;
            const char* a2 = last ? nA : cA + (size_t)(t + 2) * kstep; const char* b2 = last ? nB : cB + (size_t)(t + 2) * kstep;
            const char* a3 = a2 + kstep; const char* b3 = b2 + kstep;
            if (last && has_next) S.a_ready(nxt);
            if constexpr (SP2) {
            PG8_LDB(B0, 0, 0); PG8_LDB(B1, 0, 1); PG8_SCHED; PG8_LDA(At, 0, 0); PG8_STAGE(PG8_SA(1, 1), a1 + hstepA, voffA);
            PG8_WAIT_V(8); PG8_WAIT_L(0); PG8_BAR; PG8_MMA(0, 0, At, B0); PG8_MMA(0, 1, At, B1); PG8_BAR; PG8_SCHED;
            PG8_LDA(At, 0, 1); PG8_STAGE(PG8_SB(0, 0), b2, voffB); PG8_STAGE(PG8_SB(0, 1), b2 + hstepB, voffB); PG8_STAGE(PG8_SA(0, 0), a2, voffA);
            PG8_WAIT_V(8); PG8_WAIT_L(0); PG8_BAR; PG8_MMA(1, 0, At, B0); PG8_MMA(1, 1, At, B1); PG8_BAR; PG8_SCHED;
            PG8_LDB(B0, 1, 0); PG8_LDB(B1, 1, 1); PG8_SCHED; PG8_LDA(At, 1, 0); PG8_STAGE(PG8_SA(0, 1), a2 + hstepA, voffA);
            PG8_WAIT_V(8); PG8_WAIT_L(0); PG8_BAR; PG8_MMA(0, 0, At, B0); PG8_MMA(0, 1, At, B1); PG8_BAR; PG8_SCHED;
            PG8_LDA(At, 1, 1); PG8_STAGE(PG8_SB(1, 0), b3, voffB); PG8_STAGE(PG8_SB(1, 1), b3 + hstepB, voffB); PG8_STAGE(PG8_SA(1, 0), a3, voffA);
            PG8_WAIT_V(8); PG8_WAIT_L(0); PG8_BAR; PG8_MMA(1, 0, At, B0); PG8_MMA(1, 1, At, B1); PG8_BAR; PG8_SCHED;
            } else {
            PG8_LDB(B0, 0, 0); PG8_SCHED; PG8_LDA(At, 0, 0); PG8_STAGE(PG8_SA(1, 1), a1 + hstepA, voffA);
            PG8_WAIT_L(8); PG8_BAR; PG8_WAIT_L(0); PG8_MMA(0, 0, At, B0); PG8_BAR; PG8_SCHED;
            PG8_LDB(B1, 0, 1); PG8_STAGE(PG8_SB(0, 0), b2, voffB);
            PG8_BAR; PG8_WAIT_L(0); PG8_MMA(0, 1, At, B1); PG8_BAR;
            PG8_LDA(At, 0, 1); PG8_STAGE(PG8_SA(0, 0), a2, voffA);
            PG8_BAR; PG8_WAIT_L(0); PG8_MMA(1, 0, At, B0); PG8_BAR; PG8_SCHED;
            PG8_STAGE(PG8_SB(0, 1), b2 + hstepB, voffB);
            PG8_WAIT_V(6); PG8_BAR; PG8_MMA(1, 1, At, B1); PG8_BAR;
            PG8_LDB(B0, 1, 0); PG8_SCHED; PG8_LDA(At, 1, 0); PG8_STAGE(PG8_SA(0, 1), a2 + hstepA, voffA);
            PG8_WAIT_L(8); PG8_BAR; PG8_WAIT_L(0); PG8_MMA(0, 0, At, B0); PG8_BAR; PG8_SCHED;
            PG8_LDB(B1, 1, 1); PG8_STAGE(PG8_SB(1, 0), b3, voffB);
            PG8_BAR; PG8_WAIT_L(0); PG8_MMA(0, 1, At, B1); PG8_BAR;
            PG8_LDA(At, 1, 1); PG8_STAGE(PG8_SA(1, 0), a3, voffA);
            PG8_BAR; PG8_WAIT_L(0); PG8_MMA(1, 0, At, B0); PG8_BAR; PG8_SCHED;
            PG8_STAGE(PG8_SB(1, 1), b3 + hstepB, voffB);
            PG8_WAIT_V(6); PG8_BAR; PG8_MMA(1, 1, At, B1); PG8_BAR;
            }
        }
        if constexpr (ALIGN_EPI) { if (wr == 0) PG8_BAR; }
        if constexpr (!Epi::AFTER_DRAIN) { E(acc, cur, wr, wc, fr, fq); S.done(cur); }
        if (!has_next) break;
#pragma unroll
        for (int a = 0; a < 2; ++a)
#pragma unroll
            for (int b = 0; b < 2; ++b)
#pragma unroll
                for (int m = 0; m < 4; ++m)
#pragma unroll
                    for (int n = 0; n < 2; ++n) acc[a][b][m][n] = (f32x4){0.f, 0.f, 0.f, 0.f};
        cur = nxt; cA = nA; cB = nB; ++ui;
        if constexpr (ALIGN_EPI) { if (wr == 1) PG8_BAR; }
    }
    PG8_WAIT_V(0);
    if constexpr (!ALIGN_EPI) { if (wr == 0) PG8_BAR; }
    PG8_BAR;
    if constexpr (Epi::AFTER_DRAIN) { E.fused(acc, cur, wr, wc, fr, fq, lds, wid, lane); S.done(cur); }
#undef PG8_SA
#undef PG8_SB
#undef PG8_STAGE
#undef PG8_LDA
#undef PG8_LDB
#undef PG8_MMA
#undef PG8_WAIT_V
#undef PG8_WAIT_L
#undef PG8_BAR
#undef PG8_SCHED
}
}
#define GAS __attribute__((address_space(1)))
#define LAS __attribute__((address_space(3)))
typedef unsigned short bf16;
typedef short bf16x8 __attribute__((ext_vector_type(8)));
typedef float f32x4 __attribute__((ext_vector_type(4)));
typedef float f32x16 __attribute__((ext_vector_type(16)));
typedef unsigned u32x4 __attribute__((ext_vector_type(4)));
typedef unsigned u32x2 __attribute__((ext_vector_type(2)));
typedef short s16x4 __attribute__((ext_vector_type(4)));
typedef GAS unsigned gu32;
constexpr int NWAVES = 8;
constexpr int NBATCH = 4, SEQ = 4096, DM = 1024, TOK = NBATCH * SEQ, NLAYER = 2;
constexpr int LDP = 5376, WIN_COLS = 5136;
constexpr int C_AQ = 0, C_BV = 1024, C_CG = 1536, C_AK = 2048, C_AV = 2304, C_AG = 2560, C_BQ = 3584, C_BK = 3840, C_GL = 4096, C_BG = 4352, C_CU = 4864;
constexpr float EPS = 1e-6f, LOG2E = 1.4426950408889634f;
constexpr size_t MiB = 1u << 20;
constexpr size_t WS_CTL = 0, CTL_ZERO_BYTES = 64 * 1024;
constexpr int CW_BAR = 1024;
constexpr size_t WS_MOD = 1 * MiB;
constexpr size_t WS_TAB = 1 * MiB + 256 * 1024;
constexpr size_t WS_WIN = 2 * MiB, WIN_BYTES = (size_t)LDP * DM * 2;
constexpr size_t WS_WOUT = 23 * MiB, WOUT_BYTES = (size_t)DM * 2048 * 2;
constexpr size_t WS_WGLU = 31 * MiB, WGLU_BYTES = (size_t)512 * 512 * 2;
constexpr size_t WS_S5M = 32 * MiB, S5M_BYTES = 8 * MiB;
constexpr size_t S5M_TZ = 0, S5M_BZ = 4 * MiB, S5M_CZ = 6 * MiB;
constexpr size_t WS_H = 48 * MiB;
constexpr size_t WS_GLAE = 48 * MiB;
constexpr size_t WS_GLAD = 56 * MiB;
constexpr size_t WS_S5E = 57 * MiB;
constexpr size_t WS_P = 80 * MiB;
constexpr size_t WS_END = 248 * MiB;
static_assert(WS_WIN + 2 * WIN_BYTES <= WS_WOUT && WS_WOUT + 2 * WOUT_BYTES <= WS_WGLU && WS_WGLU + 2 * WGLU_BYTES <= WS_S5M && WS_S5M + 2 * S5M_BYTES <= WS_H, "ws map");
static_assert(WS_H + (size_t)TOK * DM * 2 <= WS_P && WS_P + (size_t)TOK * LDP * 2 <= WS_END && WS_S5E + 2048 * 128 * 4 <= WS_P, "ws map 2");
constexpr int RING_BYTES = 143360, LDSCTL_OFF = RING_BYTES, MISC_OFF = LDSCTL_OFF + 320, LDS_BYTES = 147456;

#define RLX_AGENT __ATOMIC_RELAXED, __HIP_MEMORY_SCOPE_AGENT
#define LDS_WAIT() asm volatile("s_waitcnt lgkmcnt(0)" ::: "memory")
typedef float f32x2_t __attribute__((ext_vector_type(2))); typedef __bf16 bf16x2_t __attribute__((ext_vector_type(2)));
__device__ __forceinline__ unsigned pk2(float lo, float hi) { f32x2_t v = {lo, hi}; bf16x2_t b = __builtin_convertvector(v, bf16x2_t); return __builtin_bit_cast(unsigned, b); }
__device__ __forceinline__ bf16 f2bf(float f) { return (bf16)(pk2(f, 0.f) & 0xffffu); }
__device__ __forceinline__ float bf2f(bf16 b) { return __uint_as_float((unsigned)b << 16); }
__device__ __forceinline__ float bflo(unsigned w) { return __uint_as_float(w << 16); }
__device__ __forceinline__ float bfhi(unsigned w) { return __uint_as_float(w & 0xffff0000u); }
__device__ __forceinline__ float sigmoidf_(float x) { return __builtin_amdgcn_rcpf(1.0f + __expf(-x)); }
__device__ __forceinline__ float wave_sum(float v) {
#pragma unroll
    for (int o = 1; o < 64; o <<= 1) v += __shfl_xor(v, o);
    return v;
}
#define MFMA16(a, b, c) __builtin_amdgcn_mfma_f32_16x16x32_bf16((a), (b), (c), 0, 0, 0)
#define MFMA32(a, b, c) __builtin_amdgcn_mfma_f32_32x32x16_bf16((a), (b), (c), 0, 0, 0)
#define XB_TMO      128
#define XB_XCNT(j)  (256  + 64 * (j))
#define XB_XSUB(j)  (1280 + 64 * (j))
#define XB_XGEN(j)  (2304 + 64 * (j))
#define XB_TOP      3328
#define XB_TOPGEN   3392
#define XCD_BAR_WORDS 3456
#define XB_SPIN_CAP (1u << 18)

__device__ __forceinline__ unsigned xb_ld(unsigned* p)              { return __hip_atomic_load(p, __ATOMIC_RELAXED, __HIP_MEMORY_SCOPE_AGENT); }
__device__ __forceinline__ unsigned xb_add(unsigned* p, unsigned v) { return __hip_atomic_fetch_add(p, v, __ATOMIC_RELAXED, __HIP_MEMORY_SCOPE_AGENT); }
__device__ __forceinline__ unsigned xb_xcc_id() { return (unsigned)__builtin_amdgcn_s_getreg((3 << 11) | 20) & 0xFu; }
#define XB_SPIN(cond, bar) do { unsigned _sp = 0; while (cond) { __builtin_amdgcn_s_sleep(1); \
    if ((++_sp & 255u) == 0u) { if (xb_ld(&(bar)[XB_TMO])) break; if (_sp > XB_SPIN_CAP) { atomicAdd(&(bar)[XB_TMO], 1u); break; } } } } while (0)

struct XcdBarrier {
    unsigned* bar; unsigned x;
    volatile LAS unsigned* st;
};

__device__ __forceinline__ XcdBarrier xcd_barrier_post(unsigned* bar, volatile LAS unsigned* st) {
    XcdBarrier b; b.bar = bar; b.x = xb_xcc_id(); b.st = st;
    if (threadIdx.x == 0) (void)xb_add(&bar[XB_XCNT(b.x)], 1u);
    return b;
}
__device__ __forceinline__ void xcd_barrier_complete(unsigned* bar, unsigned x, unsigned& nloc, unsigned& nx) {
    const unsigned G = gridDim.x * gridDim.y * gridDim.z;
    unsigned sum, cnt, mine, sp = 0u;
    for (;;) {
        sum = 0u; cnt = 0u; mine = 0u;
#pragma unroll
        for (unsigned j = 0; j < 16; ++j) { const unsigned c = xb_ld(&bar[XB_XCNT(j)]); sum += c; cnt += (c > 0u) ? 1u : 0u; mine = (j == x) ? c : mine; }
        if (sum == G) break;
        __builtin_amdgcn_s_sleep(1);
        if ((++sp & 255u) == 0u) { if (xb_ld(&bar[XB_TMO])) break; if (sp > XB_SPIN_CAP) { atomicAdd(&bar[XB_TMO], 1u); break; } }
    }
    nloc = mine > 0u ? mine : 1u; nx = cnt > 0u ? cnt : 1u;
}

__device__ __forceinline__ void xcd_barrier(const XcdBarrier& b) {
    asm volatile("s_waitcnt vmcnt(0)" ::: "memory");
    __syncthreads();
    if (threadIdx.x == 0) {
        unsigned* bar = b.bar;
        __builtin_amdgcn_s_waitcnt(0);
        unsigned nloc = b.st[0], nx = b.st[1];
        if (nloc == 0u) { xcd_barrier_complete(bar, b.x, nloc, nx); b.st[0] = nloc; b.st[1] = nx; }
        const unsigned old = xb_add(&bar[XB_XSUB(b.x)], 1u);
        const unsigned gen = old / nloc;
        if (old + 1u == (gen + 1u) * nloc) {
            __builtin_amdgcn_fence(__ATOMIC_RELEASE, "agent");
            asm volatile("s_waitcnt vmcnt(0)" ::: "memory");
            const unsigned og = xb_add(&bar[XB_TOP], 1u);
            const unsigned tg = og / nx;
            if (og + 1u == (tg + 1u) * nx) xb_add(&bar[XB_TOPGEN], 1u);
            else XB_SPIN(xb_ld(&bar[XB_TOPGEN]) == tg, bar);
            __builtin_amdgcn_fence(__ATOMIC_ACQUIRE, "agent");
            xb_add(&bar[XB_XGEN(b.x)], 1u);
            asm volatile("s_waitcnt vmcnt(0)" ::: "memory");
        } else {
            XB_SPIN(xb_ld(&bar[XB_XGEN(b.x)]) == gen, bar);
            __builtin_amdgcn_fence(__ATOMIC_ACQUIRE, "agent");
            asm volatile("s_waitcnt vmcnt(0)" ::: "memory");
        }
    }
    __syncthreads();
}
__device__ __forceinline__ int win_srccol(int n0) {
    if (n0 < 1024) return n0;
    if (n0 < 1536) return 3072 + (n0 - 1024);
    if (n0 < 2048) return 4624 + (n0 - 1536);
    if (n0 < 2304) return 1024 + (n0 - 2048);
    if (n0 < 2560) return 1280 + (n0 - 2304);
    if (n0 < 3584) return 1536 + (n0 - 2560);
    if (n0 < 3840) return 2560 + (n0 - 3584);
    if (n0 < 4096) return 2816 + (n0 - 3840);
    if (n0 < 4352) return -1;
    if (n0 < 4864) return 3600 + (n0 - 4352);
    return 4112 + (n0 - 4864);
}
__device__ __forceinline__ void transpose_item(const float* W, int ldw, int srccol, bf16* WT, int K, int dstrow, LAS float* scr, int k0, int lane,
                                               const float* walpha  ) {
    if (walpha == nullptr) {
        const int kr = lane >> 3, c4 = lane & 7; f32x4 v[8];
#pragma unroll
        for (int i = 0; i < 8; ++i) v[i] = *(const f32x4*)(W + (size_t)(k0 + 8 * i + kr) * ldw + srccol + 4 * c4);
#pragma unroll
        for (int i = 0; i < 8; ++i) { LAS float* d = scr + (8 * i + kr) * 33 + 4 * c4; d[0] = v[i][0]; d[1] = v[i][1]; d[2] = v[i][2]; d[3] = v[i][3]; }
    } else {
        float wa[16];
#pragma unroll
        for (int r = 0; r < 16; ++r) wa[r] = walpha[r * 256 + srccol + (lane & 31)];
#pragma unroll 4
        for (int i = 0; i < 32; ++i) { const int kk = 2 * i + (lane >> 5); const f32x4* wr = (const f32x4*)(W + (size_t)(k0 + kk) * ldw + 3584);
            const f32x4 w0 = wr[0], w1 = wr[1], w2 = wr[2], w3 = wr[3];
            float s = (w0[0] * wa[0] + w0[1] * wa[1]) + (w0[2] * wa[2] + w0[3] * wa[3]); s += (w1[0] * wa[4] + w1[1] * wa[5]) + (w1[2] * wa[6] + w1[3] * wa[7]);
            s += (w2[0] * wa[8] + w2[1] * wa[9]) + (w2[2] * wa[10] + w2[3] * wa[11]); s += (w3[0] * wa[12] + w3[1] * wa[13]) + (w3[2] * wa[14] + w3[3] * wa[15]);
            scr[kk * 33 + (lane & 31)] = s; }
    }
    LDS_WAIT(); asm volatile("" ::: "memory");
    const int c = lane & 7;
#pragma unroll
    for (int j = 0; j < 4; ++j) { const int n = (lane >> 3) + 8 * j; const LAS float* s = scr + (8 * c) * 33 + n;
        u32x4 o; o.x = pk2(s[0 * 33], s[1 * 33]); o.y = pk2(s[2 * 33], s[3 * 33]); o.z = pk2(s[4 * 33], s[5 * 33]); o.w = pk2(s[6 * 33], s[7 * 33]);
        *(u32x4*)(WT + (size_t)(dstrow + n) * K + k0 + 8 * c) = o; }
    LDS_WAIT(); asm volatile("" ::: "memory");
}

__device__ __forceinline__ void p0_mod_item(LAS unsigned char* lds, const float* c, const float* wmod, const float* bmod, float* mod, int it, int tid, int wid, int lane) {
    LAS float* sc = (LAS float*)lds; LAS float* part = (LAS float*)(lds + 16384);
    for (int i = tid; i < 4096; i += 512) { const float cv = c[i]; sc[i] = cv * sigmoidf_(cv); }
    __syncthreads();
    const int l = it / 96, nb = it % 96, col = nb * 32 + (lane & 31), ks = wid * 2 + (lane >> 5);
    const float* wp = wmod + (size_t)l * 1024 * 3072 + col;
    float a0 = 0.f, a1 = 0.f, a2 = 0.f, a3 = 0.f;
#pragma unroll 16
    for (int i = 0; i < 64; ++i) { const int k = ks * 64 + i; const float w = wp[(size_t)k * 3072]; a0 += sc[k] * w; a1 += sc[1024 + k] * w; a2 += sc[2048 + k] * w; a3 += sc[3072 + k] * w; }
    part[(ks * 4 + 0) * 32 + (lane & 31)] = a0; part[(ks * 4 + 1) * 32 + (lane & 31)] = a1; part[(ks * 4 + 2) * 32 + (lane & 31)] = a2; part[(ks * 4 + 3) * 32 + (lane & 31)] = a3;
    __syncthreads();
    if (tid < 128) { const int b = tid >> 5, n = tid & 31; float s = 0.f;
#pragma unroll
        for (int k = 0; k < 16; ++k) s += part[(k * 4 + b) * 32 + n];
        mod[(size_t)(l * 4 + b) * 3072 + nb * 32 + n] = s + bmod[l * 3072 + nb * 32 + n]; }
    __syncthreads();
}

__device__ __forceinline__ void p0_s5_item(LAS unsigned char* lds, const float* const* in, unsigned char* ws, int l, int g, int tid) {
    LAS float* PWr = (LAS float*)lds; LAS float* PWi = PWr + 17 * 64; LAS float* BTr = PWi + 17 * 64; LAS float* BTi = BTr + 1024;
    LAS float* CRr = BTi + 1024; LAS float* CRi = CRr + 1024; LAS float* KC = CRi + 1024;
    const float* are = in[11] + (size_t)(l * 32 + g) * 64; const float* aim = in[12] + (size_t)(l * 32 + g) * 64;
    const double dt = exp((double)in[13][l * 32 + g]);
    const float* bre = in[14] + (size_t)(l * 32 + g) * 1024; const float* bim = in[15] + (size_t)(l * 32 + g) * 1024;
    const float* cre = in[16] + (size_t)(l * 32 + g) * 1024; const float* cim = in[17] + (size_t)(l * 32 + g) * 1024;
    const float* dd = in[18] + (size_t)l * 512 + g * 16;
    float* tab = (float*)(ws + WS_TAB) + (size_t)(l * 32 + g) * 6 * 64;
    if (tid < 64) { const int p = tid; const double ar = are[p], ai = aim[p];
        const double mag = exp(ar * dt), abr = mag * cos(ai * dt), abi = mag * sin(ai * dt), den = ar * ar + ai * ai, nr = abr - 1.0;
        const double fr = (nr * ar + abi * ai) / den, fi = (abi * ar - nr * ai) / den;
#pragma unroll 4
        for (int h = 0; h < 16; ++h) { const double br = bre[p * 16 + h], bi = bim[p * 16 + h]; BTr[p * 16 + h] = (float)(fr * br - fi * bi); BTi[p * 16 + h] = (float)(fr * bi + fi * br); }
        double pr = 1.0, pi = 0.0;
#pragma unroll 1
        for (int tau = 0; tau <= 16; ++tau) { PWr[tau * 64 + p] = (float)pr; PWi[tau * 64 + p] = (float)pi; const double t = pr * abr - pi * abi; pi = pr * abi + pi * abr; pr = t; }
        double qr = (double)0, qi = (double)0; { qr = 1.0; qi = 0.0; double xr = abr, xi = abi;
#pragma unroll 1
          for (int s2 = 0; s2 < 8; ++s2) { const double t = xr * xr - xi * xi; xi = 2.0 * xr * xi; xr = t;
              if (s2 == 3) { tab[0 * 64 + p] = (float)xr; tab[1 * 64 + p] = (float)xi; }
              if (s2 == 5) { tab[2 * 64 + p] = (float)xr; tab[3 * 64 + p] = (float)xi; }
              if (s2 == 7) { tab[4 * 64 + p] = (float)xr; tab[5 * 64 + p] = (float)xi; } } }
        (void)qr; (void)qi; }
    for (int idx = tid; idx < 1024; idx += 512) { CRr[idx] = cre[idx]; CRi[idx] = cim[idx]; }
    __syncthreads();
#pragma unroll 1
    for (int i = 0; i < 8; ++i) { const int idx = tid + 512 * i, tau = idx >> 8, h = (idx >> 4) & 15, hp = idx & 15; float s = 0.f;
#pragma unroll 8
        for (int p = 0; p < 64; ++p) { const float pr = PWr[tau * 64 + p], pi = PWi[tau * 64 + p], br = BTr[p * 16 + hp], bi = BTi[p * 16 + hp];
            const float zr = pr * br - pi * bi, zi = pr * bi + pi * br; s += CRr[h * 64 + p] * zr - CRi[h * 64 + p] * zi; }
        if (tau == 0 && h == hp) s += dd[h];
        KC[idx] = s; }
    __syncthreads();
    bf16* Tz = (bf16*)(ws + WS_S5M + (size_t)l * S5M_BYTES + S5M_TZ) + (size_t)g * 65536;
    bf16* Bz = (bf16*)(ws + WS_S5M + (size_t)l * S5M_BYTES + S5M_BZ) + (size_t)g * 32768;
    bf16* Cz = (bf16*)(ws + WS_S5M + (size_t)l * S5M_BYTES + S5M_CZ) + (size_t)g * 32768;
#pragma unroll 1
    for (int i = 0; i < 16; ++i) { const int idx = tid + 512 * i, n = idx >> 5, c = idx & 31, ii = n >> 4, h = n & 15, j = c >> 1, hp0 = 8 * (c & 1); float v[8];
#pragma unroll
        for (int e = 0; e < 8; ++e) v[e] = (j <= ii) ? KC[((ii - j) * 16 + h) * 16 + hp0 + e] : 0.f;
        u32x4 o; o.x = pk2(v[0], v[1]); o.y = pk2(v[2], v[3]); o.z = pk2(v[4], v[5]); o.w = pk2(v[6], v[7]); *(u32x4*)(Tz + (size_t)n * 256 + 8 * c) = o; }
#pragma unroll 1
    for (int i = 0; i < 8; ++i) { const int idx = tid + 512 * i, n = idx >> 5, c = idx & 31, p = n & 63, im = n >> 6, j = c >> 1, hp0 = 8 * (c & 1), tau = 15 - j; float v[8];
        const float pr = PWr[tau * 64 + p], pi = PWi[tau * 64 + p];
#pragma unroll
        for (int e = 0; e < 8; ++e) { const float br = BTr[p * 16 + hp0 + e], bi = BTi[p * 16 + hp0 + e]; v[e] = im ? (pr * bi + pi * br) : (pr * br - pi * bi); }
        u32x4 o; o.x = pk2(v[0], v[1]); o.y = pk2(v[2], v[3]); o.z = pk2(v[4], v[5]); o.w = pk2(v[6], v[7]); *(u32x4*)(Bz + (size_t)n * 256 + 8 * c) = o; }
#pragma unroll 1
    for (int i = 0; i < 8; ++i) { const int idx = tid + 512 * i, n = idx >> 4, c = idx & 15, ii = n >> 4, h = n & 15, im = c >> 3, tau = ii + 1; float v[8];
#pragma unroll
        for (int e = 0; e < 8; ++e) { const int p = (8 * c + e) & 63; const float cr = CRr[h * 64 + p], ci = CRi[h * 64 + p], pr = PWr[tau * 64 + p], pi = PWi[tau * 64 + p];
            v[e] = im ? -(cr * pi + ci * pr) : (cr * pr - ci * pi); }
        u32x4 o; o.x = pk2(v[0], v[1]); o.y = pk2(v[2], v[3]); o.z = pk2(v[4], v[5]); o.w = pk2(v[6], v[7]); *(u32x4*)(Cz + (size_t)n * 128 + 8 * c) = o; }
    __syncthreads();
}

__device__ __forceinline__ void p0_prologue(LAS unsigned char* lds, const float* const* in, unsigned char* ws, int vcu, int G, int tid, int wid, int lane) {
    for (int it = vcu; it < 64 + 192; it += G) {
        if (it < 64) p0_s5_item(lds, in, ws, it >> 5, it & 31, tid);
        else p0_mod_item(lds, in[1], in[2], in[3], (float*)(ws + WS_MOD), it - 64, tid, wid, lane);
    }
    LAS float* scr = (LAS float*)(lds + wid * 16384);
    const int gw = vcu * NWAVES + wid, NGW = G * NWAVES;
    constexpr int I_IN = 16 * 168, I_OUT = 32 * 32, I_GLU = 8 * 16, I_L = I_IN + I_OUT + I_GLU;
    for (int it = gw; it < NLAYER * I_L; it += NGW) {
        const int l = it / I_L; int r = it % I_L;
        if (r < I_IN) { const int nb = r % 168, kb = r / 168, n0 = nb * 32, sc = win_srccol(n0);
            const float* W = in[6] + (size_t)l * DM * WIN_COLS; bf16* WT = (bf16*)(ws + WS_WIN + (size_t)l * WIN_BYTES);
            if (sc >= 0) transpose_item(W, WIN_COLS, sc, WT, DM, n0, scr, kb * 64, lane, nullptr);
            else transpose_item(W, WIN_COLS, n0 - C_GL, WT, DM, n0, scr, kb * 64, lane, in[8] + (size_t)l * 16 * 256);
            continue; }
        r -= I_IN;
        if (r < I_OUT) { const int nb = r % 32, kb = r / 32;
            transpose_item(in[21] + (size_t)l * 2048 * DM, DM, nb * 32, (bf16*)(ws + WS_WOUT + (size_t)l * WOUT_BYTES), 2048, nb * 32, scr, kb * 64, lane, nullptr); continue; }
        r -= I_OUT;
        { const int nb = r % 16, kb = r / 16;
          transpose_item(in[19] + (size_t)l * 512 * 512, 512, nb * 32, (bf16*)(ws + WS_WGLU + (size_t)l * WGLU_BYTES), 512, nb * 32, scr, kb * 64, lane, nullptr); }
    }
}
__device__ __forceinline__ void prenorm_phase(const float* x, const float* gpre, const float* mod  , bf16* H, int vcu, int wid, int lane) {
    const int gw = vcu * NWAVES + wid;
    const int m0 = gw * 8, b = m0 / SEQ;
    if (m0 >= TOK) return;
    f32x4 ga[4], sh[4];
#pragma unroll
    for (int j = 0; j < 4; ++j) { const int col = 256 * j + 4 * lane; const f32x4 g = *(const f32x4*)(gpre + col), s = *(const f32x4*)(mod + (size_t)b * 3072 + 1024 + col);
        ga[j] = g * (s + 1.0f); sh[j] = *(const f32x4*)(mod + (size_t)b * 3072 + col); }
#pragma unroll 4
    for (int i = 0; i < 8; ++i) { const int m = m0 + i; const float* xr = x + (size_t)m * DM; f32x4 v[4]; float ss = 0.f;
#pragma unroll
        for (int j = 0; j < 4; ++j) { v[j] = *(const f32x4*)(xr + 256 * j + 4 * lane); ss += (v[j][0] * v[j][0] + v[j][1] * v[j][1]) + (v[j][2] * v[j][2] + v[j][3] * v[j][3]); }
        const float r = rsqrtf(wave_sum(ss) * (1.0f / DM) + EPS);
#pragma unroll
        for (int j = 0; j < 4; ++j) { const f32x4 o = v[j] * r * ga[j] + sh[j]; u32x2 w; w.x = pk2(o[0], o[1]); w.y = pk2(o[2], o[3]); *(u32x2*)(H + (size_t)m * DM + 256 * j + 4 * lane) = w; }
    }
}
__device__ __forceinline__ void post_phase(const float* xin, float* xout, const bf16* Y, const float* gpost, const float* mod  , bool do_next, const float* gpre_n, const float* mod_n, bf16* Hn,
                                           int vcu, int wid, int lane) {
    const int gw = vcu * NWAVES + wid; const int m0 = gw * 8, b = m0 / SEQ;
    if (m0 >= TOK) return;
    f32x4 gp[4], gt[4];
#pragma unroll
    for (int j = 0; j < 4; ++j) { const int col = 256 * j + 4 * lane; gp[j] = *(const f32x4*)(gpost + col); gt[j] = *(const f32x4*)(mod + (size_t)b * 3072 + 2048 + col); }
#pragma unroll 2
    for (int i = 0; i < 8; ++i) { const int m = m0 + i; f32x4 y[4], xv[4]; float ss = 0.f;
#pragma unroll
        for (int j = 0; j < 4; ++j) { const u32x2 w = *(const u32x2*)(Y + (size_t)m * DM + 256 * j + 4 * lane); y[j] = (f32x4){bflo(w.x), bfhi(w.x), bflo(w.y), bfhi(w.y)};
            xv[j] = *(const f32x4*)(xin + (size_t)m * DM + 256 * j + 4 * lane); ss += (y[j][0] * y[j][0] + y[j][1] * y[j][1]) + (y[j][2] * y[j][2] + y[j][3] * y[j][3]); }
        const float r = rsqrtf(wave_sum(ss) * (1.0f / DM) + EPS); float s2 = 0.f;
#pragma unroll
        for (int j = 0; j < 4; ++j) { xv[j] = xv[j] + gt[j] * (y[j] * r * gp[j]); *(f32x4*)(xout + (size_t)m * DM + 256 * j + 4 * lane) = xv[j];
            s2 += (xv[j][0] * xv[j][0] + xv[j][1] * xv[j][1]) + (xv[j][2] * xv[j][2] + xv[j][3] * xv[j][3]); }
        if (do_next) { const float r2 = rsqrtf(wave_sum(s2) * (1.0f / DM) + EPS);
#pragma unroll
            for (int j = 0; j < 4; ++j) { const int col = 256 * j + 4 * lane; const f32x4 g = *(const f32x4*)(gpre_n + col), s = *(const f32x4*)(mod_n + (size_t)b * 3072 + 1024 + col), sh = *(const f32x4*)(mod_n + (size_t)b * 3072 + col);
                const f32x4 o = xv[j] * r2 * (g * (s + 1.0f)) + sh; u32x2 w; w.x = pk2(o[0], o[1]); w.y = pk2(o[2], o[3]); *(u32x2*)(Hn + (size_t)m * DM + 256 * j + 4 * lane) = w; } }
    }
}
typedef short v4i16_t __attribute__((ext_vector_type(4)));
__device__ __forceinline__ s16x4 vtr(LAS unsigned char* p) { return __builtin_bit_cast(s16x4, __builtin_amdgcn_ds_read_tr16_b64_v4i16((LAS v4i16_t*)p)); }
__device__ __forceinline__ void attn_item(LAS unsigned char* lds, bf16* P, const float* sinks, int item, int tid, int wid, int lane) {
    const int r32 = lane & 31, hi = lane >> 5;
    const int qblk = item & 31, kvh = (item >> 5) & 3, b = item >> 7, q0 = qblk * 128;
    const size_t rowbase = (size_t)b * SEQ;
    LAS unsigned char* Ks = lds; LAS unsigned char* Vs = lds + 32768; LAS float* ost = (LAS float*)(lds + 65536 + wid * 8704);
    { const int kr = tid >> 1, hf = tid & 1, key = q0 - 128 + kr; u32x4 kv[4], vv[4];
      if (key >= 0) { const bf16* src = P + (rowbase + key) * LDP + kvh * 64 + hf * 32;
#pragma unroll
          for (int c = 0; c < 4; ++c) { kv[c] = *(const u32x4*)(src + C_AK + c * 8); vv[c] = *(const u32x4*)(src + C_AV + c * 8); } }
      else {
#pragma unroll
          for (int c = 0; c < 4; ++c) { kv[c] = (u32x4){0u, 0u, 0u, 0u}; vv[c] = (u32x4){0u, 0u, 0u, 0u}; } }
#pragma unroll
      for (int c = 0; c < 4; ++c) { const int ch = hf * 4 + c; *(LAS u32x4*)(Ks + kr * 128 + ((ch ^ (kr & 7)) << 4)) = kv[c]; *(LAS u32x4*)(Vs + kr * 128 + (ch << 4)) = vv[c]; } }
    __syncthreads();
    const int g = wid >> 1, half = wid & 1, head = kvh * 4 + g;
    const float slope2 = exp2f(-0.5f * (float)(head + 1)) * LOG2E, sink2 = sinks[head] * LOG2E, C2 = 0.125f * LOG2E;
    const int q16 = (lane & 15) >> 2, p16 = lane & 3, dblk = (lane >> 4) & 1;
#pragma unroll 1
    for (int sb = 0; sb < 2; ++sb) {
        const int qs = q0 + half * 64 + sb * 32, lrow0 = half * 64 + sb * 32;
        const bf16* qp = P + (rowbase + qs + r32) * LDP + C_AQ + head * 64 + hi * 8;
        bf16x8 qf[4];
#pragma unroll
        for (int kk = 0; kk < 4; ++kk) qf[kk] = *(const bf16x8*)(qp + kk * 16);
        f32x16 S[5]; float m = sink2; int e = r32 - 4 * hi; asm volatile("" : "+v"(e)); const float ef = (float)e;
#pragma unroll
        for (int kt = 0; kt < 5; ++kt) { f32x16 acc;
#pragma unroll
            for (int r = 0; r < 16; ++r) acc[r] = 0.f;
            const int krow = lrow0 + 32 * kt + r32;
#pragma unroll
            for (int kk = 0; kk < 4; ++kk) { const int ch = 2 * kk + hi; const bf16x8 kf = *(const LAS bf16x8*)(Ks + krow * 128 + ((ch ^ (krow & 7)) << 4)); acc = MFMA32(kf, qf[kk], acc); }
            { const bool tile_ok = (qs - 128 + 32 * kt) >= 0;
              const float base = -slope2 * ((float)(128 - 32 * kt) + ef);
#pragma unroll
              for (int r = 0; r < 16; ++r) { const int cr = (r & 3) + 8 * (r >> 2);
                  const float s = fmaf(acc[r], C2, fmaf(slope2, (float)cr, base));
                  bool ok = tile_ok; if (kt == 0) ok = ok && (e < cr); if (kt == 4) ok = ok && (e >= cr);
                  S[kt][r] = ok ? s : -INFINITY; m = fmaxf(m, S[kt][r]); } }
            __builtin_amdgcn_sched_barrier(0); }
        m = fmaxf(m, __shfl_xor(m, 32));
        float l = 0.f;
#pragma unroll
        for (int kt = 0; kt < 5; ++kt)
#pragma unroll
            for (int r = 0; r < 16; ++r) { const float p = __builtin_amdgcn_exp2f(S[kt][r] - m); S[kt][r] = p; l += p; }
        l += __shfl_xor(l, 32); l += __builtin_amdgcn_exp2f(sink2 - m);
        const float inv_l = 1.0f / l;
        f32x16 o0, o1;
#pragma unroll
        for (int r = 0; r < 16; ++r) { o0[r] = 0.f; o1[r] = 0.f; }
#pragma unroll
        for (int kt = 0; kt < 5; ++kt)
#pragma unroll
            for (int ks = 0; ks < 2; ++ks) { u32x4 pw; pw.x = pk2(S[kt][8 * ks + 0], S[kt][8 * ks + 1]); pw.y = pk2(S[kt][8 * ks + 2], S[kt][8 * ks + 3]); pw.z = pk2(S[kt][8 * ks + 4], S[kt][8 * ks + 5]); pw.w = pk2(S[kt][8 * ks + 6], S[kt][8 * ks + 7]);
                const bf16x8 pa = __builtin_bit_cast(bf16x8, pw);
                LAS unsigned char* vb = Vs + (lrow0 + 32 * kt + 16 * ks + 4 * hi + q16) * 128 + dblk * 32 + p16 * 8;
                const s16x4 a0 = vtr(vb), a1 = vtr(vb + 8 * 128), b0 = vtr(vb + 64), b1 = vtr(vb + 64 + 8 * 128);
                const bf16x8 v0 = __builtin_shufflevector(a0, a1, 0, 1, 2, 3, 4, 5, 6, 7), v1 = __builtin_shufflevector(b0, b1, 0, 1, 2, 3, 4, 5, 6, 7);
                o0 = MFMA32(pa, v0, o0); o1 = MFMA32(pa, v1, o1); __builtin_amdgcn_sched_barrier(0); }
#pragma unroll
        for (int r = 0; r < 16; ++r) { const int qr = (r & 3) + 8 * (r >> 2) + 4 * hi; ost[qr * 68 + r32] = o0[r]; ost[qr * 68 + 32 + r32] = o1[r]; }
        asm volatile("" ::: "memory");
        { const int row = lane >> 1, hf = lane & 1; const float sc = __shfl(inv_l, row);
          bf16* rp = P + (rowbase + qs + row) * LDP + head * 64 + hf * 32;
#pragma unroll
          for (int c = 0; c < 4; ++c) { const u32x4 gv = *(const u32x4*)(rp + C_AG + 8 * c);
              const f32x4 x0 = *(const LAS f32x4*)(ost + row * 68 + hf * 32 + 8 * c), x1 = *(const LAS f32x4*)(ost + row * 68 + hf * 32 + 8 * c + 4);
              float gg[8] = {bflo(gv.x), bfhi(gv.x), bflo(gv.y), bfhi(gv.y), bflo(gv.z), bfhi(gv.z), bflo(gv.w), bfhi(gv.w)};
              float xx[8] = {x0[0], x0[1], x0[2], x0[3], x1[0], x1[1], x1[2], x1[3]};
#pragma unroll
              for (int e = 0; e < 8; ++e) xx[e] = xx[e] * sc * gg[e] * sigmoidf_(gg[e]);
              u32x4 w; w.x = pk2(xx[0], xx[1]); w.y = pk2(xx[2], xx[3]); w.z = pk2(xx[4], xx[5]); w.w = pk2(xx[6], xx[7]);
              *(u32x4*)(rp + C_AQ + 8 * c) = w; } }
        asm volatile("" ::: "memory");
    }
    __syncthreads();
}
constexpr int GL_QT = 0, GL_KT = 9216, GL_KH = 18432, GL_AT = 27648, GL_VT = 36864, GL_ST = 55296, GL_PART = 73728, GL_BL = 75776, GL_SS = 76032, GL_RS = 78080, GL_LD = 72;
__device__ __forceinline__ bf16x8 ldsfrag(LAS unsigned char* base, int row, int kof) { return *(const LAS bf16x8*)(base + (row * GL_LD + kof) * 2); }
template <bool OUT>
__device__ __forceinline__ void gla_item(LAS unsigned char* lds, bf16* P, const float* balpha, const float* gnorm, float* GE, float* GD, int item, int tid, int wid, int lane) {
    const int c16 = lane & 15, q = lane >> 4;
    const int b = item >> 6, hd = (item >> 4) & 3, seg = item & 15;
    const size_t row0 = (size_t)b * SEQ + seg * 256;
    LAS bf16* QT = (LAS bf16*)(lds + GL_QT); LAS bf16* KT = (LAS bf16*)(lds + GL_KT); LAS bf16* AT = (LAS bf16*)(lds + GL_AT); LAS bf16* ST = (LAS bf16*)(lds + GL_ST);
    LAS float* PART = (LAS float*)(lds + GL_PART); LAS float* BL = (LAS float*)(lds + GL_BL); LAS float* SS = (LAS float*)(lds + GL_SS); LAS float* RS = (LAS float*)(lds + GL_RS);
    f32x4 S[4];
#pragma unroll
    for (int nt = 0; nt < 4; ++nt) S[nt] = (f32x4){0.f, 0.f, 0.f, 0.f};
    if (OUT) {
#pragma unroll 1
        for (int sp = 0; sp < seg; ++sp) { const float* e = GE + (size_t)(item - seg + sp) * 8192; const float* dd = GD + (size_t)(item - seg + sp) * 64;
#pragma unroll
            for (int nt = 0; nt < 4; ++nt) { const float dec = dd[16 * nt + c16];
#pragma unroll
                for (int r = 0; r < 4; ++r) S[nt][r] = S[nt][r] * dec + e[(16 * wid + 4 * q + r) * 64 + 16 * nt + c16]; } } }
    float dtot = 0.f;
    const int d = tid & 63, part = tid >> 6;
    const float ba = balpha[hd * 64 + d];
#pragma unroll 1
    for (int ch = 0; ch < 4; ++ch) {
        const size_t rowc = row0 + ch * 64;
        float bcs[8]; float run = 0.f;
#pragma unroll
        for (int i = 0; i < 8; ++i) { const float x = bf2f(P[(rowc + part * 8 + i) * LDP + C_GL + hd * 64 + d]) + ba;
            const float la = (fminf(x, 0.f) - log1pf(__expf(-fabsf(x)))) * 0.0625f; run += la; bcs[i] = run; }
        PART[part * 64 + d] = run;
        __syncthreads();
        float off = 0.f, tot = 0.f;
#pragma unroll
        for (int p = 0; p < 8; ++p) { const float v = PART[p * 64 + d]; tot += v; off += (p < part) ? v : 0.f; }
        if (part == 0) { BL[d] = tot; dtot += tot; }
        { float kh[8];
#pragma unroll
          for (int i = 0; i < 8; ++i) { const float bi = off + bcs[i]; const int tok = part * 8 + i; const float kx = bf2f(P[(rowc + tok) * LDP + C_BK + hd * 64 + d]);
              if (OUT) { const float qx = bf2f(P[(rowc + tok) * LDP + C_BQ + hd * 64 + d]); QT[tok * GL_LD + d] = f2bf(qx * 0.125f * __expf(bi)); KT[tok * GL_LD + d] = f2bf(kx * __expf(-bi)); }
              kh[i] = kx * __expf(tot - bi); }
          u32x4 w; w.x = pk2(kh[0], kh[1]); w.y = pk2(kh[2], kh[3]); w.z = pk2(kh[4], kh[5]); w.w = pk2(kh[6], kh[7]);
          *(LAS u32x4*)(lds + GL_KH + (d * GL_LD + part * 8) * 2) = w; }
        { const int v = tid & 127, tp = tid >> 7; float vv[16];
#pragma unroll
          for (int i = 0; i < 16; ++i) vv[i] = bf2f(P[(rowc + tp * 16 + i) * LDP + C_BV + hd * 128 + v]);
          u32x4 w0, w1; w0.x = pk2(vv[0], vv[1]); w0.y = pk2(vv[2], vv[3]); w0.z = pk2(vv[4], vv[5]); w0.w = pk2(vv[6], vv[7]);
          w1.x = pk2(vv[8], vv[9]); w1.y = pk2(vv[10], vv[11]); w1.z = pk2(vv[12], vv[13]); w1.w = pk2(vv[14], vv[15]);
          *(LAS u32x4*)(lds + GL_VT + (v * GL_LD + tp * 16) * 2) = w0; *(LAS u32x4*)(lds + GL_VT + (v * GL_LD + tp * 16 + 8) * 2) = w1; }
        if (OUT) {
#pragma unroll
            for (int nt = 0; nt < 4; ++nt)
#pragma unroll
                for (int r = 0; r < 4; ++r) ST[(16 * wid + 4 * q + r) * GL_LD + 16 * nt + c16] = f2bf(S[nt][r]); }
        __syncthreads();
        if (OUT) {
            { const int mt = wid >> 1;
#pragma unroll
              for (int t = 0; t < 2; ++t) { const int nt = 2 * (wid & 1) + t; f32x4 acc = (f32x4){0.f, 0.f, 0.f, 0.f};
                  if (nt <= mt) {
#pragma unroll
                      for (int kk = 0; kk < 2; ++kk) acc = MFMA16(ldsfrag(lds + GL_QT, 16 * mt + c16, 32 * kk + 8 * q), ldsfrag(lds + GL_KT, 16 * nt + c16, 32 * kk + 8 * q), acc); }
#pragma unroll
                  for (int r = 0; r < 4; ++r) { const int i = 16 * mt + 4 * q + r, j = 16 * nt + c16; AT[i * GL_LD + j] = f2bf((j <= i) ? acc[r] : 0.f); } } }
            __syncthreads();
            f32x4 o[4];
#pragma unroll
            for (int mt = 0; mt < 4; ++mt) { f32x4 acc = (f32x4){0.f, 0.f, 0.f, 0.f};
#pragma unroll
                for (int kk = 0; kk < 2; ++kk) if (kk == 0 || mt >= 2) acc = MFMA16(ldsfrag(lds + GL_AT, 16 * mt + c16, 32 * kk + 8 * q), ldsfrag(lds + GL_VT, 16 * wid + c16, 32 * kk + 8 * q), acc);
#pragma unroll
                for (int kk = 0; kk < 2; ++kk) acc = MFMA16(ldsfrag(lds + GL_QT, 16 * mt + c16, 32 * kk + 8 * q), ldsfrag(lds + GL_ST, 16 * wid + c16, 32 * kk + 8 * q), acc);
                o[mt] = acc; }
#pragma unroll
            for (int mt = 0; mt < 4; ++mt)
#pragma unroll
                for (int r = 0; r < 4; ++r) { float s = o[mt][r] * o[mt][r]; s += __shfl_xor(s, 1); s += __shfl_xor(s, 2); s += __shfl_xor(s, 4); s += __shfl_xor(s, 8);
                    if (c16 == 0) SS[wid * 64 + 16 * mt + 4 * q + r] = s; }
            __syncthreads();
            if (tid < 64) { float t = 0.f;
#pragma unroll
                for (int w = 0; w < 8; ++w) t += SS[w * 64 + tid];
                RS[tid] = rsqrtf(t * (1.0f / 128.0f) + EPS); }
            __syncthreads();
            const float gn = gnorm[hd * 128 + 16 * wid + c16];
#pragma unroll
            for (int mt = 0; mt < 4; ++mt)
#pragma unroll
                for (int r = 0; r < 4; ++r) { const int i = 16 * mt + 4 * q + r; bf16* rp = P + (rowc + i) * LDP + hd * 128 + 16 * wid + c16; const float bg = bf2f(rp[C_BG]);
                    rp[C_BV] = f2bf(o[mt][r] * RS[i] * gn * bg * sigmoidf_(bg)); }
        }
#pragma unroll
        for (int nt = 0; nt < 4; ++nt) { const float dec = __expf(BL[16 * nt + c16]); f32x4 acc = S[nt] * dec;
#pragma unroll
            for (int kk = 0; kk < 2; ++kk) acc = MFMA16(ldsfrag(lds + GL_VT, 16 * wid + c16, 32 * kk + 8 * q), ldsfrag(lds + GL_KH, 16 * nt + c16, 32 * kk + 8 * q), acc);
            S[nt] = acc; }
        __syncthreads();
    }
    if (!OUT) {
#pragma unroll
        for (int nt = 0; nt < 4; ++nt)
#pragma unroll
            for (int r = 0; r < 4; ++r) GE[(size_t)item * 8192 + (16 * wid + 4 * q + r) * 64 + 16 * nt + c16] = S[nt][r];
        if (part == 0) GD[(size_t)item * 64 + d] = __expf(dtot);
    }
}
#ifndef PH_MASK
#define PH_MASK 0xffff
#endif
__device__ __forceinline__ void cmul_acc(float& hr, float& hi, float ar, float ai, float gr, float gi) { const float nr = ar * hr - ai * hi + gr, ni = ar * hi + ai * hr + gi; hr = nr; hi = ni; }
template <bool OUT>
__device__ __forceinline__ void s5_item(LAS unsigned char* wscr, bf16* P, const bf16* TzT, const bf16* BzT, const bf16* CzT, const float* tab, float* SE, int id, int lane) {
    const int c16 = lane & 15, q = lane >> 4;
    const int b = id >> 9, g = (id >> 4) & 31, seg = id & 15;
    const size_t tok0 = (size_t)b * SEQ + seg * 256;
    bf16x8 uf[8];
#pragma unroll
    for (int kk = 0; kk < 8; ++kk) uf[kk] = *(const bf16x8*)(P + (tok0 + 16 * c16 + 2 * kk + (q >> 1)) * LDP + C_CU + 16 * g + 8 * (q & 1));
    f32x4 G[8];
    const bf16* bz = BzT + (size_t)g * 32768;
#pragma unroll
    for (int nt = 0; nt < 8; ++nt) { f32x4 acc = (f32x4){0.f, 0.f, 0.f, 0.f};
#pragma unroll
        for (int kk = 0; kk < 8; ++kk) acc = MFMA16(uf[kk], *(const bf16x8*)(bz + (size_t)(16 * nt + c16) * 256 + 32 * kk + 8 * q), acc);
        G[nt] = acc; if (nt & 1) __builtin_amdgcn_sched_barrier(0); }
    const float* tg = tab + (size_t)g * 6 * 64;
    float a16r[4], a16i[4], a64r[4], a64i[4];
#pragma unroll
    for (int n4 = 0; n4 < 4; ++n4) { const int p = 16 * n4 + c16; a16r[n4] = tg[0 * 64 + p]; a16i[n4] = tg[1 * 64 + p]; a64r[n4] = tg[2 * 64 + p]; a64i[n4] = tg[3 * 64 + p]; }
    float er[4], ei[4], ir[4], ii[4], cr[4], ci[4];
#pragma unroll
    for (int n4 = 0; n4 < 4; ++n4) { float hr = 0.f, hi = 0.f;
#pragma unroll
        for (int r = 0; r < 4; ++r) cmul_acc(hr, hi, a16r[n4], a16i[n4], G[n4][r], G[n4 + 4][r]);
        er[n4] = hr; ei[n4] = hi; ir[n4] = hr; ii[n4] = hi; }
#pragma unroll
    for (int s = 1; s < 4; ++s)
#pragma unroll
        for (int n4 = 0; n4 < 4; ++n4) { const float vr = __shfl(ir[n4], (lane - 16) & 63), vi = __shfl(ii[n4], (lane - 16) & 63);
            if (q == s) { ir[n4] = a64r[n4] * vr - a64i[n4] * vi + er[n4]; ii[n4] = a64r[n4] * vi + a64i[n4] * vr + ei[n4]; } }
#pragma unroll
    for (int n4 = 0; n4 < 4; ++n4) { const float vr = __shfl(ir[n4], (lane - 16) & 63), vi = __shfl(ii[n4], (lane - 16) & 63); cr[n4] = (q > 0) ? vr : 0.f; ci[n4] = (q > 0) ? vi : 0.f; }
    if (!OUT) {
        if (q == 3) {
#pragma unroll
            for (int n4 = 0; n4 < 4; ++n4) { SE[(size_t)id * 128 + 16 * n4 + c16] = ir[n4]; SE[(size_t)id * 128 + 64 + 16 * n4 + c16] = ii[n4]; } }
        return;
    }
    float hinr[4] = {0.f, 0.f, 0.f, 0.f}, hini[4] = {0.f, 0.f, 0.f, 0.f};
    { float a256r[4], a256i[4];
#pragma unroll
      for (int n4 = 0; n4 < 4; ++n4) { const int p = 16 * n4 + c16; a256r[n4] = tg[4 * 64 + p]; a256i[n4] = tg[5 * 64 + p]; }
#pragma unroll 1
      for (int sp = 0; sp < seg; ++sp) { const float* e = SE + (size_t)(id - seg + sp) * 128;
#pragma unroll
          for (int n4 = 0; n4 < 4; ++n4) cmul_acc(hinr[n4], hini[n4], a256r[n4], a256i[n4], e[16 * n4 + c16], e[64 + 16 * n4 + c16]); } }
    LAS bf16* Hs = (LAS bf16*)wscr;
#pragma unroll
    for (int n4 = 0; n4 < 4; ++n4) {
        float pr = 1.f, pi = 0.f;
#pragma unroll
        for (int i = 0; i < 3; ++i) if (i < q) { const float nr = pr * a64r[n4] - pi * a64i[n4], ni = pr * a64i[n4] + pi * a64r[n4]; pr = nr; pi = ni; }
        float hr = pr * hinr[n4] - pi * hini[n4] + cr[n4], hi = pr * hini[n4] + pi * hinr[n4] + ci[n4];
#pragma unroll
        for (int r = 0; r < 4; ++r) { Hs[(4 * q + r) * 136 + 16 * n4 + c16] = f2bf(hr); Hs[(4 * q + r) * 136 + 64 + 16 * n4 + c16] = f2bf(hi);
            cmul_acc(hr, hi, a16r[n4], a16i[n4], G[n4][r], G[n4 + 4][r]); } }
    bf16x8 hf[4];
#pragma unroll
    for (int kk = 0; kk < 4; ++kk) hf[kk] = *(const LAS bf16x8*)(wscr + (c16 * 136 + 32 * kk + 8 * q) * 2);
    const bf16* tz = TzT + (size_t)g * 65536; const bf16* cz = CzT + (size_t)g * 32768;
#pragma unroll
    for (int nt = 0; nt < 16; ++nt) { f32x4 acc = (f32x4){0.f, 0.f, 0.f, 0.f};
#pragma unroll
        for (int kk = 0; kk < 8; ++kk) if (kk <= (nt >> 1)) acc = MFMA16(uf[kk], *(const bf16x8*)(tz + (size_t)(16 * nt + c16) * 256 + 32 * kk + 8 * q), acc);
#pragma unroll
        for (int kk = 0; kk < 4; ++kk) acc = MFMA16(hf[kk], *(const bf16x8*)(cz + (size_t)(16 * nt + c16) * 128 + 32 * kk + 8 * q), acc);
#pragma unroll
        for (int r = 0; r < 4; ++r) { const float y = acc[r], u2 = 1.5957691216057308f * (y + 0.044715f * y * y * y);
            P[(tok0 + 16 * (4 * q + r) + nt) * LDP + C_CU + 16 * g + c16] = f2bf(y * sigmoidf_(u2)); }
        __builtin_amdgcn_sched_barrier(0); }
}

template <bool SECOND>
#ifndef PROBE_TYPE
#define PROBE_TYPE -1
#endif
#define PBX(t) do { if ((t) == PROBE_TYPE) px_t0 = __builtin_amdgcn_s_memrealtime(); } while (0)
#define PEX(t) do { if ((t) == PROBE_TYPE) pacc += __builtin_amdgcn_s_memrealtime() - px_t0; } while (0)
__device__ __forceinline__ void mixers_phase(LAS unsigned char* lds, const float* const* in, unsigned char* ws, bf16* P, int l, int vcu, int G, int tid, int wid, int lane, unsigned long long& pacc) {
    unsigned long long px_t0 = 0; (void)px_t0;
    PBX(10); if (!SECOND && (PH_MASK & 0x100)) for (int it = vcu; it < 256; it += G) attn_item(lds, P, in[7] + l * 16, it, tid, wid, lane);
    PEX(10);
    float* GE = (float*)(ws + WS_GLAE); float* GD = (float*)(ws + WS_GLAD); float* SE = (float*)(ws + WS_S5E);
    const float* balpha = in[9] + l * 256; const float* gnorm = in[10] + l * 512;
    int tid1 = tid; asm volatile("" : "+v"(tid1));
    PBX(SECOND ? 13 : 11); if (PH_MASK & 0x200) for (int it = vcu; it < 256; it += G) gla_item<SECOND>(lds, P, balpha, gnorm, GE, GD, it, tid1, wid, tid1 & 63);
    PEX(SECOND ? 13 : 11);
    const bf16* TzT = (const bf16*)(ws + WS_S5M + (size_t)l * S5M_BYTES + S5M_TZ); const bf16* BzT = (const bf16*)(ws + WS_S5M + (size_t)l * S5M_BYTES + S5M_BZ);
    const bf16* CzT = (const bf16*)(ws + WS_S5M + (size_t)l * S5M_BYTES + S5M_CZ); const float* tab = (const float*)(ws + WS_TAB) + (size_t)l * 32 * 6 * 64;
    int lane2 = lane; asm volatile("" : "+v"(lane2));
    PBX(SECOND ? 14 : 12); if (PH_MASK & 0x400) for (int id = vcu * NWAVES + wid; id < 2048; id += G * NWAVES) s5_item<SECOND>(lds + wid * 4352, P, TzT, BzT, CzT, tab, SE, id, lane2);
    __syncthreads(); PEX(SECOND ? 14 : 12);
}
#ifndef MK_MULTI
#define MK_MULTI 0
#endif
constexpr int N_PHASES = 2 + 6 * NLAYER;
struct Args { const float* in[22]; float* out; unsigned char* ws; int ph_lo, ph_hi; };
__global__ void __launch_bounds__(NWAVES * 64, 2) hybrid_fwd(Args args_) {
    extern __shared__ __attribute__((aligned(16))) unsigned char lds_raw[];
    const int G = gridDim.x; const int bx = blockIdx.x; const int vcu = (G % 8 == 0) ? (bx % 8) * (G / 8) + bx / 8 : bx;
    XcdBarrier bar;
    { LAS unsigned char* lds0 = (LAS unsigned char*)lds_raw;
      volatile LAS unsigned* MISC = (volatile LAS unsigned*)(lds0 + MISC_OFF);
      for (int u = threadIdx.x; u < (LDS_BYTES - LDSCTL_OFF) / 4; u += NWAVES * 64) ((LAS unsigned*)(lds0 + LDSCTL_OFF))[u] = 0u;
      __syncthreads();
      bar.bar = (unsigned*)(args_.ws + WS_CTL) + CW_BAR; bar.x = 0; bar.st = nullptr;
      if (!MK_MULTI) bar = xcd_barrier_post((unsigned*)(args_.ws + WS_CTL) + CW_BAR, MISC + 8); }
    const int lo = args_.ph_lo, hi = args_.ph_hi;
#ifndef PROBE_TYPE
#define PROBE_TYPE -1
#endif
#ifndef PROBE_K
#define PROBE_K 4
#endif
#ifndef PROBE_BLOCK
#define PROBE_BLOCK 0
#endif
    unsigned long long pr_acc = 0, pr_t0 = 0; (void)pr_t0;
#define PB(t) do { if ((t) == PROBE_TYPE) pr_t0 = __builtin_amdgcn_s_memrealtime(); } while (0)
#define PE(t) do { if ((t) == PROBE_TYPE) pr_acc += __builtin_amdgcn_s_memrealtime() - pr_t0; } while (0)
#define IN(k) (lo <= (k) && (k) < hi)
#if MK_MULTI
#define SEAM(k) do { } while (0)
#else
#define SEAM(k) do { if (IN(k) && IN((k) + 1)) xcd_barrier(bar); } while (0)
#endif
#define PHASE_IDS typedef const Args __attribute__((address_space(4)))* kargp_t; kargp_t ap = (kargp_t)__builtin_amdgcn_kernarg_segment_ptr(); asm volatile("" : "+s"(ap)); const Args& args = *(const Args*)ap; \
        int tid = threadIdx.x; asm volatile("" : "+v"(tid)); const int lane = tid & 63, wid = __builtin_amdgcn_readfirstlane(tid >> 6); (void)lane; (void)wid; \
        LAS unsigned char* lds = (LAS unsigned char*)lds_raw; asm volatile("" : "+s"(lds)); unsigned char* ws = args.ws; \
        bf16* const P = (bf16*)(ws + WS_P); bf16* const H = (bf16*)(ws + WS_H); float* const MOD = (float*)(ws + WS_MOD); (void)P; (void)H; (void)MOD;
#ifndef PH_MASK
#define PH_MASK 0xffff
#endif
    PB(0); if (IN(0) && (PH_MASK & 1)) { PHASE_IDS p0_prologue(lds, args.in, ws, vcu, G, tid, wid, lane); }
    SEAM(0); PE(0);
    PB(1); if (IN(1) && (PH_MASK & 2)) { PHASE_IDS prenorm_phase(args.in[0], args.in[4], MOD, H, vcu, wid, lane); }
    SEAM(1); PE(1);
#define LAYER(l, base) \
    PB(2); if (IN(base + 0) && (PH_MASK & 4)) { PHASE_IDS \
        pg8::Gemm g{H, (const bf16*)(ws + WS_WIN + (size_t)l * WIN_BYTES), TOK, LDP, DM, DM}; pg8::StaticOrder S; S.init(TOK, LDP, G, bx); \
        pg8::EpiBf16<0> E{P, LDP, nullptr, 0, 0, 1.f}; \
        pg8::gemm_phase<pg8::EpiBf16<0>, pg8::StaticOrder, true, true>(lds, g, S, E, tid); } \
    SEAM(base + 0); PE(2); \
    PB(3); if (IN(base + 1) && (PH_MASK & 8)) { PHASE_IDS mixers_phase<false>(lds, args.in, ws, P, l, vcu, G, tid, wid, lane, pr_acc); } \
    SEAM(base + 1); PE(3); \
    PB(4); if (IN(base + 2) && (PH_MASK & 8)) { PHASE_IDS mixers_phase<true>(lds, args.in, ws, P, l, vcu, G, tid, wid, lane, pr_acc); } \
    SEAM(base + 2); PE(4); \
    PB(5); if (IN(base + 3) && (PH_MASK & 16)) { PHASE_IDS \
        pg8::Gemm g{P + C_CU, (const bf16*)(ws + WS_WGLU + (size_t)l * WGLU_BYTES), TOK, 512, 512, LDP}; pg8::StaticOrder S; S.init(TOK, 512, G, bx); \
        pg8::EpiGlu E{P, LDP, C_CU, C_CG, args.in[20] + l * 512}; \
        PB(15); if (PH_MASK & 0x800) pg8::gemm_phase<pg8::EpiGlu, pg8::StaticOrder, true, true>(lds, g, S, E, tid); PE(15); PB(16); \
        if (!(PH_MASK & 0x1000)) {} else if (G == 256) { if (bx >= 128) { attn_item(lds, P, args.in[7] + l * 16, 256 + 2 * (bx - 128), tid, wid, lane); attn_item(lds, P, args.in[7] + l * 16, 257 + 2 * (bx - 128), tid, wid, lane); } } \
        else for (int it = 256 + vcu; it < 512; it += G) attn_item(lds, P, args.in[7] + l * 16, it, tid, wid, lane); PE(16); } \
    SEAM(base + 3); PE(5); \
    PB(6); if (IN(base + 4) && (PH_MASK & 32)) { PHASE_IDS \
        pg8::Gemm g{P, (const bf16*)(ws + WS_WOUT + (size_t)l * WOUT_BYTES), TOK, DM, 2048, LDP}; pg8::StaticOrder S; S.init(TOK, DM, G, bx); \
        pg8::EpiBf16<0> E{H, DM, nullptr, 0, 0, 1.f}; \
        pg8::gemm_phase<pg8::EpiBf16<0>, pg8::StaticOrder, true, true>(lds, g, S, E, tid); } \
    SEAM(base + 4); PE(6); \
    PB(7); if (IN(base + 5) && (PH_MASK & 64)) { PHASE_IDS \
        post_phase(l == 0 ? args.in[0] : args.out, args.out, H, args.in[5] + l * DM, MOD + (size_t)l * 4 * 3072, (l + 1 < NLAYER), args.in[4] + (l + 1 < NLAYER ? l + 1 : l) * DM, MOD + (size_t)(l + 1 < NLAYER ? l + 1 : l) * 4 * 3072, H, vcu, wid, lane); } \
    SEAM(base + 5); PE(7);
    LAYER(0, 2)
    LAYER(1, 8)
#undef LAYER
    if (PROBE_TYPE >= 0 && blockIdx.x == PROBE_BLOCK) { const unsigned long long te = __builtin_amdgcn_s_memrealtime(); while (__builtin_amdgcn_s_memrealtime() - te < (unsigned long long)PROBE_K * pr_acc) __builtin_amdgcn_s_sleep(20); }
#undef IN
#undef SEAM
}

extern "C" void kernel_launch(void* const* d_in, const int* in_sizes, int n_in, void* d_out, int out_size, void* d_ws, size_t ws_size, hipStream_t stream) {
    static int grid = 0;
    if (grid == 0) {
        if (n_in != 22 || in_sizes[0] != TOK * DM || out_size != TOK * DM || ws_size < WS_END) { fprintf(stderr, "kernel_launch: unexpected shapes (n_in %d, in0 %d, out %d, ws %zu)\n", n_in, n_in > 0 ? in_sizes[0] : -1, out_size, ws_size); grid = -1; return; }
        int dev = 0, cus = 0;
        if (hipGetDevice(&dev) != hipSuccess || hipDeviceGetAttribute(&cus, hipDeviceAttributeMultiprocessorCount, dev) != hipSuccess) { grid = -1; return; }
        if (hipFuncSetAttribute((const void*)hybrid_fwd, hipFuncAttributeMaxDynamicSharedMemorySize, LDS_BYTES) != hipSuccess) { fprintf(stderr, "kernel_launch: hipFuncSetAttribute failed\n"); grid = -1; return; }
        (void)hipGetLastError();
        grid = cus;
    }
    if (grid < 0) return;
    if (hipMemsetAsync((char*)d_ws + WS_CTL, 0, CTL_ZERO_BYTES, stream) != hipSuccess) { fprintf(stderr, "kernel_launch: memset failed\n"); return; }
    Args a{};
    for (int i = 0; i < 22; ++i) a.in[i] = (const float*)d_in[i];
    a.out = (float*)d_out; a.ws = (unsigned char*)d_ws;
#if MK_MULTI
    for (int ph = 0; ph < N_PHASES; ++ph) { a.ph_lo = ph; a.ph_hi = ph + 1; hipLaunchKernelGGL(hybrid_fwd, dim3(grid), dim3(NWAVES * 64), LDS_BYTES, stream, a); }
#else
    a.ph_lo = 0; a.ph_hi = N_PHASES;
    hipLaunchKernelGGL(hybrid_fwd, dim3(grid), dim3(NWAVES * 64), LDS_BYTES, stream, a);
#endif
    const hipError_t le = hipPeekAtLastError();
    if (le != hipSuccess) fprintf(stderr, "kernel_launch: launch failed: %s\n", hipGetErrorName(le));
}
```

```cpp
#include <hip/hip_runtime.h>
#include <cstdio>
#include <cstdint>
#include <cmath>
#define MK_MULTI 0
namespace pg8 {
#define PG8_LAS __attribute__((address_space(3)))
typedef unsigned short bf16_t;
typedef short bf16x8 __attribute__((ext_vector_type(8)));
typedef float f32x4 __attribute__((ext_vector_type(4)));
typedef unsigned u32x4 __attribute__((ext_vector_type(4)));
constexpr int BM = 256, BK = 64, HALF = 128, HTB = HALF * BK * 2  , STAGE_BYTES = 8 * HTB, NXCD = 8, WGM = 8;

__host__ __device__ __forceinline__ int lds_byte(int r, int c) { const int st = (r >> 4) * 2 + (c >> 5), rr = r & 15, cc = c & 31, ob = rr * 64 + cc * 2; return st * 1024 + (ob ^ (((ob >> 9) & 1) << 5)); }
__host__ __device__ __forceinline__ void stage_rc(int b, int& R, int& C) { const int st = b / 1024, sb = b % 1024, swz = sb ^ (((sb >> 9) & 1) << 5); R = (st >> 1) * 16 + swz / 64; C = (st & 1) * 32 + (swz % 64) / 2; }
__host__ __device__ __forceinline__ int perm32(int rho) { const int n = rho >> 4, i = rho & 15; return 8 * (i >> 2) + 4 * n + (i & 3); }

struct Unit { int pm, pn; };
struct Gemm { const bf16_t* A; const bf16_t* Bt; int M, N, K, lda; };

struct StaticOrder {
    int nM, nN, nwg, G, c;
    __host__ __device__ void init(int M, int N, int G_, int c_) { nM = M / BM; nN = N / BM; nwg = nM * nN; G = G_; c = c_; }
    __host__ __device__ bool next(int i, Unit& u) const {
        const long L = (long)i * G + c; if (L >= nwg) return false;
        int wgid = (int)L; { const int q = nwg / NXCD, r = nwg % NXCD, xcd = wgid % NXCD, off = wgid / NXCD; wgid = (xcd < r ? xcd * (q + 1) : r * (q + 1) + (xcd - r) * q) + off; }
        const int nig = WGM * nN, gid = wgid / nig, fm = gid * WGM, gsz = (nM - fm) < WGM ? (nM - fm) : WGM;
        u.pm = fm + ((wgid % nig) % gsz); u.pn = (wgid % nig) / gsz; return true;
    }
    __device__ __forceinline__ void a_ready(const Unit&) const {}
    __device__ __forceinline__ void done(const Unit&) const {}
};

__device__ __forceinline__ unsigned cvt_pk_bf16(float lo, float hi) { unsigned r; asm volatile("v_cvt_pk_bf16_f32 %0, %1, %2" : "=v"(r) : "v"(lo), "v"(hi)); return r; }
typedef float f32x2 __attribute__((ext_vector_type(2)));
__device__ __forceinline__ f32x2 gelu_pk(f32x2 v) {
    const f32x2 av = __builtin_elementwise_abs(v), d = av * 0.2316418882f + 1.0f;
    f32x2 t; t.x = __builtin_amdgcn_rcpf(d.x); t.y = __builtin_amdgcn_rcpf(d.y);
    f32x2 q = t * 0.5307027145f + (-0.7265760135f); q = q * t + 0.7107068705f; q = q * t + (-0.142248368f); q = q * t + 0.127414796f; q = q * t;
    const f32x2 s = (v * v) * (-0.72134752044f);
    f32x2 e; e.x = __builtin_amdgcn_exp2f(s.x); e.y = __builtin_amdgcn_exp2f(s.y);
    const f32x2 m = v * (q * e), r = v - m;
    f32x2 o; o.x = v.x < 0.f ? m.x : r.x; o.y = v.y < 0.f ? m.y : r.y; return o;
}

template <int ACT  > struct EpiBf16 {
    static constexpr bool PERM = true, AFTER_DRAIN = false; static_assert(ACT == 0 || ACT == 1, "EpiBf16: ACT is 0 (none) or 1 (gelu_pk)");
    bf16_t* O; int ldc; const float* bias; int split_cols; size_t split_stride; float scale0;
    __device__ __forceinline__ void operator()(const f32x4 (&acc)[2][2][4][2], const Unit& u, int wr, int wc, int fr, int fq) const {
        const int row0 = u.pm * BM + wr * 64 + fr; int colt = u.pn * BM; bf16_t* base = O;
        float sc = 1.f; if (split_cols) { const int t = colt / split_cols; base += (size_t)t * split_stride; colt -= t * split_cols; if (t == 0) sc = scale0; }
        const int col0 = colt + wc * 32 + 8 * fq, bcol0 = u.pn * BM + wc * 32 + 8 * fq;
        f32x4 bv[2][2];
#pragma unroll
        for (int bj = 0; bj < 2; ++bj)
#pragma unroll
            for (int n = 0; n < 2; ++n) bv[bj][n] = bias ? *(const f32x4*)(bias + bcol0 + bj * HALF + 4 * n) : (f32x4){0.f, 0.f, 0.f, 0.f};
#pragma unroll
        for (int ai = 0; ai < 2; ++ai)
#pragma unroll
            for (int m = 0; m < 4; ++m) { bf16_t* rowp = base + (size_t)(row0 + ai * HALF + m * 16) * ldc + col0;
#pragma unroll
                for (int bj = 0; bj < 2; ++bj) { f32x4 v0 = acc[ai][bj][m][0] + bv[bj][0], v1 = acc[ai][bj][m][1] + bv[bj][1];
                    if (ACT == 1) { f32x2 a = gelu_pk((f32x2){v0[0], v0[1]}), b = gelu_pk((f32x2){v0[2], v0[3]}), c = gelu_pk((f32x2){v1[0], v1[1]}), d = gelu_pk((f32x2){v1[2], v1[3]});
                        v0 = (f32x4){a.x, a.y, b.x, b.y}; v1 = (f32x4){c.x, c.y, d.x, d.y}; }
                    v0 = v0 * sc; v1 = v1 * sc; u32x4 w; w.x = cvt_pk_bf16(v0[0], v0[1]); w.y = cvt_pk_bf16(v0[2], v0[3]); w.z = cvt_pk_bf16(v1[0], v1[1]); w.w = cvt_pk_bf16(v1[2], v1[3]);
                    *(u32x4*)(rowp + bj * HALF) = w; } }
    }
};
struct EpiGlu {
    static constexpr bool PERM = true, AFTER_DRAIN = false;
    bf16_t* P; int ldp, col_y, col_g; const float* bglu;
    __device__ __forceinline__ void operator()(const f32x4 (&acc)[2][2][4][2], const Unit& u, int wr, int wc, int fr, int fq) const {
        const int row0 = u.pm * BM + wr * 64 + fr; const int col0 = u.pn * BM + wc * 32 + 8 * fq;
#pragma unroll
        for (int ai = 0; ai < 2; ++ai)
#pragma unroll
            for (int m = 0; m < 4; ++m) { bf16_t* rowp = P + (size_t)(row0 + ai * HALF + m * 16) * ldp;
#pragma unroll
                for (int bj = 0; bj < 2; ++bj) { const int col = col0 + bj * HALF;
                    const f32x4 b0 = *(const f32x4*)(bglu + col), b1 = *(const f32x4*)(bglu + col + 4);
                    const u32x4 yv = *(const u32x4*)(rowp + col_y + col), gv = *(const u32x4*)(rowp + col_g + col);
                    const f32x4 z0 = acc[ai][bj][m][0] + b0, z1 = acc[ai][bj][m][1] + b1;
                    float z[8] = {z0[0], z0[1], z0[2], z0[3], z1[0], z1[1], z1[2], z1[3]}; float o[8];
#pragma unroll
                    for (int e = 0; e < 8; ++e) { const unsigned yw = yv[e >> 1], gw = gv[e >> 1];
                        const float y = __uint_as_float((e & 1) ? (yw & 0xffff0000u) : (yw << 16)), g = __uint_as_float((e & 1) ? (gw & 0xffff0000u) : (gw << 16));
                        const float sz = __builtin_amdgcn_rcpf(1.0f + __expf(-z[e])), sg = __builtin_amdgcn_rcpf(1.0f + __expf(-g));
                        o[e] = y * sz * g * sg; }
                    u32x4 w; w.x = cvt_pk_bf16(o[0], o[1]); w.y = cvt_pk_bf16(o[2], o[3]); w.z = cvt_pk_bf16(o[4], o[5]); w.w = cvt_pk_bf16(o[6], o[7]);
                    *(u32x4*)(rowp + col_g + col) = w; } }
    }
};
template <class Epi, class Sched, bool ALIGN_EPI = false, bool SP2 = false>
__device__ __forceinline__ void gemm_phase(PG8_LAS unsigned char* lds, const Gemm g, const Sched& S, const Epi& E, int tid_in) {
    const int tid = tid_in, wid = __builtin_amdgcn_readfirstlane(tid >> 6), lane = tid & 63, wr = wid >> 2, wc = wid & 3, fr = lane & 15, fq = lane >> 4;
    const int K = g.K, nt = K / BK;
    unsigned voffA[2], voffB[2];
#pragma unroll
    for (int i = 0; i < 2; ++i) { int R, C; stage_rc(tid * 16 + i * 8192, R, C); const int Rb = Epi::PERM ? ((R & ~31) + perm32(R & 31)) : R;
        voffA[i] = (unsigned)(R * g.lda + C) * 2u; voffB[i] = (unsigned)(Rb * K + C) * 2u; }
    const size_t kstep = (size_t)(BK * 2);
    const size_t hstepB = (size_t)HALF * K * 2, hstepA = (size_t)HALF * g.lda * 2;
    const size_t tstepB = 2 * hstepB, tstepA = 2 * hstepA;
    const unsigned ldsw = (unsigned)wid * 1024u;
    const int aoff = lds_byte(wr * 64 + fr, fq * 8), boff = lds_byte(wc * 32 + fr, fq * 8);
#define PG8_SA(b, h) (((b) * 2 + (h)) * HTB)
#define PG8_SB(b, h) ((4 + (b) * 2 + (h)) * HTB)
#define PG8_STAGE(bufoff, gbase, voff) do { _Pragma("unroll") for (int _i = 0; _i < 2; ++_i) \
        __builtin_amdgcn_global_load_lds((const unsigned*)((const char*)(gbase) + (voff)[_i]), (PG8_LAS unsigned*)(lds + (bufoff) + ldsw + _i * 8192), 16, 0, 0); } while (0)
#define PG8_LDA(dst, b, h) do { _Pragma("unroll") for (int m = 0; m < 4; ++m) _Pragma("unroll") for (int k = 0; k < 2; ++k) dst[m][k] = *(const PG8_LAS bf16x8*)(lds + PG8_SA(b, h) + aoff + m * 2048 + k * 1024); } while (0)
#define PG8_LDB(dst, b, h) do { _Pragma("unroll") for (int n = 0; n < 2; ++n) _Pragma("unroll") for (int k = 0; k < 2; ++k) dst[n][k] = *(const PG8_LAS bf16x8*)(lds + PG8_SB(b, h) + boff + n * 2048 + k * 1024); } while (0)
#define PG8_MMA(ai, bj, At, Bt) do { __builtin_amdgcn_s_setprio(1); _Pragma("unroll") for (int m = 0; m < 4; ++m) _Pragma("unroll") for (int n = 0; n < 2; ++n) _Pragma("unroll") for (int k = 0; k < 2; ++k) \
        acc[ai][bj][m][n] = __builtin_amdgcn_mfma_f32_16x16x32_bf16(Bt[n][k], At[m][k], acc[ai][bj][m][n], 0, 0, 0); __builtin_amdgcn_s_setprio(0); } while (0)
#define PG8_WAIT_V(n) asm volatile("s_waitcnt vmcnt(" #n ")" ::: "memory")
#define PG8_WAIT_L(n) asm volatile("s_waitcnt lgkmcnt(" #n ")" ::: "memory")
#define PG8_BAR __builtin_amdgcn_s_barrier()
#define PG8_SCHED __builtin_amdgcn_sched_barrier(0)
    Unit cur, nxt; int ui = 0;
    if (!S.next(0, cur)) return;
    f32x4 acc[2][2][4][2];
#pragma unroll
    for (int a = 0; a < 2; ++a)
#pragma unroll
        for (int b = 0; b < 2; ++b)
#pragma unroll
            for (int m = 0; m < 4; ++m)
#pragma unroll
                for (int n = 0; n < 2; ++n) acc[a][b][m][n] = (f32x4){0.f, 0.f, 0.f, 0.f};
    bf16x8 At[4][2], B0[2][2], B1[2][2];
    const char* cA = (const char*)g.A + (size_t)cur.pm * tstepA; const char* cB = (const char*)g.Bt + (size_t)cur.pn * tstepB;
    S.a_ready(cur);
    if constexpr (SP2) {
        PG8_STAGE(PG8_SB(0, 0), cB, voffB); PG8_STAGE(PG8_SB(0, 1), cB + hstepB, voffB); PG8_STAGE(PG8_SA(0, 0), cA, voffA); PG8_STAGE(PG8_SA(0, 1), cA + hstepA, voffA);
        if (wr == 1) PG8_BAR;
        PG8_WAIT_V(2); PG8_BAR;
        PG8_STAGE(PG8_SB(1, 0), cB + kstep, voffB); PG8_STAGE(PG8_SA(1, 0), cA + kstep, voffA); PG8_STAGE(PG8_SB(1, 1), cB + hstepB + kstep, voffB);
        PG8_WAIT_V(6); PG8_BAR;
    } else {
        PG8_STAGE(PG8_SB(0, 0), cB, voffB); PG8_STAGE(PG8_SA(0, 0), cA, voffA); PG8_STAGE(PG8_SB(0, 1), cB + hstepB, voffB); PG8_STAGE(PG8_SA(0, 1), cA + hstepA, voffA);
        if (wr == 1) PG8_BAR;
        PG8_WAIT_V(4); PG8_BAR;
        PG8_STAGE(PG8_SB(1, 0), cB + kstep, voffB); PG8_STAGE(PG8_SA(1, 0), cA + kstep, voffA); PG8_STAGE(PG8_SB(1, 1), cB + hstepB + kstep, voffB);
        PG8_WAIT_V(6); PG8_BAR;
    }
    for (;;) {
        const bool has_next = S.next(ui + 1, nxt);
        const char* nA = has_next ? (const char*)g.A + (size_t)nxt.pm * tstepA : cA; const char* nB = has_next ? (const char*)g.Bt + (size_t)nxt.pn * tstepB : cB;
        for (int t = 0; t < nt; t += 2) {
            const bool last = (t == nt - 2);
            const char* a1 = cA + (size_t)(t + 1) * kstep;
            const char* a2 = last ? nA : cA + (size_t)(t + 2) * kstep; const char* b2 = last ? nB : cB + (size_t)(t + 2) * kstep;
            const char* a3 = a2 + kstep; const char* b3 = b2 + kstep;
            if (last && has_next) S.a_ready(nxt);
            if constexpr (SP2) {
            PG8_LDB(B0, 0, 0); PG8_LDB(B1, 0, 1); PG8_SCHED; PG8_LDA(At, 0, 0); PG8_STAGE(PG8_SA(1, 1), a1 + hstepA, voffA);
            PG8_WAIT_V(8); PG8_WAIT_L(0); PG8_BAR; PG8_MMA(0, 0, At, B0); PG8_MMA(0, 1, At, B1); PG8_BAR; PG8_SCHED;
            PG8_LDA(At, 0, 1); PG8_STAGE(PG8_SB(0, 0), b2, voffB); PG8_STAGE(PG8_SB(0, 1), b2 + hstepB, voffB); PG8_STAGE(PG8_SA(0, 0), a2, voffA);
            PG8_WAIT_V(8); PG8_WAIT_L(0); PG8_BAR; PG8_MMA(1, 0, At, B0); PG8_MMA(1, 1, At, B1); PG8_BAR; PG8_SCHED;
            PG8_LDB(B0, 1, 0); PG8_LDB(B1, 1, 1); PG8_SCHED; PG8_LDA(At, 1, 0); PG8_STAGE(PG8_SA(0, 1), a2 + hstepA, voffA);
            PG8_WAIT_V(8); PG8_WAIT_L(0); PG8_BAR; PG8_MMA(0, 0, At, B0); PG8_MMA(0, 1, At, B1); PG8_BAR; PG8_SCHED;
            PG8_LDA(At, 1, 1); PG8_STAGE(PG8_SB(1, 0), b3, voffB); PG8_STAGE(PG8_SB(1, 1), b3 + hstepB, voffB); PG8_STAGE(PG8_SA(1, 0), a3, voffA);
            PG8_WAIT_V(8); PG8_WAIT_L(0); PG8_BAR; PG8_MMA(1, 0, At, B0); PG8_MMA(1, 1, At, B1); PG8_BAR; PG8_SCHED;
            } else {
            PG8_LDB(B0, 0, 0); PG8_SCHED; PG8_LDA(At, 0, 0); PG8_STAGE(PG8_SA(1, 1), a1 + hstepA, voffA);
            PG8_WAIT_L(8); PG8_BAR; PG8_WAIT_L(0); PG8_MMA(0, 0, At, B0); PG8_BAR; PG8_SCHED;
            PG8_LDB(B1, 0, 1); PG8_STAGE(PG8_SB(0, 0), b2, voffB);
            PG8_BAR; PG8_WAIT_L(0); PG8_MMA(0, 1, At, B1); PG8_BAR;
            PG8_LDA(At, 0, 1); PG8_STAGE(PG8_SA(0, 0), a2, voffA);
            PG8_BAR; PG8_WAIT_L(0); PG8_MMA(1, 0, At, B0); PG8_BAR; PG8_SCHED;
            PG8_STAGE(PG8_SB(0, 1), b2 + hstepB, voffB);
            PG8_WAIT_V(6); PG8_BAR; PG8_MMA(1, 1, At, B1); PG8_BAR;
            PG8_LDB(B0, 1, 0); PG8_SCHED; PG8_LDA(At, 1, 0); PG8_STAGE(PG8_SA(0, 1), a2 + hstepA, voffA);
            PG8_WAIT_L(8); PG8_BAR; PG8_WAIT_L(0); PG8_MMA(0, 0, At, B0); PG8_BAR; PG8_SCHED;
            PG8_LDB(B1, 1, 1); PG8_STAGE(PG8_SB(1, 0), b3, voffB);
            PG8_BAR; PG8_WAIT_L(0); PG8_MMA(0, 1, At, B1); PG8_BAR;
            PG8_LDA(At, 1, 1); PG8_STAGE(PG8_SA(1, 0), a3, voffA);
            PG8_BAR; PG8_WAIT_L(0); PG8_MMA(1, 0, At, B0); PG8_BAR; PG8_SCHED;
            PG8_STAGE(PG8_SB(1, 1), b3 + hstepB, voffB);
            PG8_WAIT_V(6); PG8_BAR; PG8_MMA(1, 1, At, B1); PG8_BAR;
            }
        }
        if constexpr (ALIGN_EPI) { if (wr == 0) PG8_BAR; }
        if constexpr (!Epi::AFTER_DRAIN) { E(acc, cur, wr, wc, fr, fq); S.done(cur); }
        if (!has_next) break;
#pragma unroll
        for (int a = 0; a < 2; ++a)
#pragma unroll
            for (int b = 0; b < 2; ++b)
#pragma unroll
                for (int m = 0; m < 4; ++m)
#pragma unroll
                    for (int n = 0; n < 2; ++n) acc[a][b][m][n] = (f32x4){0.f, 0.f, 0.f, 0.f};
        cur = nxt; cA = nA; cB = nB; ++ui;
        if constexpr (ALIGN_EPI) { if (wr == 1) PG8_BAR; }
    }
    PG8_WAIT_V(0);
    if constexpr (!ALIGN_EPI) { if (wr == 0) PG8_BAR; }
    PG8_BAR;
    if constexpr (Epi::AFTER_DRAIN) { E.fused(acc, cur, wr, wc, fr, fq, lds, wid, lane); S.done(cur); }
#undef PG8_SA
#undef PG8_SB
#undef PG8_STAGE
#undef PG8_LDA
#undef PG8_LDB
#undef PG8_MMA
#undef PG8_WAIT_V
#undef PG8_WAIT_L
#undef PG8_BAR
#undef PG8_SCHED
}
}
#define GAS __attribute__((address_space(1)))
#define LAS __attribute__((address_space(3)))
typedef unsigned short bf16;
typedef short bf16x8 __attribute__((ext_vector_type(8)));
typedef float f32x4 __attribute__((ext_vector_type(4)));
typedef float f32x16 __attribute__((ext_vector_type(16)));
typedef unsigned u32x4 __attribute__((ext_vector_type(4)));
typedef unsigned u32x2 __attribute__((ext_vector_type(2)));
typedef short s16x4 __attribute__((ext_vector_type(4)));
typedef GAS unsigned gu32;
constexpr int NWAVES = 8;
constexpr int NBATCH = 4, SEQ = 4096, DM = 1024, TOK = NBATCH * SEQ, NLAYER = 2;
constexpr int LDP = 5376, WIN_COLS = 5136;
constexpr int C_AQ = 0, C_BV = 1024, C_CG = 1536, C_AK = 2048, C_AV = 2304, C_AG = 2560, C_BQ = 3584, C_BK = 3840, C_GL = 4096, C_BG = 4352, C_CU = 4864;
constexpr float EPS = 1e-6f, LOG2E = 1.4426950408889634f;
constexpr size_t MiB = 1u << 20;
constexpr size_t WS_CTL = 0, CTL_ZERO_BYTES = 64 * 1024;
constexpr int CW_BAR = 1024;
constexpr size_t WS_MOD = 1 * MiB;
constexpr size_t WS_TAB = 1 * MiB + 256 * 1024;
constexpr size_t WS_WIN = 2 * MiB, WIN_BYTES = (size_t)LDP * DM * 2;
constexpr size_t WS_WOUT = 23 * MiB, WOUT_BYTES = (size_t)DM * 2048 * 2;
constexpr size_t WS_WGLU = 31 * MiB, WGLU_BYTES = (size_t)512 * 512 * 2;
constexpr size_t WS_S5M = 32 * MiB, S5M_BYTES = 8 * MiB;
constexpr size_t S5M_TZ = 0, S5M_BZ = 4 * MiB, S5M_CZ = 6 * MiB;
constexpr size_t WS_H = 48 * MiB;
constexpr size_t WS_GLAE = 48 * MiB;
constexpr size_t WS_GLAD = 56 * MiB;
constexpr size_t WS_S5E = 57 * MiB;
constexpr size_t WS_P = 80 * MiB;
constexpr size_t WS_END = 248 * MiB;
static_assert(WS_WIN + 2 * WIN_BYTES <= WS_WOUT && WS_WOUT + 2 * WOUT_BYTES <= WS_WGLU && WS_WGLU + 2 * WGLU_BYTES <= WS_S5M && WS_S5M + 2 * S5M_BYTES <= WS_H, "ws map");
static_assert(WS_H + (size_t)TOK * DM * 2 <= WS_P && WS_P + (size_t)TOK * LDP * 2 <= WS_END && WS_S5E + 2048 * 128 * 4 <= WS_P, "ws map 2");
constexpr int RING_BYTES = 143360, LDSCTL_OFF = RING_BYTES, MISC_OFF = LDSCTL_OFF + 320, LDS_BYTES = 147456;

#define RLX_AGENT __ATOMIC_RELAXED, __HIP_MEMORY_SCOPE_AGENT
#define LDS_WAIT() asm volatile("s_waitcnt lgkmcnt(0)" ::: "memory")
typedef float f32x2_t __attribute__((ext_vector_type(2))); typedef __bf16 bf16x2_t __attribute__((ext_vector_type(2)));
__device__ __forceinline__ unsigned pk2(float lo, float hi) { f32x2_t v = {lo, hi}; bf16x2_t b = __builtin_convertvector(v, bf16x2_t); return __builtin_bit_cast(unsigned, b); }
__device__ __forceinline__ bf16 f2bf(float f) { return (bf16)(pk2(f, 0.f) & 0xffffu); }
__device__ __forceinline__ float bf2f(bf16 b) { return __uint_as_float((unsigned)b << 16); }
__device__ __forceinline__ float bflo(unsigned w) { return __uint_as_float(w << 16); }
__device__ __forceinline__ float bfhi(unsigned w) { return __uint_as_float(w & 0xffff0000u); }
__device__ __forceinline__ float sigmoidf_(float x) { return __builtin_amdgcn_rcpf(1.0f + __expf(-x)); }
__device__ __forceinline__ float wave_sum(float v) {
#pragma unroll
    for (int o = 1; o < 64; o <<= 1) v += __shfl_xor(v, o);
    return v;
}
#define MFMA16(a, b, c) __builtin_amdgcn_mfma_f32_16x16x32_bf16((a), (b), (c), 0, 0, 0)
#define MFMA32(a, b, c) __builtin_amdgcn_mfma_f32_32x32x16_bf16((a), (b), (c), 0, 0, 0)
#define XB_TMO      128
#define XB_XCNT(j)  (256  + 64 * (j))
#define XB_XSUB(j)  (1280 + 64 * (j))
#define XB_XGEN(j)  (2304 + 64 * (j))
#define XB_TOP      3328
#define XB_TOPGEN   3392
#define XCD_BAR_WORDS 3456
#define XB_SPIN_CAP (1u << 18)

__device__ __forceinline__ unsigned xb_ld(unsigned* p)              { return __hip_atomic_load(p, __ATOMIC_RELAXED, __HIP_MEMORY_SCOPE_AGENT); }
__device__ __forceinline__ unsigned xb_add(unsigned* p, unsigned v) { return __hip_atomic_fetch_add(p, v, __ATOMIC_RELAXED, __HIP_MEMORY_SCOPE_AGENT); }
__device__ __forceinline__ unsigned xb_xcc_id() { return (unsigned)__builtin_amdgcn_s_getreg((3 << 11) | 20) & 0xFu; }
#define XB_SPIN(cond, bar) do { unsigned _sp = 0; while (cond) { __builtin_amdgcn_s_sleep(1); \
    if ((++_sp & 255u) == 0u) { if (xb_ld(&(bar)[XB_TMO])) break; if (_sp > XB_SPIN_CAP) { atomicAdd(&(bar)[XB_TMO], 1u); break; } } } } while (0)

struct XcdBarrier {
    unsigned* bar; unsigned x;
    volatile LAS unsigned* st;
};

__device__ __forceinline__ XcdBarrier xcd_barrier_post(unsigned* bar, volatile LAS unsigned* st) {
    XcdBarrier b; b.bar = bar; b.x = xb_xcc_id(); b.st = st;
    if (threadIdx.x == 0) (void)xb_add(&bar[XB_XCNT(b.x)], 1u);
    return b;
}
__device__ __forceinline__ void xcd_barrier_complete(unsigned* bar, unsigned x, unsigned& nloc, unsigned& nx) {
    const unsigned G = gridDim.x * gridDim.y * gridDim.z;
    unsigned sum, cnt, mine, sp = 0u;
    for (;;) {
        sum = 0u; cnt = 0u; mine = 0u;
#pragma unroll
        for (unsigned j = 0; j < 16; ++j) { const unsigned c = xb_ld(&bar[XB_XCNT(j)]); sum += c; cnt += (c > 0u) ? 1u : 0u; mine = (j == x) ? c : mine; }
        if (sum == G) break;
        __builtin_amdgcn_s_sleep(1);
        if ((++sp & 255u) == 0u) { if (xb_ld(&bar[XB_TMO])) break; if (sp > XB_SPIN_CAP) { atomicAdd(&bar[XB_TMO], 1u); break; } }
    }
    nloc = mine > 0u ? mine : 1u; nx = cnt > 0u ? cnt : 1u;
}

__device__ __forceinline__ void xcd_barrier(const XcdBarrier& b) {
    asm volatile("s_waitcnt vmcnt(0)" ::: "memory");
    __syncthreads();
    if (threadIdx.x == 0) {
        unsigned* bar = b.bar;
        __builtin_amdgcn_s_waitcnt(0);
        unsigned nloc = b.st[0], nx = b.st[1];
        if (nloc == 0u) { xcd_barrier_complete(bar, b.x, nloc, nx); b.st[0] = nloc; b.st[1] = nx; }
        const unsigned old = xb_add(&bar[XB_XSUB(b.x)], 1u);
        const unsigned gen = old / nloc;
        if (old + 1u == (gen + 1u) * nloc) {
            __builtin_amdgcn_fence(__ATOMIC_RELEASE, "agent");
            asm volatile("s_waitcnt vmcnt(0)" ::: "memory");
            const unsigned og = xb_add(&bar[XB_TOP], 1u);
            const unsigned tg = og / nx;
            if (og + 1u == (tg + 1u) * nx) xb_add(&bar[XB_TOPGEN], 1u);
            else XB_SPIN(xb_ld(&bar[XB_TOPGEN]) == tg, bar);
            __builtin_amdgcn_fence(__ATOMIC_ACQUIRE, "agent");
            xb_add(&bar[XB_XGEN(b.x)], 1u);
            asm volatile("s_waitcnt vmcnt(0)" ::: "memory");
        } else {
            XB_SPIN(xb_ld(&bar[XB_XGEN(b.x)]) == gen, bar);
            __builtin_amdgcn_fence(__ATOMIC_ACQUIRE, "agent");
            asm volatile("s_waitcnt vmcnt(0)" ::: "memory");
        }
    }
    __syncthreads();
}
__device__ __forceinline__ int win_srccol(int n0) {
    if (n0 < 1024) return n0;
    if (n0 < 1536) return 3072 + (n0 - 1024);
    if (n0 < 2048) return 4624 + (n0 - 1536);
    if (n0 < 2304) return 1024 + (n0 - 2048);
    if (n0 < 2560) return 1280 + (n0 - 2304);
    if (n0 < 3584) return 1536 + (n0 - 2560);
    if (n0 < 3840) return 2560 + (n0 - 3584);
    if (n0 < 4096) return 2816 + (n0 - 3840);
    if (n0 < 4352) return -1;
    if (n0 < 4864) return 3600 + (n0 - 4352);
    return 4112 + (n0 - 4864);
}
__device__ __forceinline__ void p0_mod_item(LAS unsigned char* lds, const float* c, const float* wmod, const float* bmod, const float* gpre, float* mod, int it, int tid, int wid, int lane) {
    LAS float* sc = (LAS float*)lds; LAS float* part = (LAS float*)(lds + 16384);
    const int l = it / 96, nb = it % 96, col = nb * 32 + (lane & 31), ks = wid * 2 + (lane >> 5);
    const float* wp = wmod + (size_t)l * 1024 * 3072 + col + (size_t)ks * 64 * 3072;
    float w[64];
#pragma unroll
    for (int i = 0; i < 64; ++i) w[i] = wp[(size_t)i * 3072];
    for (int i = tid; i < 4096; i += 512) { const float cv = c[i]; sc[i] = cv * sigmoidf_(cv); }
    __syncthreads();
    float a0 = 0.f, a1 = 0.f, a2 = 0.f, a3 = 0.f;
#pragma unroll
    for (int i = 0; i < 64; ++i) { const int k = ks * 64 + i; a0 += sc[k] * w[i]; a1 += sc[1024 + k] * w[i]; a2 += sc[2048 + k] * w[i]; a3 += sc[3072 + k] * w[i]; }
    part[(ks * 4 + 0) * 32 + (lane & 31)] = a0; part[(ks * 4 + 1) * 32 + (lane & 31)] = a1; part[(ks * 4 + 2) * 32 + (lane & 31)] = a2; part[(ks * 4 + 3) * 32 + (lane & 31)] = a3;
    __syncthreads();
    if (tid < 128) { const int b = tid >> 5, n = nb * 32 + (tid & 31); float s = 0.f;
#pragma unroll
        for (int k = 0; k < 16; ++k) s += part[(k * 4 + b) * 32 + (tid & 31)];
        s += bmod[l * 3072 + n];
        if (n >= 1024 && n < 2048) s = gpre[l * 1024 + n - 1024] * (1.0f + s);
        mod[(size_t)(l * 4 + b) * 3072 + n] = s; }
    __syncthreads();
}

__device__ __forceinline__ void p0_s5_item(LAS unsigned char* lds, const float* const* in, unsigned char* ws, int l, int g, int tid) {
    LAS float* PWr = (LAS float*)lds; LAS float* PWi = PWr + 17 * 64; LAS float* BTr = PWi + 17 * 64; LAS float* BTi = BTr + 1024;
    LAS float* CRr = BTi + 1024; LAS float* CRi = CRr + 1024; LAS float* KC = CRi + 1024;
    const float* are = in[11] + (size_t)(l * 32 + g) * 64; const float* aim = in[12] + (size_t)(l * 32 + g) * 64;
    const double dt = exp((double)in[13][l * 32 + g]);
    const float* bre = in[14] + (size_t)(l * 32 + g) * 1024; const float* bim = in[15] + (size_t)(l * 32 + g) * 1024;
    const float* cre = in[16] + (size_t)(l * 32 + g) * 1024; const float* cim = in[17] + (size_t)(l * 32 + g) * 1024;
    const float* dd = in[18] + (size_t)l * 512 + g * 16;
    float* tab = (float*)(ws + WS_TAB) + (size_t)(l * 32 + g) * 6 * 64;
    if (tid < 64) { const int p = tid; const double ar = are[p], ai = aim[p];
        const double mag = exp(ar * dt), abr = mag * cos(ai * dt), abi = mag * sin(ai * dt), den = ar * ar + ai * ai, nr = abr - 1.0;
        const double fr = (nr * ar + abi * ai) / den, fi = (abi * ar - nr * ai) / den;
#pragma unroll 4
        for (int h = 0; h < 16; ++h) { const double br = bre[p * 16 + h], bi = bim[p * 16 + h]; BTr[p * 16 + h] = (float)(fr * br - fi * bi); BTi[p * 16 + h] = (float)(fr * bi + fi * br); }
        double pr = 1.0, pi = 0.0;
#pragma unroll 1
        for (int tau = 0; tau <= 16; ++tau) { PWr[tau * 64 + p] = (float)pr; PWi[tau * 64 + p] = (float)pi; const double t = pr * abr - pi * abi; pi = pr * abi + pi * abr; pr = t; }
        double qr = (double)0, qi = (double)0; { qr = 1.0; qi = 0.0; double xr = abr, xi = abi;
#pragma unroll 1
          for (int s2 = 0; s2 < 8; ++s2) { const double t = xr * xr - xi * xi; xi = 2.0 * xr * xi; xr = t;
              if (s2 == 3) { tab[0 * 64 + p] = (float)xr; tab[1 * 64 + p] = (float)xi; }
              if (s2 == 5) { tab[2 * 64 + p] = (float)xr; tab[3 * 64 + p] = (float)xi; }
              if (s2 == 7) { tab[4 * 64 + p] = (float)xr; tab[5 * 64 + p] = (float)xi; } } }
        (void)qr; (void)qi; }
    for (int idx = tid; idx < 1024; idx += 512) { CRr[idx] = cre[idx]; CRi[idx] = cim[idx]; }
    __syncthreads();
    { const int hp = tid & 15, tau = (tid >> 4) & 15, hh = __builtin_amdgcn_readfirstlane(tid >> 8); float acc[8];
#pragma unroll
      for (int j = 0; j < 8; ++j) acc[j] = 0.f;
#pragma unroll 4
      for (int p = 0; p < 64; ++p) { const float pr = PWr[tau * 64 + p], pi = PWi[tau * 64 + p], br = BTr[p * 16 + hp], bi = BTi[p * 16 + hp];
          const float xr = pr * br - pi * bi, xi = pr * bi + pi * br;
#pragma unroll
          for (int j = 0; j < 8; ++j) acc[j] += cre[(8 * hh + j) * 64 + p] * xr - cim[(8 * hh + j) * 64 + p] * xi; }
#pragma unroll
      for (int j = 0; j < 8; ++j) { const int h = 8 * hh + j; float s = acc[j]; if (tau == 0 && h == hp) s += dd[h]; KC[(tau * 16 + h) * 16 + hp] = s; } }
    __syncthreads();
    bf16* Tz = (bf16*)(ws + WS_S5M + (size_t)l * S5M_BYTES + S5M_TZ) + (size_t)g * 65536;
    bf16* Bz = (bf16*)(ws + WS_S5M + (size_t)l * S5M_BYTES + S5M_BZ) + (size_t)g * 32768;
    bf16* Cz = (bf16*)(ws + WS_S5M + (size_t)l * S5M_BYTES + S5M_CZ) + (size_t)g * 32768;
#pragma unroll 1
    for (int i = 0; i < 16; ++i) { const int idx = tid + 512 * i, n = idx >> 5, c = idx & 31, ii = n >> 4, h = n & 15, j = c >> 1, hp0 = 8 * (c & 1); float v[8];
#pragma unroll
        for (int e = 0; e < 8; ++e) v[e] = (j <= ii) ? KC[((ii - j) * 16 + h) * 16 + hp0 + e] : 0.f;
        u32x4 o; o.x = pk2(v[0], v[1]); o.y = pk2(v[2], v[3]); o.z = pk2(v[4], v[5]); o.w = pk2(v[6], v[7]); *(u32x4*)(Tz + (size_t)n * 256 + 8 * c) = o; }
#pragma unroll 1
    for (int i = 0; i < 8; ++i) { const int idx = tid + 512 * i, n = idx >> 5, c = idx & 31, p = n & 63, im = n >> 6, j = c >> 1, hp0 = 8 * (c & 1), tau = 15 - j; float v[8];
        const float pr = PWr[tau * 64 + p], pi = PWi[tau * 64 + p];
#pragma unroll
        for (int e = 0; e < 8; ++e) { const float br = BTr[p * 16 + hp0 + e], bi = BTi[p * 16 + hp0 + e]; v[e] = im ? (pr * bi + pi * br) : (pr * br - pi * bi); }
        u32x4 o; o.x = pk2(v[0], v[1]); o.y = pk2(v[2], v[3]); o.z = pk2(v[4], v[5]); o.w = pk2(v[6], v[7]); *(u32x4*)(Bz + (size_t)n * 256 + 8 * c) = o; }
#pragma unroll 1
    for (int i = 0; i < 8; ++i) { const int idx = tid + 512 * i, n = idx >> 4, c = idx & 15, ii = n >> 4, h = n & 15, im = c >> 3, tau = ii + 1; float v[8];
#pragma unroll
        for (int e = 0; e < 8; ++e) { const int p = (8 * c + e) & 63; const float cr = CRr[h * 64 + p], ci = CRi[h * 64 + p], pr = PWr[tau * 64 + p], pi = PWi[tau * 64 + p];
            v[e] = im ? -(cr * pi + ci * pr) : (cr * pr - ci * pi); }
        u32x4 o; o.x = pk2(v[0], v[1]); o.y = pk2(v[2], v[3]); o.z = pk2(v[4], v[5]); o.w = pk2(v[6], v[7]); *(u32x4*)(Cz + (size_t)n * 128 + 8 * c) = o; }
    __syncthreads();}

__device__ __forceinline__ void p0_mod_phase(LAS unsigned char* lds, const float* const* in, unsigned char* ws, int vcu, int G, int tid, int wid, int lane) {
    for (int it = vcu; it < 192; it += G) p0_mod_item(lds, in[1], in[2], in[3], in[4], (float*)(ws + WS_MOD), it, tid, wid, lane);
}
struct TrDesc { const float* src; bf16* dst; int ldw, K; const float* walpha; int acol; };
__device__ __forceinline__ TrDesc tr_decode(const float* const* in, unsigned char* ws, int it) {
    constexpr int I_IN = 16 * 168, I_OUT = 32 * 32, I_GLU = 8 * 16, I_L = I_IN + I_OUT + I_GLU;
    const int l = it / I_L; int r = it % I_L; TrDesc d; d.walpha = nullptr; d.acol = 0;
    if (r < I_IN) { const int nb = r % 168, kb = r / 168, n0 = nb * 32, sc = win_srccol(n0);
        const float* W = in[6] + (size_t)l * DM * WIN_COLS; bf16* WT = (bf16*)(ws + WS_WIN + (size_t)l * WIN_BYTES);
        d.ldw = WIN_COLS; d.K = DM; d.dst = WT + (size_t)n0 * DM + kb * 64;
        if (sc >= 0) d.src = W + (size_t)(kb * 64) * WIN_COLS + sc; else { d.src = W + (size_t)(kb * 64) * WIN_COLS + 3584; d.walpha = in[8] + (size_t)l * 16 * 256; d.acol = n0 - C_GL; }
        return d; }
    r -= I_IN;
    if (r < I_OUT) { const int nb = r % 32, kb = r / 32; d.ldw = DM; d.K = 2048; d.src = in[21] + (size_t)l * 2048 * DM + (size_t)(kb * 64) * DM + nb * 32; d.dst = (bf16*)(ws + WS_WOUT + (size_t)l * WOUT_BYTES) + (size_t)(nb * 32) * 2048 + kb * 64; return d; }
    r -= I_OUT;
    { const int nb = r % 16, kb = r / 16; d.ldw = 512; d.K = 512; d.src = in[19] + (size_t)l * 512 * 512 + (size_t)(kb * 64) * 512 + nb * 32; d.dst = (bf16*)(ws + WS_WGLU + (size_t)l * WGLU_BYTES) + (size_t)(nb * 32) * 512 + kb * 64; return d; }
}
__device__ __forceinline__ void tr_load(const TrDesc& d, f32x4 (&v)[8], int lane) {
    const int kr = lane >> 3, c4 = lane & 7;
#pragma unroll
    for (int i = 0; i < 8; ++i) v[i] = *(const f32x4*)(d.src + (size_t)(8 * i + kr) * d.ldw + 4 * c4);
}
__device__ __forceinline__ void tr_lds_fill(const TrDesc& d, const f32x4 (&v)[8], LAS float* scr, int lane) {
    if (d.walpha == nullptr) { const int kr = lane >> 3, c4 = lane & 7;
#pragma unroll
        for (int i = 0; i < 8; ++i) { LAS float* q = scr + (8 * i + kr) * 33 + 4 * c4; q[0] = v[i][0]; q[1] = v[i][1]; q[2] = v[i][2]; q[3] = v[i][3]; } }
    else {
        float wa[16];
#pragma unroll
        for (int r = 0; r < 16; ++r) wa[r] = d.walpha[r * 256 + d.acol + (lane & 31)];
#pragma unroll 4
        for (int i = 0; i < 32; ++i) { const int kk = 2 * i + (lane >> 5); const f32x4* wr = (const f32x4*)(d.src + (size_t)kk * d.ldw);
            const f32x4 w0 = wr[0], w1 = wr[1], w2 = wr[2], w3 = wr[3];
            float s = (w0[0] * wa[0] + w0[1] * wa[1]) + (w0[2] * wa[2] + w0[3] * wa[3]); s += (w1[0] * wa[4] + w1[1] * wa[5]) + (w1[2] * wa[6] + w1[3] * wa[7]);
            s += (w2[0] * wa[8] + w2[1] * wa[9]) + (w2[2] * wa[10] + w2[3] * wa[11]); s += (w3[0] * wa[12] + w3[1] * wa[13]) + (w3[2] * wa[14] + w3[3] * wa[15]);
            scr[kk * 33 + (lane & 31)] = s; } }
}
__device__ __forceinline__ void tr_store(const TrDesc& d, LAS float* scr, int lane) {
    const int c = lane & 7;
#pragma unroll
    for (int j = 0; j < 4; ++j) { const int n = (lane >> 3) + 8 * j; const LAS float* s = scr + (8 * c) * 33 + n;
        u32x4 o; o.x = pk2(s[0 * 33], s[1 * 33]); o.y = pk2(s[2 * 33], s[3 * 33]); o.z = pk2(s[4 * 33], s[5 * 33]); o.w = pk2(s[6 * 33], s[7 * 33]);
        *(u32x4*)(d.dst + (size_t)n * d.K + 8 * c) = o; }
}
__device__ __forceinline__ void p1_transposes(LAS unsigned char* lds, const float* const* in, unsigned char* ws, int gw, int NGW, int wid, int lane) {
    LAS float* scr = (LAS float*)(lds + wid * 16384);
    constexpr int NIT = NLAYER * (16 * 168 + 32 * 32 + 8 * 16);
    int it = gw; if (it >= NIT) return;
    TrDesc d = tr_decode(in, ws, it); f32x4 v[8];
    if (d.walpha == nullptr) tr_load(d, v, lane);
    for (;;) {
        tr_lds_fill(d, v, scr, lane);
        const int nx = it + NGW; TrDesc dn = d; const bool more = nx < NIT;
        if (more) { dn = tr_decode(in, ws, nx); if (dn.walpha == nullptr) tr_load(dn, v, lane); }
        LDS_WAIT(); asm volatile("" ::: "memory");
        tr_store(d, scr, lane);
        LDS_WAIT(); asm volatile("" ::: "memory");
        if (!more) break;
        d = dn; it = nx;
    }
}
__device__ __forceinline__ void prenorm_phase(const float* x, const float* mod  , bf16* H, int gw, int NGW, int lane) {
    f32x4 v[4], n1[4], n2[4];
    int m = gw; if (m >= TOK) return;
#pragma unroll
    for (int j = 0; j < 4; ++j) { v[j] = *(const f32x4*)(x + (size_t)m * DM + 256 * j + 4 * lane); n1[j] = v[j]; n2[j] = v[j]; }
    if (m + NGW < TOK) {
#pragma unroll
        for (int j = 0; j < 4; ++j) n1[j] = *(const f32x4*)(x + (size_t)(m + NGW) * DM + 256 * j + 4 * lane); }
    for (; m < TOK; m += NGW) {
        if (m + 2 * NGW < TOK) {
#pragma unroll
            for (int j = 0; j < 4; ++j) n2[j] = *(const f32x4*)(x + (size_t)(m + 2 * NGW) * DM + 256 * j + 4 * lane); }
        const int b = m / SEQ; const float* mb = mod + (size_t)b * 3072; f32x4 ga[4], sh[4]; float ss = 0.f;
#pragma unroll
        for (int j = 0; j < 4; ++j) { ss += (v[j][0] * v[j][0] + v[j][1] * v[j][1]) + (v[j][2] * v[j][2] + v[j][3] * v[j][3]); ga[j] = *(const f32x4*)(mb + 1024 + 256 * j + 4 * lane); sh[j] = *(const f32x4*)(mb + 256 * j + 4 * lane); }
        const float r = rsqrtf(wave_sum(ss) * (1.0f / DM) + EPS);
#pragma unroll
        for (int j = 0; j < 4; ++j) { const f32x4 o = v[j] * r * ga[j] + sh[j]; u32x2 w; w.x = pk2(o[0], o[1]); w.y = pk2(o[2], o[3]); *(u32x2*)(H + (size_t)m * DM + 256 * j + 4 * lane) = w; }
#pragma unroll
        for (int j = 0; j < 4; ++j) { v[j] = n1[j]; n1[j] = n2[j]; }
    }
}
__device__ __forceinline__ void post_phase(const float* xin, float* xout, const bf16* Y, const float* gpost, const float* mod  , bool do_next, const float* gpre_n, const float* mod_n, bf16* Hn,
                                           int vcu, int wid, int lane) {
    const int gw = vcu * NWAVES + wid; const int m0 = gw * 8, b = m0 / SEQ;
    if (m0 >= TOK) return;
    f32x4 gp[4], gt[4];
#pragma unroll
    for (int j = 0; j < 4; ++j) { const int col = 256 * j + 4 * lane; gp[j] = *(const f32x4*)(gpost + col); gt[j] = *(const f32x4*)(mod + (size_t)b * 3072 + 2048 + col); }
    u32x2 yw[4], nyw[4]; f32x4 xv[4], nxv[4];
#pragma unroll
    for (int j = 0; j < 4; ++j) { yw[j] = *(const u32x2*)(Y + (size_t)m0 * DM + 256 * j + 4 * lane); xv[j] = *(const f32x4*)(xin + (size_t)m0 * DM + 256 * j + 4 * lane); nyw[j] = yw[j]; nxv[j] = xv[j]; }
#pragma unroll 1
    for (int i = 0; i < 8; ++i) { const int m = m0 + i; f32x4 y[4]; float ss = 0.f;
        if (i < 7) {
#pragma unroll
            for (int j = 0; j < 4; ++j) { nyw[j] = *(const u32x2*)(Y + (size_t)(m + 1) * DM + 256 * j + 4 * lane); nxv[j] = *(const f32x4*)(xin + (size_t)(m + 1) * DM + 256 * j + 4 * lane); } }
#pragma unroll
        for (int j = 0; j < 4; ++j) { y[j] = (f32x4){bflo(yw[j].x), bfhi(yw[j].x), bflo(yw[j].y), bfhi(yw[j].y)}; ss += (y[j][0] * y[j][0] + y[j][1] * y[j][1]) + (y[j][2] * y[j][2] + y[j][3] * y[j][3]); }
        const float r = rsqrtf(wave_sum(ss) * (1.0f / DM) + EPS); float s2 = 0.f;
#pragma unroll
        for (int j = 0; j < 4; ++j) { xv[j] = xv[j] + gt[j] * (y[j] * r * gp[j]); *(f32x4*)(xout + (size_t)m * DM + 256 * j + 4 * lane) = xv[j];
            s2 += (xv[j][0] * xv[j][0] + xv[j][1] * xv[j][1]) + (xv[j][2] * xv[j][2] + xv[j][3] * xv[j][3]); }
        if (do_next) { const float r2 = rsqrtf(wave_sum(s2) * (1.0f / DM) + EPS);
#pragma unroll
            for (int j = 0; j < 4; ++j) { const int col = 256 * j + 4 * lane; const f32x4 ga = *(const f32x4*)(mod_n + (size_t)b * 3072 + 1024 + col), sh = *(const f32x4*)(mod_n + (size_t)b * 3072 + col);
                const f32x4 o = xv[j] * r2 * ga + sh; u32x2 w; w.x = pk2(o[0], o[1]); w.y = pk2(o[2], o[3]); *(u32x2*)(Hn + (size_t)m * DM + 256 * j + 4 * lane) = w; } }
#pragma unroll
        for (int j = 0; j < 4; ++j) { yw[j] = nyw[j]; xv[j] = nxv[j]; }
    }
}
typedef short v4i16_t __attribute__((ext_vector_type(4)));
__device__ __forceinline__ s16x4 vtr(LAS unsigned char* p) { return __builtin_bit_cast(s16x4, __builtin_amdgcn_ds_read_tr16_b64_v4i16((LAS v4i16_t*)p)); }
__device__ __forceinline__ void attn_item(LAS unsigned char* lds, bf16* P, const float* sinks, int item, int tid, int wid, int lane) {
    const int r32 = lane & 31, hi = lane >> 5;
    const int qblk = item & 31, kvh = (item >> 5) & 3, b = item >> 7, q0 = qblk * 128;
    const size_t rowbase = (size_t)b * SEQ;
    LAS unsigned char* Ks = lds; LAS unsigned char* Vs = lds + 32768; LAS float* ost = (LAS float*)(lds + 65536 + wid * 8704);
    { const int kr = tid >> 1, hf = tid & 1, key = q0 - 128 + kr; u32x4 kv[4], vv[4];
      if (key >= 0) { const bf16* src = P + (rowbase + key) * LDP + kvh * 64 + hf * 32;
#pragma unroll
          for (int c = 0; c < 4; ++c) { kv[c] = *(const u32x4*)(src + C_AK + c * 8); vv[c] = *(const u32x4*)(src + C_AV + c * 8); } }
      else {
#pragma unroll
          for (int c = 0; c < 4; ++c) { kv[c] = (u32x4){0u, 0u, 0u, 0u}; vv[c] = (u32x4){0u, 0u, 0u, 0u}; } }
#pragma unroll
      for (int c = 0; c < 4; ++c) { const int ch = hf * 4 + c; *(LAS u32x4*)(Ks + kr * 128 + ((ch ^ (kr & 7)) << 4)) = kv[c]; *(LAS u32x4*)(Vs + kr * 128 + (ch << 4)) = vv[c]; } }
    __syncthreads();
    const int g = wid >> 1, half = wid & 1, head = kvh * 4 + g;
    const float slope2 = exp2f(-0.5f * (float)(head + 1)) * LOG2E, sink2 = sinks[head] * LOG2E, C2 = 0.125f * LOG2E;
    const int q16 = (lane & 15) >> 2, p16 = lane & 3, dblk = (lane >> 4) & 1;
#pragma unroll 1
    for (int sb = 0; sb < 2; ++sb) {
        const int qs = q0 + half * 64 + sb * 32, lrow0 = half * 64 + sb * 32;
        const bf16* qp = P + (rowbase + qs + r32) * LDP + C_AQ + head * 64 + hi * 8;
        bf16x8 qf[4];
#pragma unroll
        for (int kk = 0; kk < 4; ++kk) qf[kk] = *(const bf16x8*)(qp + kk * 16);
        f32x16 S[5]; float m = sink2; int e = r32 - 4 * hi; asm volatile("" : "+v"(e)); const float ef = (float)e;
#pragma unroll
        for (int kt = 0; kt < 5; ++kt) { f32x16 acc;
#pragma unroll
            for (int r = 0; r < 16; ++r) acc[r] = 0.f;
            const int krow = lrow0 + 32 * kt + r32;
#pragma unroll
            for (int kk = 0; kk < 4; ++kk) { const int ch = 2 * kk + hi; const bf16x8 kf = *(const LAS bf16x8*)(Ks + krow * 128 + ((ch ^ (krow & 7)) << 4)); acc = MFMA32(kf, qf[kk], acc); }
            { const bool tile_ok = (qs - 128 + 32 * kt) >= 0;
              const float base = -slope2 * ((float)(128 - 32 * kt) + ef);
#pragma unroll
              for (int r = 0; r < 16; ++r) { const int cr = (r & 3) + 8 * (r >> 2);
                  const float s = fmaf(acc[r], C2, fmaf(slope2, (float)cr, base));
                  bool ok = tile_ok; if (kt == 0) ok = ok && (e < cr); if (kt == 4) ok = ok && (e >= cr);
                  S[kt][r] = ok ? s : -INFINITY; m = fmaxf(m, S[kt][r]); } }
            __builtin_amdgcn_sched_barrier(0); }
        m = fmaxf(m, __shfl_xor(m, 32));
        float l = 0.f;
#pragma unroll
        for (int kt = 0; kt < 5; ++kt)
#pragma unroll
            for (int r = 0; r < 16; ++r) { const float p = __builtin_amdgcn_exp2f(S[kt][r] - m); S[kt][r] = p; l += p; }
        l += __shfl_xor(l, 32); l += __builtin_amdgcn_exp2f(sink2 - m);
        const float inv_l = 1.0f / l;
        f32x16 o0, o1;
#pragma unroll
        for (int r = 0; r < 16; ++r) { o0[r] = 0.f; o1[r] = 0.f; }
#pragma unroll
        for (int kt = 0; kt < 5; ++kt)
#pragma unroll
            for (int ks = 0; ks < 2; ++ks) { u32x4 pw; pw.x = pk2(S[kt][8 * ks + 0], S[kt][8 * ks + 1]); pw.y = pk2(S[kt][8 * ks + 2], S[kt][8 * ks + 3]); pw.z = pk2(S[kt][8 * ks + 4], S[kt][8 * ks + 5]); pw.w = pk2(S[kt][8 * ks + 6], S[kt][8 * ks + 7]);
                const bf16x8 pa = __builtin_bit_cast(bf16x8, pw);
                LAS unsigned char* vb = Vs + (lrow0 + 32 * kt + 16 * ks + 4 * hi + q16) * 128 + dblk * 32 + p16 * 8;
                const s16x4 a0 = vtr(vb), a1 = vtr(vb + 8 * 128), b0 = vtr(vb + 64), b1 = vtr(vb + 64 + 8 * 128);
                const bf16x8 v0 = __builtin_shufflevector(a0, a1, 0, 1, 2, 3, 4, 5, 6, 7), v1 = __builtin_shufflevector(b0, b1, 0, 1, 2, 3, 4, 5, 6, 7);
                o0 = MFMA32(pa, v0, o0); o1 = MFMA32(pa, v1, o1); __builtin_amdgcn_sched_barrier(0); }
#pragma unroll
        for (int r = 0; r < 16; ++r) { const int qr = (r & 3) + 8 * (r >> 2) + 4 * hi; ost[qr * 68 + r32] = o0[r]; ost[qr * 68 + 32 + r32] = o1[r]; }
        asm volatile("" ::: "memory");
        { const int row = lane >> 1, hf = lane & 1; const float sc = __shfl(inv_l, row);
          bf16* rp = P + (rowbase + qs + row) * LDP + head * 64 + hf * 32;
#pragma unroll
          for (int c = 0; c < 4; ++c) { const u32x4 gv = *(const u32x4*)(rp + C_AG + 8 * c);
              const f32x4 x0 = *(const LAS f32x4*)(ost + row * 68 + hf * 32 + 8 * c), x1 = *(const LAS f32x4*)(ost + row * 68 + hf * 32 + 8 * c + 4);
              float gg[8] = {bflo(gv.x), bfhi(gv.x), bflo(gv.y), bfhi(gv.y), bflo(gv.z), bfhi(gv.z), bflo(gv.w), bfhi(gv.w)};
              float xx[8] = {x0[0], x0[1], x0[2], x0[3], x1[0], x1[1], x1[2], x1[3]};
#pragma unroll
              for (int e = 0; e < 8; ++e) xx[e] = xx[e] * sc * gg[e] * sigmoidf_(gg[e]);
              u32x4 w; w.x = pk2(xx[0], xx[1]); w.y = pk2(xx[2], xx[3]); w.z = pk2(xx[4], xx[5]); w.w = pk2(xx[6], xx[7]);
              *(u32x4*)(rp + C_AQ + 8 * c) = w; } }
        asm volatile("" ::: "memory");
    }
    __syncthreads();
}
constexpr int GL_QT = 0, GL_KT = 9216, GL_KH = 18432, GL_AT = 27648, GL_VT = 36864, GL_ST = 55296, GL_PART = 73728, GL_BL = 75776, GL_SS = 76032, GL_RS = 78080, GL_LD = 72;
__device__ __forceinline__ bf16x8 ldsfrag(LAS unsigned char* base, int row, int kof) { return *(const LAS bf16x8*)(base + (row * GL_LD + kof) * 2); }
template <bool OUT>
__device__ __forceinline__ void gla_item(LAS unsigned char* lds, bf16* P, const float* balpha, const float* gnorm, float* GE, float* GD, int item, int tid, int wid, int lane) {
    const int c16 = lane & 15, q = lane >> 4;
    const int b = item >> 6, hd = (item >> 4) & 3, seg = item & 15;
    const size_t row0 = (size_t)b * SEQ + seg * 256;
    LAS bf16* QT = (LAS bf16*)(lds + GL_QT); LAS bf16* KT = (LAS bf16*)(lds + GL_KT); LAS bf16* AT = (LAS bf16*)(lds + GL_AT); LAS bf16* ST = (LAS bf16*)(lds + GL_ST);
    LAS float* PART = (LAS float*)(lds + GL_PART); LAS float* BL = (LAS float*)(lds + GL_BL); LAS float* SS = (LAS float*)(lds + GL_SS); LAS float* RS = (LAS float*)(lds + GL_RS);
    f32x4 S[4];
#pragma unroll
    for (int nt = 0; nt < 4; ++nt) S[nt] = (f32x4){0.f, 0.f, 0.f, 0.f};
    if (OUT) {
#pragma unroll 1
        for (int sp = 0; sp < seg; ++sp) { const float* e = GE + (size_t)(item - seg + sp) * 8192; const float* dd = GD + (size_t)(item - seg + sp) * 64;
#pragma unroll
            for (int nt = 0; nt < 4; ++nt) { const float dec = dd[16 * nt + c16];
#pragma unroll
                for (int r = 0; r < 4; ++r) S[nt][r] = S[nt][r] * dec + e[(16 * wid + 4 * q + r) * 64 + 16 * nt + c16]; } } }
    float dtot = 0.f;
    const int d = tid & 63, part = tid >> 6;
    const float ba = balpha[hd * 64 + d];
#pragma unroll 1
    for (int ch = 0; ch < 4; ++ch) {
        const size_t rowc = row0 + ch * 64;
        float bcs[8]; float run = 0.f;
#pragma unroll
        for (int i = 0; i < 8; ++i) { const float x = bf2f(P[(rowc + part * 8 + i) * LDP + C_GL + hd * 64 + d]) + ba;
            const float la = (fminf(x, 0.f) - log1pf(__expf(-fabsf(x)))) * 0.0625f; run += la; bcs[i] = run; }
        PART[part * 64 + d] = run;
        __syncthreads();
        float off = 0.f, tot = 0.f;
#pragma unroll
        for (int p = 0; p < 8; ++p) { const float v = PART[p * 64 + d]; tot += v; off += (p < part) ? v : 0.f; }
        if (part == 0) { BL[d] = tot; dtot += tot; }
        { float kh[8];
#pragma unroll
          for (int i = 0; i < 8; ++i) { const float bi = off + bcs[i]; const int tok = part * 8 + i; const float kx = bf2f(P[(rowc + tok) * LDP + C_BK + hd * 64 + d]);
              if (OUT) { const float qx = bf2f(P[(rowc + tok) * LDP + C_BQ + hd * 64 + d]); QT[tok * GL_LD + d] = f2bf(qx * 0.125f * __expf(bi)); KT[tok * GL_LD + d] = f2bf(kx * __expf(-bi)); }
              kh[i] = kx * __expf(tot - bi); }
          u32x4 w; w.x = pk2(kh[0], kh[1]); w.y = pk2(kh[2], kh[3]); w.z = pk2(kh[4], kh[5]); w.w = pk2(kh[6], kh[7]);
          *(LAS u32x4*)(lds + GL_KH + (d * GL_LD + part * 8) * 2) = w; }
        { const int v = tid & 127, tp = tid >> 7; float vv[16];
#pragma unroll
          for (int i = 0; i < 16; ++i) vv[i] = bf2f(P[(rowc + tp * 16 + i) * LDP + C_BV + hd * 128 + v]);
          u32x4 w0, w1; w0.x = pk2(vv[0], vv[1]); w0.y = pk2(vv[2], vv[3]); w0.z = pk2(vv[4], vv[5]); w0.w = pk2(vv[6], vv[7]);
          w1.x = pk2(vv[8], vv[9]); w1.y = pk2(vv[10], vv[11]); w1.z = pk2(vv[12], vv[13]); w1.w = pk2(vv[14], vv[15]);
          *(LAS u32x4*)(lds + GL_VT + (v * GL_LD + tp * 16) * 2) = w0; *(LAS u32x4*)(lds + GL_VT + (v * GL_LD + tp * 16 + 8) * 2) = w1; }
        if (OUT) {
#pragma unroll
            for (int nt = 0; nt < 4; ++nt)
#pragma unroll
                for (int r = 0; r < 4; ++r) ST[(16 * wid + 4 * q + r) * GL_LD + 16 * nt + c16] = f2bf(S[nt][r]); }
        __syncthreads();
        if (OUT) {
            { const int mt = wid >> 1;
#pragma unroll
              for (int t = 0; t < 2; ++t) { const int nt = 2 * (wid & 1) + t; f32x4 acc = (f32x4){0.f, 0.f, 0.f, 0.f};
                  if (nt <= mt) {
#pragma unroll
                      for (int kk = 0; kk < 2; ++kk) acc = MFMA16(ldsfrag(lds + GL_QT, 16 * mt + c16, 32 * kk + 8 * q), ldsfrag(lds + GL_KT, 16 * nt + c16, 32 * kk + 8 * q), acc); }
#pragma unroll
                  for (int r = 0; r < 4; ++r) { const int i = 16 * mt + 4 * q + r, j = 16 * nt + c16; AT[i * GL_LD + j] = f2bf((j <= i) ? acc[r] : 0.f); } } }
            __syncthreads();
            f32x4 o[4];
#pragma unroll
            for (int mt = 0; mt < 4; ++mt) { f32x4 acc = (f32x4){0.f, 0.f, 0.f, 0.f};
#pragma unroll
                for (int kk = 0; kk < 2; ++kk) if (kk == 0 || mt >= 2) acc = MFMA16(ldsfrag(lds + GL_AT, 16 * mt + c16, 32 * kk + 8 * q), ldsfrag(lds + GL_VT, 16 * wid + c16, 32 * kk + 8 * q), acc);
#pragma unroll
                for (int kk = 0; kk < 2; ++kk) acc = MFMA16(ldsfrag(lds + GL_QT, 16 * mt + c16, 32 * kk + 8 * q), ldsfrag(lds + GL_ST, 16 * wid + c16, 32 * kk + 8 * q), acc);
                o[mt] = acc; }
#pragma unroll
            for (int mt = 0; mt < 4; ++mt)
#pragma unroll
                for (int r = 0; r < 4; ++r) { float s = o[mt][r] * o[mt][r]; s += __shfl_xor(s, 1); s += __shfl_xor(s, 2); s += __shfl_xor(s, 4); s += __shfl_xor(s, 8);
                    if (c16 == 0) SS[wid * 64 + 16 * mt + 4 * q + r] = s; }
            __syncthreads();
            if (tid < 64) { float t = 0.f;
#pragma unroll
                for (int w = 0; w < 8; ++w) t += SS[w * 64 + tid];
                RS[tid] = rsqrtf(t * (1.0f / 128.0f) + EPS); }
            __syncthreads();
            const float gn = gnorm[hd * 128 + 16 * wid + c16];
#pragma unroll
            for (int mt = 0; mt < 4; ++mt)
#pragma unroll
                for (int r = 0; r < 4; ++r) { const int i = 16 * mt + 4 * q + r; bf16* rp = P + (rowc + i) * LDP + hd * 128 + 16 * wid + c16; const float bg = bf2f(rp[C_BG]);
                    rp[C_BV] = f2bf(o[mt][r] * RS[i] * gn * bg * sigmoidf_(bg)); }
        }
#pragma unroll
        for (int nt = 0; nt < 4; ++nt) { const float dec = __expf(BL[16 * nt + c16]); f32x4 acc = S[nt] * dec;
#pragma unroll
            for (int kk = 0; kk < 2; ++kk) acc = MFMA16(ldsfrag(lds + GL_VT, 16 * wid + c16, 32 * kk + 8 * q), ldsfrag(lds + GL_KH, 16 * nt + c16, 32 * kk + 8 * q), acc);
            S[nt] = acc; }
        __syncthreads();
    }
    if (!OUT) {
#pragma unroll
        for (int nt = 0; nt < 4; ++nt)
#pragma unroll
            for (int r = 0; r < 4; ++r) GE[(size_t)item * 8192 + (16 * wid + 4 * q + r) * 64 + 16 * nt + c16] = S[nt][r];
        if (part == 0) GD[(size_t)item * 64 + d] = __expf(dtot);
    }
}
#ifndef PH_MASK
#define PH_MASK 0xffff
#endif
__device__ __forceinline__ void cmul_acc(float& hr, float& hi, float ar, float ai, float gr, float gi) { const float nr = ar * hr - ai * hi + gr, ni = ar * hi + ai * hr + gi; hr = nr; hi = ni; }
constexpr int S5_WB = 0, S5_CZ = 67584, S5_HS = 102400, S5_LDW = 264, S5_LDC = 136;
template <bool OUT>
__device__ __forceinline__ void s5_wg_item(LAS unsigned char* lds, bf16* P, const bf16* TzT, const bf16* BzT, const bf16* CzT, const float* tab, float* SE, int item, int tid, int wid, int lane) {
    const int c16 = lane & 15, q = lane >> 4;
    const int b = item >> 6, g = (item >> 1) & 31, seg = 8 * (item & 1) + wid;
    const int id = ((b * 32 + g) << 4) + seg;
    const size_t tok0 = (size_t)b * SEQ + seg * 256;
    LAS unsigned char* wscr = lds + S5_HS + wid * 4352;
    bf16x8 uf[8];
#pragma unroll
    for (int kk = 0; kk < 8; ++kk) uf[kk] = *(const bf16x8*)(P + (tok0 + 16 * c16 + 2 * kk + (q >> 1)) * LDP + C_CU + 16 * g + 8 * (q & 1));
    { const bf16* bz = BzT + (size_t)g * 32768; u32x4 t[8];
#pragma unroll
      for (int i = 0; i < 8; ++i) t[i] = *(const u32x4*)(bz + (size_t)(tid + 512 * i) * 8);
#pragma unroll
      for (int i = 0; i < 8; ++i) { const int pc = tid + 512 * i; *(LAS u32x4*)(lds + S5_WB + (pc >> 5) * (S5_LDW * 2) + (pc & 31) * 16) = t[i]; } }
    __syncthreads();
    f32x4 G[8];
#pragma unroll
    for (int nt = 0; nt < 8; ++nt) { f32x4 acc = (f32x4){0.f, 0.f, 0.f, 0.f};
#pragma unroll
        for (int kk = 0; kk < 8; ++kk) acc = MFMA16(uf[kk], *(const LAS bf16x8*)(lds + S5_WB + ((16 * nt + c16) * S5_LDW + 32 * kk + 8 * q) * 2), acc);
        G[nt] = acc; }
    const float* tg = tab + (size_t)g * 6 * 64;
    float a16r[4], a16i[4], a64r[4], a64i[4];
#pragma unroll
    for (int n4 = 0; n4 < 4; ++n4) { const int p = 16 * n4 + c16; a16r[n4] = tg[0 * 64 + p]; a16i[n4] = tg[1 * 64 + p]; a64r[n4] = tg[2 * 64 + p]; a64i[n4] = tg[3 * 64 + p]; }
    float er[4], ei[4], ir[4], ii[4], cr[4], ci[4];
#pragma unroll
    for (int n4 = 0; n4 < 4; ++n4) { float hr = 0.f, hi = 0.f;
#pragma unroll
        for (int r = 0; r < 4; ++r) cmul_acc(hr, hi, a16r[n4], a16i[n4], G[n4][r], G[n4 + 4][r]);
        er[n4] = hr; ei[n4] = hi; ir[n4] = hr; ii[n4] = hi; }
#pragma unroll
    for (int s = 1; s < 4; ++s)
#pragma unroll
        for (int n4 = 0; n4 < 4; ++n4) { const float vr = __shfl(ir[n4], (lane - 16) & 63), vi = __shfl(ii[n4], (lane - 16) & 63);
            if (q == s) { ir[n4] = a64r[n4] * vr - a64i[n4] * vi + er[n4]; ii[n4] = a64r[n4] * vi + a64i[n4] * vr + ei[n4]; } }
#pragma unroll
    for (int n4 = 0; n4 < 4; ++n4) { const float vr = __shfl(ir[n4], (lane - 16) & 63), vi = __shfl(ii[n4], (lane - 16) & 63); cr[n4] = (q > 0) ? vr : 0.f; ci[n4] = (q > 0) ? vi : 0.f; }
    if (!OUT) {
        if (q == 3) {
#pragma unroll
            for (int n4 = 0; n4 < 4; ++n4) { SE[(size_t)id * 128 + 16 * n4 + c16] = ir[n4]; SE[(size_t)id * 128 + 64 + 16 * n4 + c16] = ii[n4]; } }
        __syncthreads();
        return;
    }
    float hinr[4] = {0.f, 0.f, 0.f, 0.f}, hini[4] = {0.f, 0.f, 0.f, 0.f};
    { float a256r[4], a256i[4];
#pragma unroll
      for (int n4 = 0; n4 < 4; ++n4) { const int p = 16 * n4 + c16; a256r[n4] = tg[4 * 64 + p]; a256i[n4] = tg[5 * 64 + p]; }
#pragma unroll 1
      for (int s0 = 0; s0 < seg; s0 += 4) { float evr[4][4], evi[4][4];
#pragma unroll
          for (int u = 0; u < 4; ++u) { const int sp = (s0 + u < seg) ? s0 + u : seg - 1; const float* e = SE + (size_t)(id - seg + sp) * 128;
#pragma unroll
              for (int n4 = 0; n4 < 4; ++n4) { evr[u][n4] = e[16 * n4 + c16]; evi[u][n4] = e[64 + 16 * n4 + c16]; } }
#pragma unroll
          for (int u = 0; u < 4; ++u) if (s0 + u < seg) {
#pragma unroll
              for (int n4 = 0; n4 < 4; ++n4) cmul_acc(hinr[n4], hini[n4], a256r[n4], a256i[n4], evr[u][n4], evi[u][n4]); } } }
    LAS bf16* Hs = (LAS bf16*)wscr;
#pragma unroll
    for (int n4 = 0; n4 < 4; ++n4) {
        float pr = 1.f, pi = 0.f;
#pragma unroll
        for (int i = 0; i < 3; ++i) if (i < q) { const float nr = pr * a64r[n4] - pi * a64i[n4], ni = pr * a64i[n4] + pi * a64r[n4]; pr = nr; pi = ni; }
        float hr = pr * hinr[n4] - pi * hini[n4] + cr[n4], hi = pr * hini[n4] + pi * hinr[n4] + ci[n4];
#pragma unroll
        for (int r = 0; r < 4; ++r) { Hs[(4 * q + r) * 136 + 16 * n4 + c16] = f2bf(hr); Hs[(4 * q + r) * 136 + 64 + 16 * n4 + c16] = f2bf(hi);
            cmul_acc(hr, hi, a16r[n4], a16i[n4], G[n4][r], G[n4 + 4][r]); } }
    asm volatile("" ::: "memory");
    bf16x8 hf[4];
#pragma unroll
    for (int kk = 0; kk < 4; ++kk) hf[kk] = *(const LAS bf16x8*)(wscr + (c16 * 136 + 32 * kk + 8 * q) * 2);
    const bf16* tz = TzT + (size_t)g * 65536; const bf16* cz = CzT + (size_t)g * 32768;
    unsigned ypk[16][2];
#pragma unroll
    for (int hl = 0; hl < 2; ++hl) {
        __syncthreads();
        { u32x4 t[8], tc[4];
          if (hl == 0) {
#pragma unroll
              for (int i = 0; i < 4; ++i) { const int pc = tid + 512 * i; t[i] = *(const u32x4*)(tz + (size_t)(pc >> 4) * 256 + (pc & 15) * 8); }
          } else {
#pragma unroll
              for (int i = 0; i < 8; ++i) { const int pc = tid + 512 * i; t[i] = *(const u32x4*)(tz + (size_t)(128 + (pc >> 5)) * 256 + (pc & 31) * 8); } }
#pragma unroll
          for (int i = 0; i < 4; ++i) { const int pc = tid + 512 * i; tc[i] = *(const u32x4*)(cz + (size_t)(128 * hl + (pc >> 4)) * 128 + (pc & 15) * 8); }
          if (hl == 0) {
#pragma unroll
              for (int i = 0; i < 4; ++i) { const int pc = tid + 512 * i; *(LAS u32x4*)(lds + S5_WB + (pc >> 4) * (S5_LDW * 2) + (pc & 15) * 16) = t[i]; }
          } else {
#pragma unroll
              for (int i = 0; i < 8; ++i) { const int pc = tid + 512 * i; *(LAS u32x4*)(lds + S5_WB + (pc >> 5) * (S5_LDW * 2) + (pc & 31) * 16) = t[i]; } }
#pragma unroll
          for (int i = 0; i < 4; ++i) { const int pc = tid + 512 * i; *(LAS u32x4*)(lds + S5_CZ + (pc >> 4) * (S5_LDC * 2) + (pc & 15) * 16) = tc[i]; } }
        __syncthreads();
#pragma unroll
        for (int n8 = 0; n8 < 8; ++n8) { const int nt = 8 * hl + n8; f32x4 acc = (f32x4){0.f, 0.f, 0.f, 0.f};
#pragma unroll
            for (int kk = 0; kk < 8; ++kk) if (kk <= (nt >> 1)) acc = MFMA16(uf[kk], *(const LAS bf16x8*)(lds + S5_WB + ((16 * n8 + c16) * S5_LDW + 32 * kk + 8 * q) * 2), acc);
#pragma unroll
            for (int kk = 0; kk < 4; ++kk) acc = MFMA16(hf[kk], *(const LAS bf16x8*)(lds + S5_CZ + ((16 * n8 + c16) * S5_LDC + 32 * kk + 8 * q) * 2), acc);
            float yv[4];
#pragma unroll
            for (int r = 0; r < 4; ++r) { const float y = acc[r], u2 = 1.5957691216057308f * (y + 0.044715f * y * y * y); yv[r] = y * sigmoidf_(u2); }
            ypk[nt][0] = pk2(yv[0], yv[1]); ypk[nt][1] = pk2(yv[2], yv[3]); }
    }
    __syncthreads();
    LAS bf16* Ys = (LAS bf16*)(lds + S5_WB + wid * 8192);
#pragma unroll
    for (int nt = 0; nt < 16; ++nt)
#pragma unroll
        for (int r = 0; r < 4; ++r) Ys[(16 * (4 * q + r) + nt) * 16 + c16] = (bf16)((r & 1) ? (ypk[nt][r >> 1] >> 16) : (ypk[nt][r >> 1] & 0xffffu));
    asm volatile("" ::: "memory");
#pragma unroll
    for (int i = 0; i < 8; ++i) { const int pc = lane + 64 * i, tk = pc >> 1, hf2 = pc & 1;
        *(u32x4*)(P + (tok0 + tk) * LDP + C_CU + 16 * g + 8 * hf2) = *(const LAS u32x4*)(lds + S5_WB + wid * 8192 + pc * 16); }
    __syncthreads();
}

template <bool SECOND>
#ifndef PROBE_TYPE
#define PROBE_TYPE -1
#endif
#define PBX(t) do { if ((t) == PROBE_TYPE) px_t0 = __builtin_amdgcn_s_memrealtime(); } while (0)
#define PEX(t) do { if ((t) == PROBE_TYPE) pacc += __builtin_amdgcn_s_memrealtime() - px_t0; } while (0)
__device__ __forceinline__ void mixers_phase(LAS unsigned char* lds, const float* const* in, unsigned char* ws, bf16* P, int l, int vcu, int G, int tid, int wid, int lane, unsigned long long& pacc) {
    unsigned long long px_t0 = 0; (void)px_t0;
    PBX(10); if (!SECOND && (PH_MASK & 0x100)) for (int it = vcu; it < 256; it += G) attn_item(lds, P, in[7] + l * 16, it, tid, wid, lane);
    PEX(10);
    float* GE = (float*)(ws + WS_GLAE); float* GD = (float*)(ws + WS_GLAD); float* SE = (float*)(ws + WS_S5E);
    const float* balpha = in[9] + l * 256; const float* gnorm = in[10] + l * 512;
    int tid1 = tid; asm volatile("" : "+v"(tid1));
    PBX(SECOND ? 13 : 11); if (PH_MASK & 0x200) for (int it = vcu; it < 256; it += G) gla_item<SECOND>(lds, P, balpha, gnorm, GE, GD, it, tid1, wid, tid1 & 63);
    PEX(SECOND ? 13 : 11);
    const bf16* TzT = (const bf16*)(ws + WS_S5M + (size_t)l * S5M_BYTES + S5M_TZ); const bf16* BzT = (const bf16*)(ws + WS_S5M + (size_t)l * S5M_BYTES + S5M_BZ);
    const bf16* CzT = (const bf16*)(ws + WS_S5M + (size_t)l * S5M_BYTES + S5M_CZ); const float* tab = (const float*)(ws + WS_TAB) + (size_t)l * 32 * 6 * 64;
    int tid2 = tid; asm volatile("" : "+v"(tid2));
    PBX(SECOND ? 14 : 12); if (PH_MASK & 0x400) for (int it = vcu; it < 256; it += G) s5_wg_item<SECOND>(lds, P, TzT, BzT, CzT, tab, SE, it, tid2, wid, tid2 & 63);
    PEX(SECOND ? 14 : 12);
}
#ifndef MK_MULTI
#define MK_MULTI 0
#endif
constexpr int N_PHASES = 2 + 6 * NLAYER;
struct Args { const float* in[22]; float* out; unsigned char* ws; int ph_lo, ph_hi; };
__global__ void __launch_bounds__(NWAVES * 64, 2) hybrid_fwd(Args args_) {
    extern __shared__ __attribute__((aligned(16))) unsigned char lds_raw[];
    const int G = gridDim.x; const int bx = blockIdx.x; const int vcu = (G % 8 == 0) ? (bx % 8) * (G / 8) + bx / 8 : bx;
    XcdBarrier bar;
    { LAS unsigned char* lds0 = (LAS unsigned char*)lds_raw;
      volatile LAS unsigned* MISC = (volatile LAS unsigned*)(lds0 + MISC_OFF);
      for (int u = threadIdx.x; u < (LDS_BYTES - LDSCTL_OFF) / 4; u += NWAVES * 64) ((LAS unsigned*)(lds0 + LDSCTL_OFF))[u] = 0u;
      __syncthreads();
      bar.bar = (unsigned*)(args_.ws + WS_CTL) + CW_BAR; bar.x = 0; bar.st = nullptr;
      if (!MK_MULTI) bar = xcd_barrier_post((unsigned*)(args_.ws + WS_CTL) + CW_BAR, MISC + 8); }
    const int lo = args_.ph_lo, hi = args_.ph_hi;
#ifndef PROBE_TYPE
#define PROBE_TYPE -1
#endif
#ifndef PROBE_K
#define PROBE_K 4
#endif
#ifndef PROBE_BLOCK
#define PROBE_BLOCK 0
#endif
    unsigned long long pr_acc = 0, pr_t0 = 0; (void)pr_t0;
#define PB(t) do { if ((t) == PROBE_TYPE) pr_t0 = __builtin_amdgcn_s_memrealtime(); } while (0)
#define PE(t) do { if ((t) == PROBE_TYPE) pr_acc += __builtin_amdgcn_s_memrealtime() - pr_t0; } while (0)
#define IN(k) (lo <= (k) && (k) < hi)
#if MK_MULTI
#define SEAM(k) do { } while (0)
#else
#define SEAM(k) do { if (IN(k) && IN((k) + 1)) xcd_barrier(bar); } while (0)
#endif
#define PHASE_IDS typedef const Args __attribute__((address_space(4)))* kargp_t; kargp_t ap = (kargp_t)__builtin_amdgcn_kernarg_segment_ptr(); asm volatile("" : "+s"(ap)); const Args& args = *(const Args*)ap; \
        int tid = threadIdx.x; asm volatile("" : "+v"(tid)); const int lane = tid & 63, wid = __builtin_amdgcn_readfirstlane(tid >> 6); (void)lane; (void)wid; \
        LAS unsigned char* lds = (LAS unsigned char*)lds_raw; asm volatile("" : "+s"(lds)); unsigned char* ws = args.ws; \
        bf16* const P = (bf16*)(ws + WS_P); bf16* const H = (bf16*)(ws + WS_H); float* const MOD = (float*)(ws + WS_MOD); (void)P; (void)H; (void)MOD;
#ifndef PH_MASK
#define PH_MASK 0xffff
#endif
    PB(0); if (IN(0) && (PH_MASK & 1)) { PHASE_IDS p0_mod_phase(lds, args.in, ws, vcu, G, tid, wid, lane); }
    SEAM(0); PE(0);
    PB(1); if (IN(1) && (PH_MASK & 2)) { PHASE_IDS
        if (G == 256) { if (vcu < 64) { PB(20); p0_s5_item(lds, args.in, ws, vcu >> 5, vcu & 31, tid); PE(20); }
                        else { const int gw = (vcu - 64) * NWAVES + wid; PB(21); p1_transposes(lds, args.in, ws, gw, 192 * NWAVES, wid, lane); __syncthreads(); PE(21); PB(25); prenorm_phase(args.in[0], MOD, H, gw, 192 * NWAVES, lane); __syncthreads(); PE(25); } }
        else { for (int it = vcu; it < 64; it += G) p0_s5_item(lds, args.in, ws, it >> 5, it & 31, tid);
               const int gw = vcu * NWAVES + wid; p1_transposes(lds, args.in, ws, gw, G * NWAVES, wid, lane); prenorm_phase(args.in[0], MOD, H, gw, G * NWAVES, lane); } }
    SEAM(1); PE(1);
#define LAYER(l, base) \
    PB(2); if (IN(base + 0) && (PH_MASK & 4)) { PHASE_IDS \
        pg8::Gemm g{H, (const bf16*)(ws + WS_WIN + (size_t)l * WIN_BYTES), TOK, LDP, DM, DM}; pg8::StaticOrder S; S.init(TOK, LDP, G, bx); \
        pg8::EpiBf16<0> E{P, LDP, nullptr, 0, 0, 1.f}; \
        pg8::gemm_phase<pg8::EpiBf16<0>, pg8::StaticOrder, true, true>(lds, g, S, E, tid); } \
    SEAM(base + 0); PE(2); \
    PB(3); if (IN(base + 1) && (PH_MASK & 8)) { PHASE_IDS mixers_phase<false>(lds, args.in, ws, P, l, vcu, G, tid, wid, lane, pr_acc); } \
    SEAM(base + 1); PE(3); \
    PB(4); if (IN(base + 2) && (PH_MASK & 8)) { PHASE_IDS mixers_phase<true>(lds, args.in, ws, P, l, vcu, G, tid, wid, lane, pr_acc); } \
    SEAM(base + 2); PE(4); \
    PB(5); if (IN(base + 3) && (PH_MASK & 16)) { PHASE_IDS \
        pg8::Gemm g{P + C_CU, (const bf16*)(ws + WS_WGLU + (size_t)l * WGLU_BYTES), TOK, 512, 512, LDP}; pg8::StaticOrder S; S.init(TOK, 512, G, bx); \
        pg8::EpiGlu E{P, LDP, C_CU, C_CG, args.in[20] + l * 512}; \
        PB(15); if (PH_MASK & 0x800) pg8::gemm_phase<pg8::EpiGlu, pg8::StaticOrder, true, true>(lds, g, S, E, tid); PE(15); PB(16); \
        if (!(PH_MASK & 0x1000)) {} else if (G == 256) { if (bx >= 128) { attn_item(lds, P, args.in[7] + l * 16, 256 + 2 * (bx - 128), tid, wid, lane); attn_item(lds, P, args.in[7] + l * 16, 257 + 2 * (bx - 128), tid, wid, lane); } } \
        else for (int it = 256 + vcu; it < 512; it += G) attn_item(lds, P, args.in[7] + l * 16, it, tid, wid, lane); PE(16); } \
    SEAM(base + 3); PE(5); \
    PB(6); if (IN(base + 4) && (PH_MASK & 32)) { PHASE_IDS \
        pg8::Gemm g{P, (const bf16*)(ws + WS_WOUT + (size_t)l * WOUT_BYTES), TOK, DM, 2048, LDP}; pg8::StaticOrder S; S.init(TOK, DM, G, bx); \
        pg8::EpiBf16<0> E{H, DM, nullptr, 0, 0, 1.f}; \
        pg8::gemm_phase<pg8::EpiBf16<0>, pg8::StaticOrder, true, true>(lds, g, S, E, tid); } \
    SEAM(base + 4); PE(6); \
    PB(7); if (IN(base + 5) && (PH_MASK & 64)) { PHASE_IDS \
        post_phase(l == 0 ? args.in[0] : args.out, args.out, H, args.in[5] + l * DM, MOD + (size_t)l * 4 * 3072, (l + 1 < NLAYER), args.in[4] + (l + 1 < NLAYER ? l + 1 : l) * DM, MOD + (size_t)(l + 1 < NLAYER ? l + 1 : l) * 4 * 3072, H, vcu, wid, lane); } \
    SEAM(base + 5); PE(7);
    LAYER(0, 2)
    LAYER(1, 8)
#undef LAYER
    if (PROBE_TYPE >= 0 && blockIdx.x == PROBE_BLOCK) { const unsigned long long te = __builtin_amdgcn_s_memrealtime(); while (__builtin_amdgcn_s_memrealtime() - te < (unsigned long long)PROBE_K * pr_acc) __builtin_amdgcn_s_sleep(20); }
#undef IN
#undef SEAM
}

extern "C" void kernel_launch(void* const* d_in, const int* in_sizes, int n_in, void* d_out, int out_size, void* d_ws, size_t ws_size, hipStream_t stream) {
    static int grid = 0;
    if (grid == 0) {
        if (n_in != 22 || in_sizes[0] != TOK * DM || out_size != TOK * DM || ws_size < WS_END) { fprintf(stderr, "kernel_launch: unexpected shapes (n_in %d, in0 %d, out %d, ws %zu)\n", n_in, n_in > 0 ? in_sizes[0] : -1, out_size, ws_size); grid = -1; return; }
        int dev = 0, cus = 0;
        if (hipGetDevice(&dev) != hipSuccess || hipDeviceGetAttribute(&cus, hipDeviceAttributeMultiprocessorCount, dev) != hipSuccess) { grid = -1; return; }
        if (hipFuncSetAttribute((const void*)hybrid_fwd, hipFuncAttributeMaxDynamicSharedMemorySize, LDS_BYTES) != hipSuccess) { fprintf(stderr, "kernel_launch: hipFuncSetAttribute failed\n"); grid = -1; return; }
        (void)hipGetLastError();
        grid = cus;
    }
    if (grid < 0) return;
    if (hipMemsetAsync((char*)d_ws + WS_CTL, 0, CTL_ZERO_BYTES, stream) != hipSuccess) { fprintf(stderr, "kernel_launch: memset failed\n"); return; }
    Args a{};
    for (int i = 0; i < 22; ++i) a.in[i] = (const float*)d_in[i];
    a.out = (float*)d_out; a.ws = (unsigned char*)d_ws;
#if MK_MULTI
    for (int ph = 0; ph < N_PHASES; ++ph) { a.ph_lo = ph; a.ph_hi = ph + 1; hipLaunchKernelGGL(hybrid_fwd, dim3(grid), dim3(NWAVES * 64), LDS_BYTES, stream, a); }
#else
    a.ph_lo = 0; a.ph_hi = N_PHASES;
    hipLaunchKernelGGL(hybrid_fwd, dim3(grid), dim3(NWAVES * 64), LDS_BYTES, stream, a);
#endif
    const hipError_t le = hipPeekAtLastError();
    if (le != hipSuccess) fprintf(stderr, "kernel_launch: launch failed: %s\n", hipGetErrorName(le));
}
```

```cpp
#include <hip/hip_runtime.h>
#include <cstdio>
#include <cstdint>
#include <cmath>
#define MK_MULTI 0
namespace pg8 {
#define PG8_LAS __attribute__((address_space(3)))
typedef unsigned short bf16_t;
typedef short bf16x8 __attribute__((ext_vector_type(8)));
typedef float f32x4 __attribute__((ext_vector_type(4)));
typedef unsigned u32x4 __attribute__((ext_vector_type(4)));
constexpr int BM = 256, BK = 64, HALF = 128, HTB = HALF * BK * 2  , STAGE_BYTES = 8 * HTB, NXCD = 8, WGM = 8;

__host__ __device__ __forceinline__ int lds_byte(int r, int c) { const int st = (r >> 4) * 2 + (c >> 5), rr = r & 15, cc = c & 31, ob = rr * 64 + cc * 2; return st * 1024 + (ob ^ (((ob >> 9) & 1) << 5)); }
__host__ __device__ __forceinline__ void stage_rc(int b, int& R, int& C) { const int st = b / 1024, sb = b % 1024, swz = sb ^ (((sb >> 9) & 1) << 5); R = (st >> 1) * 16 + swz / 64; C = (st & 1) * 32 + (swz % 64) / 2; }
__host__ __device__ __forceinline__ int perm32(int rho) { const int n = rho >> 4, i = rho & 15; return 8 * (i >> 2) + 4 * n + (i & 3); }

struct Unit { int pm, pn; };
struct Gemm { const bf16_t* A; const bf16_t* Bt; int M, N, K, lda; };

struct StaticOrder {
    int nM, nN, nwg, G, c;
    __host__ __device__ void init(int M, int N, int G_, int c_) { nM = M / BM; nN = N / BM; nwg = nM * nN; G = G_; c = c_; }
    __host__ __device__ bool next(int i, Unit& u) const {
        const long L = (long)i * G + c; if (L >= nwg) return false;
        int wgid = (int)L; { const int q = nwg / NXCD, r = nwg % NXCD, xcd = wgid % NXCD, off = wgid / NXCD; wgid = (xcd < r ? xcd * (q + 1) : r * (q + 1) + (xcd - r) * q) + off; }
        const int nig = WGM * nN, gid = wgid / nig, fm = gid * WGM, gsz = (nM - fm) < WGM ? (nM - fm) : WGM;
        u.pm = fm + ((wgid % nig) % gsz); u.pn = (wgid % nig) / gsz; return true;
    }
    __device__ __forceinline__ void a_ready(const Unit&) const {}
    __device__ __forceinline__ void done(const Unit&) const {}
};

__device__ __forceinline__ unsigned cvt_pk_bf16(float lo, float hi) { unsigned r; asm volatile("v_cvt_pk_bf16_f32 %0, %1, %2" : "=v"(r) : "v"(lo), "v"(hi)); return r; }
typedef float f32x2 __attribute__((ext_vector_type(2)));
__device__ __forceinline__ f32x2 gelu_pk(f32x2 v) {
    const f32x2 av = __builtin_elementwise_abs(v), d = av * 0.2316418882f + 1.0f;
    f32x2 t; t.x = __builtin_amdgcn_rcpf(d.x); t.y = __builtin_amdgcn_rcpf(d.y);
    f32x2 q = t * 0.5307027145f + (-0.7265760135f); q = q * t + 0.7107068705f; q = q * t + (-0.142248368f); q = q * t + 0.127414796f; q = q * t;
    const f32x2 s = (v * v) * (-0.72134752044f);
    f32x2 e; e.x = __builtin_amdgcn_exp2f(s.x); e.y = __builtin_amdgcn_exp2f(s.y);
    const f32x2 m = v * (q * e), r = v - m;
    f32x2 o; o.x = v.x < 0.f ? m.x : r.x; o.y = v.y < 0.f ? m.y : r.y; return o;
}

template <int ACT  > struct EpiBf16 {
    static constexpr bool PERM = true, AFTER_DRAIN = false; static_assert(ACT == 0 || ACT == 1, "EpiBf16: ACT is 0 (none) or 1 (gelu_pk)");
    bf16_t* O; int ldc; const float* bias; int split_cols; size_t split_stride; float scale0;
    __device__ __forceinline__ void operator()(const f32x4 (&acc)[2][2][4][2], const Unit& u, int wr, int wc, int fr, int fq) const {
        const int row0 = u.pm * BM + wr * 64 + fr; int colt = u.pn * BM; bf16_t* base = O;
        float sc = 1.f; if (split_cols) { const int t = colt / split_cols; base += (size_t)t * split_stride; colt -= t * split_cols; if (t == 0) sc = scale0; }
        const int col0 = colt + wc * 32 + 8 * fq, bcol0 = u.pn * BM + wc * 32 + 8 * fq;
        f32x4 bv[2][2];
#pragma unroll
        for (int bj = 0; bj < 2; ++bj)
#pragma unroll
            for (int n = 0; n < 2; ++n) bv[bj][n] = bias ? *(const f32x4*)(bias + bcol0 + bj * HALF + 4 * n) : (f32x4){0.f, 0.f, 0.f, 0.f};
#pragma unroll
        for (int ai = 0; ai < 2; ++ai)
#pragma unroll
            for (int m = 0; m < 4; ++m) { bf16_t* rowp = base + (size_t)(row0 + ai * HALF + m * 16) * ldc + col0;
#pragma unroll
                for (int bj = 0; bj < 2; ++bj) { f32x4 v0 = acc[ai][bj][m][0] + bv[bj][0], v1 = acc[ai][bj][m][1] + bv[bj][1];
                    if (ACT == 1) { f32x2 a = gelu_pk((f32x2){v0[0], v0[1]}), b = gelu_pk((f32x2){v0[2], v0[3]}), c = gelu_pk((f32x2){v1[0], v1[1]}), d = gelu_pk((f32x2){v1[2], v1[3]});
                        v0 = (f32x4){a.x, a.y, b.x, b.y}; v1 = (f32x4){c.x, c.y, d.x, d.y}; }
                    v0 = v0 * sc; v1 = v1 * sc; u32x4 w; w.x = cvt_pk_bf16(v0[0], v0[1]); w.y = cvt_pk_bf16(v0[2], v0[3]); w.z = cvt_pk_bf16(v1[0], v1[1]); w.w = cvt_pk_bf16(v1[2], v1[3]);
                    *(u32x4*)(rowp + bj * HALF) = w; } }
    }
};
struct EpiGlu {
    static constexpr bool PERM = true, AFTER_DRAIN = false;
    bf16_t* P; int ldp, col_y, col_g; const float* bglu;
    __device__ __forceinline__ void operator()(const f32x4 (&acc)[2][2][4][2], const Unit& u, int wr, int wc, int fr, int fq) const {
        const int row0 = u.pm * BM + wr * 64 + fr; const int col0 = u.pn * BM + wc * 32 + 8 * fq;
#pragma unroll
        for (int ai = 0; ai < 2; ++ai)
#pragma unroll
            for (int m = 0; m < 4; ++m) { bf16_t* rowp = P + (size_t)(row0 + ai * HALF + m * 16) * ldp;
#pragma unroll
                for (int bj = 0; bj < 2; ++bj) { const int col = col0 + bj * HALF;
                    const f32x4 b0 = *(const f32x4*)(bglu + col), b1 = *(const f32x4*)(bglu + col + 4);
                    const u32x4 yv = *(const u32x4*)(rowp + col_y + col), gv = *(const u32x4*)(rowp + col_g + col);
                    const f32x4 z0 = acc[ai][bj][m][0] + b0, z1 = acc[ai][bj][m][1] + b1;
                    float z[8] = {z0[0], z0[1], z0[2], z0[3], z1[0], z1[1], z1[2], z1[3]}; float o[8];
#pragma unroll
                    for (int e = 0; e < 8; ++e) { const unsigned yw = yv[e >> 1], gw = gv[e >> 1];
                        const float y = __uint_as_float((e & 1) ? (yw & 0xffff0000u) : (yw << 16)), g = __uint_as_float((e & 1) ? (gw & 0xffff0000u) : (gw << 16));
                        const float sz = __builtin_amdgcn_rcpf(1.0f + __expf(-z[e])), sg = __builtin_amdgcn_rcpf(1.0f + __expf(-g));
                        o[e] = y * sz * g * sg; }
                    u32x4 w; w.x = cvt_pk_bf16(o[0], o[1]); w.y = cvt_pk_bf16(o[2], o[3]); w.z = cvt_pk_bf16(o[4], o[5]); w.w = cvt_pk_bf16(o[6], o[7]);
                    *(u32x4*)(rowp + col_g + col) = w; } }
    }
};
template <class Epi, class Sched, bool ALIGN_EPI = false, bool SP2 = false>
__device__ __forceinline__ void gemm_phase(PG8_LAS unsigned char* lds, const Gemm g, const Sched& S, const Epi& E, int tid_in) {
    const int tid = tid_in, wid = __builtin_amdgcn_readfirstlane(tid >> 6), lane = tid & 63, wr = wid >> 2, wc = wid & 3, fr = lane & 15, fq = lane >> 4;
    const int K = g.K, nt = K / BK;
    unsigned voffA[2], voffB[2];
#pragma unroll
    for (int i = 0; i < 2; ++i) { int R, C; stage_rc(tid * 16 + i * 8192, R, C); const int Rb = Epi::PERM ? ((R & ~31) + perm32(R & 31)) : R;
        voffA[i] = (unsigned)(R * g.lda + C) * 2u; voffB[i] = (unsigned)(Rb * K + C) * 2u; }
    const size_t kstep = (size_t)(BK * 2);
    const size_t hstepB = (size_t)HALF * K * 2, hstepA = (size_t)HALF * g.lda * 2;
    const size_t tstepB = 2 * hstepB, tstepA = 2 * hstepA;
    const unsigned ldsw = (unsigned)wid * 1024u;
    const int aoff = lds_byte(wr * 64 + fr, fq * 8), boff = lds_byte(wc * 32 + fr, fq * 8);
#define PG8_SA(b, h) (((b) * 2 + (h)) * HTB)
#define PG8_SB(b, h) ((4 + (b) * 2 + (h)) * HTB)
#define PG8_STAGE(bufoff, gbase, voff) do { _Pragma("unroll") for (int _i = 0; _i < 2; ++_i) \
        __builtin_amdgcn_global_load_lds((const unsigned*)((const char*)(gbase) + (voff)[_i]), (PG8_LAS unsigned*)(lds + (bufoff) + ldsw + _i * 8192), 16, 0, 0); } while (0)
#define PG8_LDA(dst, b, h) do { _Pragma("unroll") for (int m = 0; m < 4; ++m) _Pragma("unroll") for (int k = 0; k < 2; ++k) dst[m][k] = *(const PG8_LAS bf16x8*)(lds + PG8_SA(b, h) + aoff + m * 2048 + k * 1024); } while (0)
#define PG8_LDB(dst, b, h) do { _Pragma("unroll") for (int n = 0; n < 2; ++n) _Pragma("unroll") for (int k = 0; k < 2; ++k) dst[n][k] = *(const PG8_LAS bf16x8*)(lds + PG8_SB(b, h) + boff + n * 2048 + k * 1024); } while (0)
#define PG8_MMA(ai, bj, At, Bt) do { __builtin_amdgcn_s_setprio(1); _Pragma("unroll") for (int m = 0; m < 4; ++m) _Pragma("unroll") for (int n = 0; n < 2; ++n) _Pragma("unroll") for (int k = 0; k < 2; ++k) \
        acc[ai][bj][m][n] = __builtin_amdgcn_mfma_f32_16x16x32_bf16(Bt[n][k], At[m][k], acc[ai][bj][m][n], 0, 0, 0); __builtin_amdgcn_s_setprio(0); } while (0)
#define PG8_WAIT_V(n) asm volatile("s_waitcnt vmcnt(" #n ")" ::: "memory")
#define PG8_WAIT_L(n) asm volatile("s_waitcnt lgkmcnt(" #n ")" ::: "memory")
#define PG8_BAR __builtin_amdgcn_s_barrier()
#define PG8_SCHED __builtin_amdgcn_sched_barrier(0)
    Unit cur, nxt; int ui = 0;
    if (!S.next(0, cur)) return;
    f32x4 acc[2][2][4][2];
#pragma unroll
    for (int a = 0; a < 2; ++a)
#pragma unroll
        for (int b = 0; b < 2; ++b)
#pragma unroll
            for (int m = 0; m < 4; ++m)
#pragma unroll
                for (int n = 0; n < 2; ++n) acc[a][b][m][n] = (f32x4){0.f, 0.f, 0.f, 0.f};
    bf16x8 At[4][2], B0[2][2], B1[2][2];
    const char* cA = (const char*)g.A + (size_t)cur.pm * tstepA; const char* cB = (const char*)g.Bt + (size_t)cur.pn * tstepB;
    S.a_ready(cur);
    if constexpr (SP2) {
        PG8_STAGE(PG8_SB(0, 0), cB, voffB); PG8_STAGE(PG8_SB(0, 1), cB + hstepB, voffB); PG8_STAGE(PG8_SA(0, 0), cA, voffA); PG8_STAGE(PG8_SA(0, 1), cA + hstepA, voffA);
        if (wr == 1) PG8_BAR;
        PG8_WAIT_V(2); PG8_BAR;
        PG8_STAGE(PG8_SB(1, 0), cB + kstep, voffB); PG8_STAGE(PG8_SA(1, 0), cA + kstep, voffA); PG8_STAGE(PG8_SB(1, 1), cB + hstepB + kstep, voffB);
        PG8_WAIT_V(6); PG8_BAR;
    } else {
        PG8_STAGE(PG8_SB(0, 0), cB, voffB); PG8_STAGE(PG8_SA(0, 0), cA, voffA); PG8_STAGE(PG8_SB(0, 1), cB + hstepB, voffB); PG8_STAGE(PG8_SA(0, 1), cA + hstepA, voffA);
        if (wr == 1) PG8_BAR;
        PG8_WAIT_V(4); PG8_BAR;
        PG8_STAGE(PG8_SB(1, 0), cB + kstep, voffB); PG8_STAGE(PG8_SA(1, 0), cA + kstep, voffA); PG8_STAGE(PG8_SB(1, 1), cB + hstepB + kstep, voffB);
        PG8_WAIT_V(6); PG8_BAR;
    }
    for (;;) {
        const bool has_next = S.next(ui + 1, nxt);
        const char* nA = has_next ? (const char*)g.A + (size_t)nxt.pm * tstepA : cA; const char* nB = has_next ? (const char*)g.Bt + (size_t)nxt.pn * tstepB : cB;
        for (int t = 0; t < nt; t += 2) {
            const bool last = (t == nt - 2);
            const char* a1 = cA + (size_t)(t + 1) * kstep;
            const char* a2 = last ? nA : cA + (size_t)(t + 2) * kstep; const char* b2 = last ? nB : cB + (size_t)(t + 2) * kstep;
            const char* a3 = a2 + kstep; const char* b3 = b2 + kstep;
            if (last && has_next) S.a_ready(nxt);
            if constexpr (SP2) {
            PG8_LDB(B0, 0, 0); PG8_LDB(B1, 0, 1); PG8_SCHED; PG8_LDA(At, 0, 0); PG8_STAGE(PG8_SA(1, 1), a1 + hstepA, voffA);
            PG8_WAIT_V(8); PG8_WAIT_L(0); PG8_BAR; PG8_MMA(0, 0, At, B0); PG8_MMA(0, 1, At, B1); PG8_BAR; PG8_SCHED;
            PG8_LDA(At, 0, 1); PG8_STAGE(PG8_SB(0, 0), b2, voffB); PG8_STAGE(PG8_SB(0, 1), b2 + hstepB, voffB); PG8_STAGE(PG8_SA(0, 0), a2, voffA);
            PG8_WAIT_V(8); PG8_WAIT_L(0); PG8_BAR; PG8_MMA(1, 0, At, B0); PG8_MMA(1, 1, At, B1); PG8_BAR; PG8_SCHED;
            PG8_LDB(B0, 1, 0); PG8_LDB(B1, 1, 1); PG8_SCHED; PG8_LDA(At, 1, 0); PG8_STAGE(PG8_SA(0, 1), a2 + hstepA, voffA);
            PG8_WAIT_V(8); PG8_WAIT_L(0); PG8_BAR; PG8_MMA(0, 0, At, B0); PG8_MMA(0, 1, At, B1); PG8_BAR; PG8_SCHED;
            PG8_LDA(At, 1, 1); PG8_STAGE(PG8_SB(1, 0), b3, voffB); PG8_STAGE(PG8_SB(1, 1), b3 + hstepB, voffB); PG8_STAGE(PG8_SA(1, 0), a3, voffA);
            PG8_WAIT_V(8); PG8_WAIT_L(0); PG8_BAR; PG8_MMA(1, 0, At, B0); PG8_MMA(1, 1, At, B1); PG8_BAR; PG8_SCHED;
            } else {
            PG8_LDB(B0, 0, 0); PG8_SCHED; PG8_LDA(At, 0, 0); PG8_STAGE(PG8_SA(1, 1), a1 + hstepA, voffA);
            PG8_WAIT_L(8); PG8_BAR; PG8_WAIT_L(0); PG8_MMA(0, 0, At, B0); PG8_BAR; PG8_SCHED;
            PG8_LDB(B1, 0, 1); PG8_STAGE(PG8_SB(0, 0), b2, voffB);
            PG8_BAR; PG8_WAIT_L(0); PG8_MMA(0, 1, At, B1); PG8_BAR;
            PG8_LDA(At, 0, 1); PG8_STAGE(PG8_SA(0, 0), a2, voffA);
            PG8_BAR; PG8_WAIT_L(0); PG8_MMA(1, 0, At, B0); PG8_BAR; PG8_SCHED;
            PG8_STAGE(PG8_SB(0, 1), b2 + hstepB, voffB);
            PG8_WAIT_V(6); PG8_BAR; PG8_MMA(1, 1, At, B1); PG8_BAR;
            PG8_LDB(B0, 1, 0); PG8_SCHED; PG8_LDA(At, 1, 0); PG8_STAGE(PG8_SA(0, 1), a2 + hstepA, voffA);
            PG8_WAIT_L(8); PG8_BAR; PG8_WAIT_L(0); PG8_MMA(0, 0, At, B0); PG8_BAR; PG8_SCHED;
            PG8_LDB(B1, 1, 1); PG8_STAGE(PG8_SB(1, 0), b3, voffB);
            PG8_BAR; PG8_WAIT_L(0); PG8_MMA(0, 1, At, B1); PG8_BAR;
            PG8_LDA(At, 1, 1); PG8_STAGE(PG8_SA(1, 0), a3, voffA);
            PG8_BAR; PG8_WAIT_L(0); PG8_MMA(1, 0, At, B0); PG8_BAR; PG8_SCHED;
            PG8_STAGE(PG8_SB(1, 1), b3 + hstepB, voffB);
            PG8_WAIT_V(6); PG8_BAR; PG8_MMA(1, 1, At, B1); PG8_BAR;
            }
        }
        if constexpr (ALIGN_EPI) { if (wr == 0) PG8_BAR; }
        if constexpr (!Epi::AFTER_DRAIN) { E(acc, cur, wr, wc, fr, fq); S.done(cur); }
        if (!has_next) break;
#pragma unroll
        for (int a = 0; a < 2; ++a)
#pragma unroll
            for (int b = 0; b < 2; ++b)
#pragma unroll
                for (int m = 0; m < 4; ++m)
#pragma unroll
                    for (int n = 0; n < 2; ++n) acc[a][b][m][n] = (f32x4){0.f, 0.f, 0.f, 0.f};
        cur = nxt; cA = nA; cB = nB; ++ui;
        if constexpr (ALIGN_EPI) { if (wr == 1) PG8_BAR; }
    }
    PG8_WAIT_V(0);
    if constexpr (!ALIGN_EPI) { if (wr == 0) PG8_BAR; }
    PG8_BAR;
    if constexpr (Epi::AFTER_DRAIN) { E.fused(acc, cur, wr, wc, fr, fq, lds, wid, lane); S.done(cur); }
#undef PG8_SA
#undef PG8_SB
#undef PG8_STAGE
#undef PG8_LDA
#undef PG8_LDB
#undef PG8_MMA
#undef PG8_WAIT_V
#undef PG8_WAIT_L
#undef PG8_BAR
#undef PG8_SCHED
}
}
#define GAS __attribute__((address_space(1)))
#define LAS __attribute__((address_space(3)))
typedef unsigned short bf16;
typedef short bf16x8 __attribute__((ext_vector_type(8)));
typedef float f32x4 __attribute__((ext_vector_type(4)));
typedef float f32x16 __attribute__((ext_vector_type(16)));
typedef unsigned u32x4 __attribute__((ext_vector_type(4)));
typedef unsigned u32x2 __attribute__((ext_vector_type(2)));
typedef short s16x4 __attribute__((ext_vector_type(4)));
typedef GAS unsigned gu32;
constexpr int NWAVES = 8;
constexpr int NBATCH = 4, SEQ = 4096, DM = 1024, TOK = NBATCH * SEQ, NLAYER = 2;
constexpr int LDP = 5376, WIN_COLS = 5136;
constexpr int C_AQ = 0, C_BV = 1024, C_CG = 1536, C_AK = 2048, C_AV = 2304, C_AG = 2560, C_BQ = 3584, C_BK = 3840, C_GL = 4096, C_BG = 4352, C_CU = 4864;
constexpr float EPS = 1e-6f, LOG2E = 1.4426950408889634f;
constexpr size_t MiB = 1u << 20;
constexpr size_t WS_CTL = 0, CTL_ZERO_BYTES = 64 * 1024;
constexpr int CW_BAR = 1024;
constexpr size_t WS_MOD = 1 * MiB;
constexpr size_t WS_TAB = 1 * MiB + 256 * 1024;
constexpr size_t WS_WIN = 2 * MiB, WIN_BYTES = (size_t)LDP * DM * 2;
constexpr size_t WS_WOUT = 23 * MiB, WOUT_BYTES = (size_t)DM * 2048 * 2;
constexpr size_t WS_WGLU = 31 * MiB, WGLU_BYTES = (size_t)512 * 512 * 2;
constexpr size_t WS_S5M = 32 * MiB, S5M_BYTES = 8 * MiB;
constexpr size_t S5M_TZ = 0, S5M_BZ = 4 * MiB, S5M_CZ = 6 * MiB;
constexpr size_t WS_H = 48 * MiB;
constexpr size_t WS_GLAE = 48 * MiB;
constexpr size_t WS_GLAD = 56 * MiB;
constexpr size_t WS_S5E = 57 * MiB;
constexpr size_t WS_P = 80 * MiB;
constexpr size_t WS_END = 248 * MiB;
static_assert(WS_WIN + 2 * WIN_BYTES <= WS_WOUT && WS_WOUT + 2 * WOUT_BYTES <= WS_WGLU && WS_WGLU + 2 * WGLU_BYTES <= WS_S5M && WS_S5M + 2 * S5M_BYTES <= WS_H, "ws map");
static_assert(WS_H + (size_t)TOK * DM * 2 <= WS_P && WS_P + (size_t)TOK * LDP * 2 <= WS_END && WS_S5E + 2048 * 128 * 4 <= WS_P, "ws map 2");
constexpr int RING_BYTES = 143360, LDSCTL_OFF = RING_BYTES, MISC_OFF = LDSCTL_OFF + 320, LDS_BYTES = 147456;

#define RLX_AGENT __ATOMIC_RELAXED, __HIP_MEMORY_SCOPE_AGENT
#define LDS_WAIT() asm volatile("s_waitcnt lgkmcnt(0)" ::: "memory")
typedef float f32x2_t __attribute__((ext_vector_type(2))); typedef __bf16 bf16x2_t __attribute__((ext_vector_type(2)));
__device__ __forceinline__ unsigned pk2(float lo, float hi) { f32x2_t v = {lo, hi}; bf16x2_t b = __builtin_convertvector(v, bf16x2_t); return __builtin_bit_cast(unsigned, b); }
__device__ __forceinline__ bf16 f2bf(float f) { return (bf16)(pk2(f, 0.f) & 0xffffu); }
__device__ __forceinline__ float bf2f(bf16 b) { return __uint_as_float((unsigned)b << 16); }
__device__ __forceinline__ float bflo(unsigned w) { return __uint_as_float(w << 16); }
__device__ __forceinline__ float bfhi(unsigned w) { return __uint_as_float(w & 0xffff0000u); }
__device__ __forceinline__ float sigmoidf_(float x) { return __builtin_amdgcn_rcpf(1.0f + __expf(-x)); }
__device__ __forceinline__ float wave_sum(float v) {
#pragma unroll
    for (int o = 1; o < 64; o <<= 1) v += __shfl_xor(v, o);
    return v;
}
#define MFMA16(a, b, c) __builtin_amdgcn_mfma_f32_16x16x32_bf16((a), (b), (c), 0, 0, 0)
#define MFMA32(a, b, c) __builtin_amdgcn_mfma_f32_32x32x16_bf16((a), (b), (c), 0, 0, 0)
#define XB_TMO      128
#define XB_XCNT(j)  (256  + 64 * (j))
#define XB_XSUB(j)  (1280 + 64 * (j))
#define XB_XGEN(j)  (2304 + 64 * (j))
#define XB_TOP      3328
#define XB_TOPGEN   3392
#define XCD_BAR_WORDS 3456
#define XB_SPIN_CAP (1u << 18)

__device__ __forceinline__ unsigned xb_ld(unsigned* p)              { return __hip_atomic_load(p, __ATOMIC_RELAXED, __HIP_MEMORY_SCOPE_AGENT); }
__device__ __forceinline__ unsigned xb_add(unsigned* p, unsigned v) { return __hip_atomic_fetch_add(p, v, __ATOMIC_RELAXED, __HIP_MEMORY_SCOPE_AGENT); }
__device__ __forceinline__ unsigned xb_xcc_id() { return (unsigned)__builtin_amdgcn_s_getreg((3 << 11) | 20) & 0xFu; }
#define XB_SPIN(cond, bar) do { unsigned _sp = 0; while (cond) { __builtin_amdgcn_s_sleep(1); \
    if ((++_sp & 255u) == 0u) { if (xb_ld(&(bar)[XB_TMO])) break; if (_sp > XB_SPIN_CAP) { atomicAdd(&(bar)[XB_TMO], 1u); break; } } } } while (0)

struct XcdBarrier {
    unsigned* bar; unsigned x;
    volatile LAS unsigned* st;
};

__device__ __forceinline__ XcdBarrier xcd_barrier_post(unsigned* bar, volatile LAS unsigned* st) {
    XcdBarrier b; b.bar = bar; b.x = xb_xcc_id(); b.st = st;
    if (threadIdx.x == 0) (void)xb_add(&bar[XB_XCNT(b.x)], 1u);
    return b;
}
__device__ __forceinline__ void xcd_barrier_complete(unsigned* bar, unsigned x, unsigned& nloc, unsigned& nx) {
    const unsigned G = gridDim.x * gridDim.y * gridDim.z;
    unsigned sum, cnt, mine, sp = 0u;
    for (;;) {
        sum = 0u; cnt = 0u; mine = 0u;
#pragma unroll
        for (unsigned j = 0; j < 16; ++j) { const unsigned c = xb_ld(&bar[XB_XCNT(j)]); sum += c; cnt += (c > 0u) ? 1u : 0u; mine = (j == x) ? c : mine; }
        if (sum == G) break;
        __builtin_amdgcn_s_sleep(1);
        if ((++sp & 255u) == 0u) { if (xb_ld(&bar[XB_TMO])) break; if (sp > XB_SPIN_CAP) { atomicAdd(&bar[XB_TMO], 1u); break; } }
    }
    nloc = mine > 0u ? mine : 1u; nx = cnt > 0u ? cnt : 1u;
}

__device__ __forceinline__ void xcd_barrier(const XcdBarrier& b) {
    asm volatile("s_waitcnt vmcnt(0)" ::: "memory");
    __syncthreads();
    if (threadIdx.x == 0) {
        unsigned* bar = b.bar;
        __builtin_amdgcn_s_waitcnt(0);
        unsigned nloc = b.st[0], nx = b.st[1];
        if (nloc == 0u) { xcd_barrier_complete(bar, b.x, nloc, nx); b.st[0] = nloc; b.st[1] = nx; }
        const unsigned old = xb_add(&bar[XB_XSUB(b.x)], 1u);
        const unsigned gen = old / nloc;
        if (old + 1u == (gen + 1u) * nloc) {
            __builtin_amdgcn_fence(__ATOMIC_RELEASE, "agent");
            asm volatile("s_waitcnt vmcnt(0)" ::: "memory");
            const unsigned og = xb_add(&bar[XB_TOP], 1u);
            const unsigned tg = og / nx;
            if (og + 1u == (tg + 1u) * nx) xb_add(&bar[XB_TOPGEN], 1u);
            else XB_SPIN(xb_ld(&bar[XB_TOPGEN]) == tg, bar);
            __builtin_amdgcn_fence(__ATOMIC_ACQUIRE, "agent");
            xb_add(&bar[XB_XGEN(b.x)], 1u);
            asm volatile("s_waitcnt vmcnt(0)" ::: "memory");
        } else {
            XB_SPIN(xb_ld(&bar[XB_XGEN(b.x)]) == gen, bar);
            __builtin_amdgcn_fence(__ATOMIC_ACQUIRE, "agent");
            asm volatile("s_waitcnt vmcnt(0)" ::: "memory");
        }
    }
    __syncthreads();
}
__device__ __forceinline__ int win_srccol(int n0) {
    if (n0 < 1024) return n0;
    if (n0 < 1536) return 3072 + (n0 - 1024);
    if (n0 < 2048) return 4624 + (n0 - 1536);
    if (n0 < 2304) return 1024 + (n0 - 2048);
    if (n0 < 2560) return 1280 + (n0 - 2304);
    if (n0 < 3584) return 1536 + (n0 - 2560);
    if (n0 < 3840) return 2560 + (n0 - 3584);
    if (n0 < 4096) return 2816 + (n0 - 3840);
    if (n0 < 4352) return -1;
    if (n0 < 4864) return 3600 + (n0 - 4352);
    return 4112 + (n0 - 4864);
}
__device__ __forceinline__ void p0_mod_item(LAS unsigned char* lds, const float* c, const float* wmod, const float* bmod, const float* gpre, float* mod, int it, int tid, int wid, int lane) {
    LAS float* sc = (LAS float*)lds; LAS float* part = (LAS float*)(lds + 16384);
    const int l = it / 96, nb = it % 96, col = nb * 32 + (lane & 31), ks = wid * 2 + (lane >> 5);
    const float* wp = wmod + (size_t)l * 1024 * 3072 + col + (size_t)ks * 64 * 3072;
    float w[64];
#pragma unroll
    for (int i = 0; i < 64; ++i) w[i] = wp[(size_t)i * 3072];
    for (int i = tid; i < 4096; i += 512) { const float cv = c[i]; sc[i] = cv * sigmoidf_(cv); }
    __syncthreads();
    float a0 = 0.f, a1 = 0.f, a2 = 0.f, a3 = 0.f;
#pragma unroll
    for (int i = 0; i < 64; ++i) { const int k = ks * 64 + i; a0 += sc[k] * w[i]; a1 += sc[1024 + k] * w[i]; a2 += sc[2048 + k] * w[i]; a3 += sc[3072 + k] * w[i]; }
    part[(ks * 4 + 0) * 32 + (lane & 31)] = a0; part[(ks * 4 + 1) * 32 + (lane & 31)] = a1; part[(ks * 4 + 2) * 32 + (lane & 31)] = a2; part[(ks * 4 + 3) * 32 + (lane & 31)] = a3;
    __syncthreads();
    if (tid < 128) { const int b = tid >> 5, n = nb * 32 + (tid & 31); float s = 0.f;
#pragma unroll
        for (int k = 0; k < 16; ++k) s += part[(k * 4 + b) * 32 + (tid & 31)];
        s += bmod[l * 3072 + n];
        if (n >= 1024 && n < 2048) s = gpre[l * 1024 + n - 1024] * (1.0f + s);
        mod[(size_t)(l * 4 + b) * 3072 + n] = s; }
    __syncthreads();
}

__device__ __forceinline__ void p0_s5_item(LAS unsigned char* lds, const float* const* in, unsigned char* ws, int l, int g, int tid) {
    LAS float* PWr = (LAS float*)lds; LAS float* PWi = PWr + 17 * 64; LAS float* BTr = PWi + 17 * 64; LAS float* BTi = BTr + 1024;
    LAS float* CRr = BTi + 1024; LAS float* CRi = CRr + 1024; LAS float* KC = CRi + 1024;
    const float* are = in[11] + (size_t)(l * 32 + g) * 64; const float* aim = in[12] + (size_t)(l * 32 + g) * 64;
    const double dt = exp((double)in[13][l * 32 + g]);
    const float* bre = in[14] + (size_t)(l * 32 + g) * 1024; const float* bim = in[15] + (size_t)(l * 32 + g) * 1024;
    const float* cre = in[16] + (size_t)(l * 32 + g) * 1024; const float* cim = in[17] + (size_t)(l * 32 + g) * 1024;
    const float* dd = in[18] + (size_t)l * 512 + g * 16;
    float* tab = (float*)(ws + WS_TAB) + (size_t)(l * 32 + g) * 6 * 64;
    if (tid < 64) { const int p = tid; const double ar = are[p], ai = aim[p];
        const double mag = exp(ar * dt), abr = mag * cos(ai * dt), abi = mag * sin(ai * dt), den = ar * ar + ai * ai, nr = abr - 1.0;
        const double fr = (nr * ar + abi * ai) / den, fi = (abi * ar - nr * ai) / den;
#pragma unroll 4
        for (int h = 0; h < 16; ++h) { const double br = bre[p * 16 + h], bi = bim[p * 16 + h]; BTr[p * 16 + h] = (float)(fr * br - fi * bi); BTi[p * 16 + h] = (float)(fr * bi + fi * br); }
        double pr = 1.0, pi = 0.0;
#pragma unroll 1
        for (int tau = 0; tau <= 16; ++tau) { PWr[tau * 64 + p] = (float)pr; PWi[tau * 64 + p] = (float)pi; const double t = pr * abr - pi * abi; pi = pr * abi + pi * abr; pr = t; }
        double qr = (double)0, qi = (double)0; { qr = 1.0; qi = 0.0; double xr = abr, xi = abi;
#pragma unroll 1
          for (int s2 = 0; s2 < 8; ++s2) { const double t = xr * xr - xi * xi; xi = 2.0 * xr * xi; xr = t;
              if (s2 == 3) { tab[0 * 64 + p] = (float)xr; tab[1 * 64 + p] = (float)xi; }
              if (s2 == 5) { tab[2 * 64 + p] = (float)xr; tab[3 * 64 + p] = (float)xi; }
              if (s2 == 7) { tab[4 * 64 + p] = (float)xr; tab[5 * 64 + p] = (float)xi; } } }
        (void)qr; (void)qi; }
    for (int idx = tid; idx < 1024; idx += 512) { CRr[idx] = cre[idx]; CRi[idx] = cim[idx]; }
    __syncthreads();
    { const int hp = tid & 15, tau = (tid >> 4) & 15, hh = __builtin_amdgcn_readfirstlane(tid >> 8); float acc[8];
#pragma unroll
      for (int j = 0; j < 8; ++j) acc[j] = 0.f;
#pragma unroll 4
      for (int p = 0; p < 64; ++p) { const float pr = PWr[tau * 64 + p], pi = PWi[tau * 64 + p], br = BTr[p * 16 + hp], bi = BTi[p * 16 + hp];
          const float xr = pr * br - pi * bi, xi = pr * bi + pi * br;
#pragma unroll
          for (int j = 0; j < 8; ++j) acc[j] += cre[(8 * hh + j) * 64 + p] * xr - cim[(8 * hh + j) * 64 + p] * xi; }
#pragma unroll
      for (int j = 0; j < 8; ++j) { const int h = 8 * hh + j; float s = acc[j]; if (tau == 0 && h == hp) s += dd[h]; KC[(tau * 16 + h) * 16 + hp] = s; } }
    __syncthreads();
    bf16* Tz = (bf16*)(ws + WS_S5M + (size_t)l * S5M_BYTES + S5M_TZ) + (size_t)g * 65536;
    bf16* Bz = (bf16*)(ws + WS_S5M + (size_t)l * S5M_BYTES + S5M_BZ) + (size_t)g * 32768;
    bf16* Cz = (bf16*)(ws + WS_S5M + (size_t)l * S5M_BYTES + S5M_CZ) + (size_t)g * 32768;
#pragma unroll 1
    for (int i = 0; i < 16; ++i) { const int idx = tid + 512 * i, n = idx >> 5, c = idx & 31, ii = n >> 4, h = n & 15, j = c >> 1, hp0 = 8 * (c & 1); float v[8];
#pragma unroll
        for (int e = 0; e < 8; ++e) v[e] = (j <= ii) ? KC[((ii - j) * 16 + h) * 16 + hp0 + e] : 0.f;
        u32x4 o; o.x = pk2(v[0], v[1]); o.y = pk2(v[2], v[3]); o.z = pk2(v[4], v[5]); o.w = pk2(v[6], v[7]); *(u32x4*)(Tz + (size_t)n * 256 + 8 * c) = o; }
#pragma unroll 1
    for (int i = 0; i < 8; ++i) { const int idx = tid + 512 * i, n = idx >> 5, c = idx & 31, p = n & 63, im = n >> 6, j = c >> 1, hp0 = 8 * (c & 1), tau = 15 - j; float v[8];
        const float pr = PWr[tau * 64 + p], pi = PWi[tau * 64 + p];
#pragma unroll
        for (int e = 0; e < 8; ++e) { const float br = BTr[p * 16 + hp0 + e], bi = BTi[p * 16 + hp0 + e]; v[e] = im ? (pr * bi + pi * br) : (pr * br - pi * bi); }
        u32x4 o; o.x = pk2(v[0], v[1]); o.y = pk2(v[2], v[3]); o.z = pk2(v[4], v[5]); o.w = pk2(v[6], v[7]); *(u32x4*)(Bz + (size_t)n * 256 + 8 * c) = o; }
#pragma unroll 1
    for (int i = 0; i < 8; ++i) { const int idx = tid + 512 * i, n = idx >> 4, c = idx & 15, ii = n >> 4, h = n & 15, im = c >> 3, tau = ii + 1; float v[8];
#pragma unroll
        for (int e = 0; e < 8; ++e) { const int p = (8 * c + e) & 63; const float cr = CRr[h * 64 + p], ci = CRi[h * 64 + p], pr = PWr[tau * 64 + p], pi = PWi[tau * 64 + p];
            v[e] = im ? -(cr * pi + ci * pr) : (cr * pr - ci * pi); }
        u32x4 o; o.x = pk2(v[0], v[1]); o.y = pk2(v[2], v[3]); o.z = pk2(v[4], v[5]); o.w = pk2(v[6], v[7]); *(u32x4*)(Cz + (size_t)n * 128 + 8 * c) = o; }
    __syncthreads();}

__device__ __forceinline__ void p0_mod_phase(LAS unsigned char* lds, const float* const* in, unsigned char* ws, int vcu, int G, int tid, int wid, int lane) {
    for (int it = vcu; it < 192; it += G) p0_mod_item(lds, in[1], in[2], in[3], in[4], (float*)(ws + WS_MOD), it, tid, wid, lane);
}
struct TrDesc { const float* src; bf16* dst; int ldw, K; const float* walpha; int acol; };
__device__ __forceinline__ TrDesc tr_decode(const float* const* in, unsigned char* ws, int it) {
    constexpr int I_IN = 16 * 168, I_OUT = 32 * 32, I_GLU = 8 * 16, I_L = I_IN + I_OUT + I_GLU;
    const int l = it / I_L; int r = it % I_L; TrDesc d; d.walpha = nullptr; d.acol = 0;
    if (r < I_IN) { const int nb = r % 168, kb = r / 168, n0 = nb * 32, sc = win_srccol(n0);
        const float* W = in[6] + (size_t)l * DM * WIN_COLS; bf16* WT = (bf16*)(ws + WS_WIN + (size_t)l * WIN_BYTES);
        d.ldw = WIN_COLS; d.K = DM; d.dst = WT + (size_t)n0 * DM + kb * 64;
        if (sc >= 0) d.src = W + (size_t)(kb * 64) * WIN_COLS + sc; else { d.src = W + (size_t)(kb * 64) * WIN_COLS + 3584; d.walpha = in[8] + (size_t)l * 16 * 256; d.acol = n0 - C_GL; }
        return d; }
    r -= I_IN;
    if (r < I_OUT) { const int nb = r % 32, kb = r / 32; d.ldw = DM; d.K = 2048; d.src = in[21] + (size_t)l * 2048 * DM + (size_t)(kb * 64) * DM + nb * 32; d.dst = (bf16*)(ws + WS_WOUT + (size_t)l * WOUT_BYTES) + (size_t)(nb * 32) * 2048 + kb * 64; return d; }
    r -= I_OUT;
    { const int nb = r % 16, kb = r / 16; d.ldw = 512; d.K = 512; d.src = in[19] + (size_t)l * 512 * 512 + (size_t)(kb * 64) * 512 + nb * 32; d.dst = (bf16*)(ws + WS_WGLU + (size_t)l * WGLU_BYTES) + (size_t)(nb * 32) * 512 + kb * 64; return d; }
}
__device__ __forceinline__ void tr_load(const TrDesc& d, f32x4 (&v)[8], int lane) {
    const int kr = lane >> 3, c4 = lane & 7;
#pragma unroll
    for (int i = 0; i < 8; ++i) v[i] = *(const f32x4*)(d.src + (size_t)(8 * i + kr) * d.ldw + 4 * c4);
}
__device__ __forceinline__ void tr_lds_fill(const TrDesc& d, const f32x4 (&v)[8], LAS float* scr, int lane) {
    if (d.walpha == nullptr) { const int kr = lane >> 3, c4 = lane & 7;
#pragma unroll
        for (int i = 0; i < 8; ++i) { LAS float* q = scr + (8 * i + kr) * 33 + 4 * c4; q[0] = v[i][0]; q[1] = v[i][1]; q[2] = v[i][2]; q[3] = v[i][3]; } }
    else {
        float wa[16];
#pragma unroll
        for (int r = 0; r < 16; ++r) wa[r] = d.walpha[r * 256 + d.acol + (lane & 31)];
#pragma unroll 4
        for (int i = 0; i < 32; ++i) { const int kk = 2 * i + (lane >> 5); const f32x4* wr = (const f32x4*)(d.src + (size_t)kk * d.ldw);
            const f32x4 w0 = wr[0], w1 = wr[1], w2 = wr[2], w3 = wr[3];
            float s = (w0[0] * wa[0] + w0[1] * wa[1]) + (w0[2] * wa[2] + w0[3] * wa[3]); s += (w1[0] * wa[4] + w1[1] * wa[5]) + (w1[2] * wa[6] + w1[3] * wa[7]);
            s += (w2[0] * wa[8] + w2[1] * wa[9]) + (w2[2] * wa[10] + w2[3] * wa[11]); s += (w3[0] * wa[12] + w3[1] * wa[13]) + (w3[2] * wa[14] + w3[3] * wa[15]);
            scr[kk * 33 + (lane & 31)] = s; } }
}
__device__ __forceinline__ void tr_store(const TrDesc& d, LAS float* scr, int lane) {
    const int c = lane & 7;
#pragma unroll
    for (int j = 0; j < 4; ++j) { const int n = (lane >> 3) + 8 * j; const LAS float* s = scr + (8 * c) * 33 + n;
        u32x4 o; o.x = pk2(s[0 * 33], s[1 * 33]); o.y = pk2(s[2 * 33], s[3 * 33]); o.z = pk2(s[4 * 33], s[5 * 33]); o.w = pk2(s[6 * 33], s[7 * 33]);
        *(u32x4*)(d.dst + (size_t)n * d.K + 8 * c) = o; }
}
__device__ __forceinline__ void p1_transposes(LAS unsigned char* lds, const float* const* in, unsigned char* ws, int gw, int NGW, int wid, int lane) {
    LAS float* scr = (LAS float*)(lds + wid * 16384);
    constexpr int NIT = NLAYER * (16 * 168 + 32 * 32 + 8 * 16);
    int it = gw; if (it >= NIT) return;
    TrDesc d = tr_decode(in, ws, it); f32x4 v[8];
    if (d.walpha == nullptr) tr_load(d, v, lane);
    for (;;) {
        tr_lds_fill(d, v, scr, lane);
        const int nx = it + NGW; TrDesc dn = d; const bool more = nx < NIT;
        if (more) { dn = tr_decode(in, ws, nx); if (dn.walpha == nullptr) tr_load(dn, v, lane); }
        LDS_WAIT(); asm volatile("" ::: "memory");
        tr_store(d, scr, lane);
        LDS_WAIT(); asm volatile("" ::: "memory");
        if (!more) break;
        d = dn; it = nx;
    }
}
__device__ __forceinline__ void prenorm_phase(const float* x, const float* mod  , bf16* H, int gw, int NGW, int lane) {
    f32x4 v[4], n1[4], n2[4];
    int m = gw; if (m >= TOK) return;
#pragma unroll
    for (int j = 0; j < 4; ++j) { v[j] = *(const f32x4*)(x + (size_t)m * DM + 256 * j + 4 * lane); n1[j] = v[j]; n2[j] = v[j]; }
    if (m + NGW < TOK) {
#pragma unroll
        for (int j = 0; j < 4; ++j) n1[j] = *(const f32x4*)(x + (size_t)(m + NGW) * DM + 256 * j + 4 * lane); }
    for (; m < TOK; m += NGW) {
        if (m + 2 * NGW < TOK) {
#pragma unroll
            for (int j = 0; j < 4; ++j) n2[j] = *(const f32x4*)(x + (size_t)(m + 2 * NGW) * DM + 256 * j + 4 * lane); }
        const int b = m / SEQ; const float* mb = mod + (size_t)b * 3072; f32x4 ga[4], sh[4]; float ss = 0.f;
#pragma unroll
        for (int j = 0; j < 4; ++j) { ss += (v[j][0] * v[j][0] + v[j][1] * v[j][1]) + (v[j][2] * v[j][2] + v[j][3] * v[j][3]); ga[j] = *(const f32x4*)(mb + 1024 + 256 * j + 4 * lane); sh[j] = *(const f32x4*)(mb + 256 * j + 4 * lane); }
        const float r = rsqrtf(wave_sum(ss) * (1.0f / DM) + EPS);
#pragma unroll
        for (int j = 0; j < 4; ++j) { const f32x4 o = v[j] * r * ga[j] + sh[j]; u32x2 w; w.x = pk2(o[0], o[1]); w.y = pk2(o[2], o[3]); *(u32x2*)(H + (size_t)m * DM + 256 * j + 4 * lane) = w; }
#pragma unroll
        for (int j = 0; j < 4; ++j) { v[j] = n1[j]; n1[j] = n2[j]; }
    }
}
__device__ __forceinline__ void post_phase(const float* xin, float* xout, const bf16* Y, const float* gpost, const float* mod  , bool do_next, const float* gpre_n, const float* mod_n, bf16* Hn,
                                           int vcu, int wid, int lane) {
    const int gw = vcu * NWAVES + wid; const int m0 = gw * 8, b = m0 / SEQ;
    if (m0 >= TOK) return;
    f32x4 gp[4], gt[4];
#pragma unroll
    for (int j = 0; j < 4; ++j) { const int col = 256 * j + 4 * lane; gp[j] = *(const f32x4*)(gpost + col); gt[j] = *(const f32x4*)(mod + (size_t)b * 3072 + 2048 + col); }
    u32x2 yw[4], nyw[4]; f32x4 xv[4], nxv[4];
#pragma unroll
    for (int j = 0; j < 4; ++j) { yw[j] = *(const u32x2*)(Y + (size_t)m0 * DM + 256 * j + 4 * lane); xv[j] = *(const f32x4*)(xin + (size_t)m0 * DM + 256 * j + 4 * lane); nyw[j] = yw[j]; nxv[j] = xv[j]; }
#pragma unroll 1
    for (int i = 0; i < 8; ++i) { const int m = m0 + i; f32x4 y[4]; float ss = 0.f;
        if (i < 7) {
#pragma unroll
            for (int j = 0; j < 4; ++j) { nyw[j] = *(const u32x2*)(Y + (size_t)(m + 1) * DM + 256 * j + 4 * lane); nxv[j] = *(const f32x4*)(xin + (size_t)(m + 1) * DM + 256 * j + 4 * lane); } }
#pragma unroll
        for (int j = 0; j < 4; ++j) { y[j] = (f32x4){bflo(yw[j].x), bfhi(yw[j].x), bflo(yw[j].y), bfhi(yw[j].y)}; ss += (y[j][0] * y[j][0] + y[j][1] * y[j][1]) + (y[j][2] * y[j][2] + y[j][3] * y[j][3]); }
        const float r = rsqrtf(wave_sum(ss) * (1.0f / DM) + EPS); float s2 = 0.f;
#pragma unroll
        for (int j = 0; j < 4; ++j) { xv[j] = xv[j] + gt[j] * (y[j] * r * gp[j]); *(f32x4*)(xout + (size_t)m * DM + 256 * j + 4 * lane) = xv[j];
            s2 += (xv[j][0] * xv[j][0] + xv[j][1] * xv[j][1]) + (xv[j][2] * xv[j][2] + xv[j][3] * xv[j][3]); }
        if (do_next) { const float r2 = rsqrtf(wave_sum(s2) * (1.0f / DM) + EPS);
#pragma unroll
            for (int j = 0; j < 4; ++j) { const int col = 256 * j + 4 * lane; const f32x4 ga = *(const f32x4*)(mod_n + (size_t)b * 3072 + 1024 + col), sh = *(const f32x4*)(mod_n + (size_t)b * 3072 + col);
                const f32x4 o = xv[j] * r2 * ga + sh; u32x2 w; w.x = pk2(o[0], o[1]); w.y = pk2(o[2], o[3]); *(u32x2*)(Hn + (size_t)m * DM + 256 * j + 4 * lane) = w; } }
#pragma unroll
        for (int j = 0; j < 4; ++j) { yw[j] = nyw[j]; xv[j] = nxv[j]; }
    }
}
typedef short v4i16_t __attribute__((ext_vector_type(4)));
__device__ __forceinline__ s16x4 vtr(LAS unsigned char* p) { return __builtin_bit_cast(s16x4, __builtin_amdgcn_ds_read_tr16_b64_v4i16((LAS v4i16_t*)p)); }
__device__ __forceinline__ void attn_item(LAS unsigned char* lds, bf16* P, const float* sinks, int item, int tid, int wid, int lane) {
    const int r32 = lane & 31, hi = lane >> 5;
    const int qblk = item & 31, kvh = (item >> 5) & 3, b = item >> 7, q0 = qblk * 128;
    const size_t rowbase = (size_t)b * SEQ;
    LAS unsigned char* Ks = lds; LAS unsigned char* Vs = lds + 32768; LAS float* ost = (LAS float*)(lds + 65536 + wid * 8704);
    { const int kr = tid >> 1, hf = tid & 1, key = q0 - 128 + kr; u32x4 kv[4], vv[4];
      if (key >= 0) { const bf16* src = P + (rowbase + key) * LDP + kvh * 64 + hf * 32;
#pragma unroll
          for (int c = 0; c < 4; ++c) { kv[c] = *(const u32x4*)(src + C_AK + c * 8); vv[c] = *(const u32x4*)(src + C_AV + c * 8); } }
      else {
#pragma unroll
          for (int c = 0; c < 4; ++c) { kv[c] = (u32x4){0u, 0u, 0u, 0u}; vv[c] = (u32x4){0u, 0u, 0u, 0u}; } }
#pragma unroll
      for (int c = 0; c < 4; ++c) { const int ch = hf * 4 + c; *(LAS u32x4*)(Ks + kr * 128 + ((ch ^ (kr & 7)) << 4)) = kv[c]; *(LAS u32x4*)(Vs + kr * 128 + (ch << 4)) = vv[c]; } }
    __syncthreads();
    const int g = wid >> 1, half = wid & 1, head = kvh * 4 + g;
    const float slope2 = exp2f(-0.5f * (float)(head + 1)) * LOG2E, sink2 = sinks[head] * LOG2E, C2 = 0.125f * LOG2E;
    const int q16 = (lane & 15) >> 2, p16 = lane & 3, dblk = (lane >> 4) & 1;
#pragma unroll 1
    for (int sb = 0; sb < 2; ++sb) {
        const int qs = q0 + half * 64 + sb * 32, lrow0 = half * 64 + sb * 32;
        const bf16* qp = P + (rowbase + qs + r32) * LDP + C_AQ + head * 64 + hi * 8;
        bf16x8 qf[4];
#pragma unroll
        for (int kk = 0; kk < 4; ++kk) qf[kk] = *(const bf16x8*)(qp + kk * 16);
        f32x16 S[5]; float m = sink2; int e = r32 - 4 * hi; asm volatile("" : "+v"(e)); const float ef = (float)e;
#pragma unroll
        for (int kt = 0; kt < 5; ++kt) { f32x16 acc;
#pragma unroll
            for (int r = 0; r < 16; ++r) acc[r] = 0.f;
            const int krow = lrow0 + 32 * kt + r32;
#pragma unroll
            for (int kk = 0; kk < 4; ++kk) { const int ch = 2 * kk + hi; const bf16x8 kf = *(const LAS bf16x8*)(Ks + krow * 128 + ((ch ^ (krow & 7)) << 4)); acc = MFMA32(kf, qf[kk], acc); }
            { const bool tile_ok = (qs - 128 + 32 * kt) >= 0;
              const float base = -slope2 * ((float)(128 - 32 * kt) + ef);
#pragma unroll
              for (int r = 0; r < 16; ++r) { const int cr = (r & 3) + 8 * (r >> 2);
                  const float s = fmaf(acc[r], C2, fmaf(slope2, (float)cr, base));
                  bool ok = tile_ok; if (kt == 0) ok = ok && (e < cr); if (kt == 4) ok = ok && (e >= cr);
                  S[kt][r] = ok ? s : -INFINITY; m = fmaxf(m, S[kt][r]); } }
            __builtin_amdgcn_sched_barrier(0); }
        m = fmaxf(m, __shfl_xor(m, 32));
        float l = 0.f;
#pragma unroll
        for (int kt = 0; kt < 5; ++kt)
#pragma unroll
            for (int r = 0; r < 16; ++r) { const float p = __builtin_amdgcn_exp2f(S[kt][r] - m); S[kt][r] = p; l += p; }
        l += __shfl_xor(l, 32); l += __builtin_amdgcn_exp2f(sink2 - m);
        const float inv_l = 1.0f / l;
        f32x16 o0, o1;
#pragma unroll
        for (int r = 0; r < 16; ++r) { o0[r] = 0.f; o1[r] = 0.f; }
#pragma unroll
        for (int kt = 0; kt < 5; ++kt)
#pragma unroll
            for (int ks = 0; ks < 2; ++ks) { u32x4 pw; pw.x = pk2(S[kt][8 * ks + 0], S[kt][8 * ks + 1]); pw.y = pk2(S[kt][8 * ks + 2], S[kt][8 * ks + 3]); pw.z = pk2(S[kt][8 * ks + 4], S[kt][8 * ks + 5]); pw.w = pk2(S[kt][8 * ks + 6], S[kt][8 * ks + 7]);
                const bf16x8 pa = __builtin_bit_cast(bf16x8, pw);
                LAS unsigned char* vb = Vs + (lrow0 + 32 * kt + 16 * ks + 4 * hi + q16) * 128 + dblk * 32 + p16 * 8;
                const s16x4 a0 = vtr(vb), a1 = vtr(vb + 8 * 128), b0 = vtr(vb + 64), b1 = vtr(vb + 64 + 8 * 128);
                const bf16x8 v0 = __builtin_shufflevector(a0, a1, 0, 1, 2, 3, 4, 5, 6, 7), v1 = __builtin_shufflevector(b0, b1, 0, 1, 2, 3, 4, 5, 6, 7);
                o0 = MFMA32(pa, v0, o0); o1 = MFMA32(pa, v1, o1); __builtin_amdgcn_sched_barrier(0); }
#pragma unroll
        for (int r = 0; r < 16; ++r) { const int qr = (r & 3) + 8 * (r >> 2) + 4 * hi; ost[qr * 68 + r32] = o0[r]; ost[qr * 68 + 32 + r32] = o1[r]; }
        asm volatile("" ::: "memory");
        { const int row = lane >> 1, hf = lane & 1; const float sc = __shfl(inv_l, row);
          bf16* rp = P + (rowbase + qs + row) * LDP + head * 64 + hf * 32;
#pragma unroll
          for (int c = 0; c < 4; ++c) { const u32x4 gv = *(const u32x4*)(rp + C_AG + 8 * c);
              const f32x4 x0 = *(const LAS f32x4*)(ost + row * 68 + hf * 32 + 8 * c), x1 = *(const LAS f32x4*)(ost + row * 68 + hf * 32 + 8 * c + 4);
              float gg[8] = {bflo(gv.x), bfhi(gv.x), bflo(gv.y), bfhi(gv.y), bflo(gv.z), bfhi(gv.z), bflo(gv.w), bfhi(gv.w)};
              float xx[8] = {x0[0], x0[1], x0[2], x0[3], x1[0], x1[1], x1[2], x1[3]};
#pragma unroll
              for (int e = 0; e < 8; ++e) xx[e] = xx[e] * sc * gg[e] * sigmoidf_(gg[e]);
              u32x4 w; w.x = pk2(xx[0], xx[1]); w.y = pk2(xx[2], xx[3]); w.z = pk2(xx[4], xx[5]); w.w = pk2(xx[6], xx[7]);
              *(u32x4*)(rp + C_AQ + 8 * c) = w; } }
        asm volatile("" ::: "memory");
    }
    __syncthreads();
}
constexpr int GL_QT = 0, GL_KT = 9216, GL_KH = 18432, GL_AT = 27648, GL_VT = 36864, GL_ST = 55296, GL_PART = 73728, GL_BL = 75776, GL_SS = 76032, GL_RS = 78080, GL_LD = 72;
__device__ __forceinline__ bf16x8 ldsfrag(LAS unsigned char* base, int row, int kof) { return *(const LAS bf16x8*)(base + (row * GL_LD + kof) * 2); }
template <bool OUT>
__device__ __forceinline__ void gla_item(LAS unsigned char* lds, bf16* P, const float* balpha, const float* gnorm, float* GE, float* GD, int item, int tid, int wid, int lane) {
    const int c16 = lane & 15, q = lane >> 4;
    const int b = item >> 6, hd = (item >> 4) & 3, seg = item & 15;
    const size_t row0 = (size_t)b * SEQ + seg * 256;
    LAS bf16* QT = (LAS bf16*)(lds + GL_QT); LAS bf16* KT = (LAS bf16*)(lds + GL_KT); LAS bf16* AT = (LAS bf16*)(lds + GL_AT); LAS bf16* ST = (LAS bf16*)(lds + GL_ST);
    LAS float* PART = (LAS float*)(lds + GL_PART); LAS float* BL = (LAS float*)(lds + GL_BL); LAS float* SS = (LAS float*)(lds + GL_SS); LAS float* RS = (LAS float*)(lds + GL_RS);
    f32x4 S[4];
#pragma unroll
    for (int nt = 0; nt < 4; ++nt) S[nt] = (f32x4){0.f, 0.f, 0.f, 0.f};
    if (OUT) {
#pragma unroll 1
        for (int sp = 0; sp < seg; ++sp) { const float* e = GE + (size_t)(item - seg + sp) * 8192; const float* dd = GD + (size_t)(item - seg + sp) * 64;
#pragma unroll
            for (int nt = 0; nt < 4; ++nt) { const float dec = dd[16 * nt + c16];
#pragma unroll
                for (int r = 0; r < 4; ++r) S[nt][r] = S[nt][r] * dec + e[(16 * wid + 4 * q + r) * 64 + 16 * nt + c16]; } } }
    float dtot = 0.f;
    const int d = tid & 63, part = tid >> 6;
    const float ba = balpha[hd * 64 + d];
#pragma unroll 1
    for (int ch = 0; ch < 4; ++ch) {
        const size_t rowc = row0 + ch * 64;
        float bcs[8]; float run = 0.f;
#pragma unroll
        for (int i = 0; i < 8; ++i) { const float x = bf2f(P[(rowc + part * 8 + i) * LDP + C_GL + hd * 64 + d]) + ba;
            const float la = (fminf(x, 0.f) - __logf(1.0f + __expf(-fabsf(x)))) * 0.0625f; run += la; bcs[i] = run; }
        PART[part * 64 + d] = run;
        __syncthreads();
        float off = 0.f, tot = 0.f;
#pragma unroll
        for (int p = 0; p < 8; ++p) { const float v = PART[p * 64 + d]; tot += v; off += (p < part) ? v : 0.f; }
        if (part == 0) { BL[d] = tot; dtot += tot; }
        const float etot = __expf(tot);
        { float kh[8];
#pragma unroll
          for (int i = 0; i < 8; ++i) { const float bi = off + bcs[i]; const int tok = part * 8 + i; const float kx = bf2f(P[(rowc + tok) * LDP + C_BK + hd * 64 + d]);
              const float eb = __expf(bi), ieb = __builtin_amdgcn_rcpf(eb);
              if (OUT) { const float qx = bf2f(P[(rowc + tok) * LDP + C_BQ + hd * 64 + d]); QT[tok * GL_LD + d] = f2bf(qx * 0.125f * eb); KT[tok * GL_LD + d] = f2bf(kx * ieb); }
              kh[i] = kx * (etot * ieb); }
          u32x4 w; w.x = pk2(kh[0], kh[1]); w.y = pk2(kh[2], kh[3]); w.z = pk2(kh[4], kh[5]); w.w = pk2(kh[6], kh[7]);
          *(LAS u32x4*)(lds + GL_KH + (d * GL_LD + part * 8) * 2) = w; }
        { const int v = tid & 127, tp = tid >> 7; float vv[16];
#pragma unroll
          for (int i = 0; i < 16; ++i) vv[i] = bf2f(P[(rowc + tp * 16 + i) * LDP + C_BV + hd * 128 + v]);
          u32x4 w0, w1; w0.x = pk2(vv[0], vv[1]); w0.y = pk2(vv[2], vv[3]); w0.z = pk2(vv[4], vv[5]); w0.w = pk2(vv[6], vv[7]);
          w1.x = pk2(vv[8], vv[9]); w1.y = pk2(vv[10], vv[11]); w1.z = pk2(vv[12], vv[13]); w1.w = pk2(vv[14], vv[15]);
          *(LAS u32x4*)(lds + GL_VT + (v * GL_LD + tp * 16) * 2) = w0; *(LAS u32x4*)(lds + GL_VT + (v * GL_LD + tp * 16 + 8) * 2) = w1; }
        if (OUT) {
#pragma unroll
            for (int nt = 0; nt < 4; ++nt)
#pragma unroll
                for (int r = 0; r < 4; ++r) ST[(16 * wid + 4 * q + r) * GL_LD + 16 * nt + c16] = f2bf(S[nt][r]); }
        __syncthreads();
        if (OUT) {
            { const int mt = wid >> 1;
#pragma unroll
              for (int t = 0; t < 2; ++t) { const int nt = 2 * (wid & 1) + t; f32x4 acc = (f32x4){0.f, 0.f, 0.f, 0.f};
                  if (nt <= mt) {
#pragma unroll
                      for (int kk = 0; kk < 2; ++kk) acc = MFMA16(ldsfrag(lds + GL_QT, 16 * mt + c16, 32 * kk + 8 * q), ldsfrag(lds + GL_KT, 16 * nt + c16, 32 * kk + 8 * q), acc); }
#pragma unroll
                  for (int r = 0; r < 4; ++r) { const int i = 16 * mt + 4 * q + r, j = 16 * nt + c16; AT[i * GL_LD + j] = f2bf((j <= i) ? acc[r] : 0.f); } } }
            __syncthreads();
            f32x4 o[4];
#pragma unroll
            for (int mt = 0; mt < 4; ++mt) { f32x4 acc = (f32x4){0.f, 0.f, 0.f, 0.f};
#pragma unroll
                for (int kk = 0; kk < 2; ++kk) if (kk == 0 || mt >= 2) acc = MFMA16(ldsfrag(lds + GL_AT, 16 * mt + c16, 32 * kk + 8 * q), ldsfrag(lds + GL_VT, 16 * wid + c16, 32 * kk + 8 * q), acc);
#pragma unroll
                for (int kk = 0; kk < 2; ++kk) acc = MFMA16(ldsfrag(lds + GL_QT, 16 * mt + c16, 32 * kk + 8 * q), ldsfrag(lds + GL_ST, 16 * wid + c16, 32 * kk + 8 * q), acc);
                o[mt] = acc; }
#pragma unroll
            for (int mt = 0; mt < 4; ++mt)
#pragma unroll
                for (int r = 0; r < 4; ++r) { float s = o[mt][r] * o[mt][r]; s += __shfl_xor(s, 1); s += __shfl_xor(s, 2); s += __shfl_xor(s, 4); s += __shfl_xor(s, 8);
                    if (c16 == 0) SS[wid * 64 + 16 * mt + 4 * q + r] = s; }
            __syncthreads();
            if (tid < 64) { float t = 0.f;
#pragma unroll
                for (int w = 0; w < 8; ++w) t += SS[w * 64 + tid];
                RS[tid] = rsqrtf(t * (1.0f / 128.0f) + EPS); }
            __syncthreads();
            const float gn = gnorm[hd * 128 + 16 * wid + c16];
#pragma unroll
            for (int mt = 0; mt < 4; ++mt)
#pragma unroll
                for (int r = 0; r < 4; ++r) { const int i = 16 * mt + 4 * q + r; bf16* rp = P + (rowc + i) * LDP + hd * 128 + 16 * wid + c16; const float bg = bf2f(rp[C_BG]);
                    rp[C_BV] = f2bf(o[mt][r] * RS[i] * gn * bg * sigmoidf_(bg)); }
        }
#pragma unroll
        for (int nt = 0; nt < 4; ++nt) { const float dec = __expf(BL[16 * nt + c16]); f32x4 acc = S[nt] * dec;
#pragma unroll
            for (int kk = 0; kk < 2; ++kk) acc = MFMA16(ldsfrag(lds + GL_VT, 16 * wid + c16, 32 * kk + 8 * q), ldsfrag(lds + GL_KH, 16 * nt + c16, 32 * kk + 8 * q), acc);
            S[nt] = acc; }
        __syncthreads();
    }
    if (!OUT) {
#pragma unroll
        for (int nt = 0; nt < 4; ++nt)
#pragma unroll
            for (int r = 0; r < 4; ++r) GE[(size_t)item * 8192 + (16 * wid + 4 * q + r) * 64 + 16 * nt + c16] = S[nt][r];
        if (part == 0) GD[(size_t)item * 64 + d] = __expf(dtot);
    }
}
#ifndef PH_MASK
#define PH_MASK 0xffff
#endif
__device__ __forceinline__ void cmul_acc(float& hr, float& hi, float ar, float ai, float gr, float gi) { const float nr = ar * hr - ai * hi + gr, ni = ar * hi + ai * hr + gi; hr = nr; hi = ni; }
constexpr int S5_WB = 0, S5_CZ = 67584, S5_HS = 102400, S5_LDW = 264, S5_LDC = 136;
template <bool OUT>
__device__ __forceinline__ void s5_wg_item(LAS unsigned char* lds, bf16* P, const bf16* TzT, const bf16* BzT, const bf16* CzT, const float* tab, float* SE, int item, int tid, int wid, int lane) {
    const int c16 = lane & 15, q = lane >> 4;
    const int b = item >> 6, g = (item >> 1) & 31, seg = 8 * (item & 1) + wid;
    const int id = ((b * 32 + g) << 4) + seg;
    const size_t tok0 = (size_t)b * SEQ + seg * 256;
    LAS unsigned char* wscr = lds + S5_HS + wid * 4352;
    bf16x8 uf[8];
#pragma unroll
    for (int kk = 0; kk < 8; ++kk) uf[kk] = *(const bf16x8*)(P + (tok0 + 16 * c16 + 2 * kk + (q >> 1)) * LDP + C_CU + 16 * g + 8 * (q & 1));
    { const bf16* bz = BzT + (size_t)g * 32768; u32x4 t[8];
#pragma unroll
      for (int i = 0; i < 8; ++i) t[i] = *(const u32x4*)(bz + (size_t)(tid + 512 * i) * 8);
#pragma unroll
      for (int i = 0; i < 8; ++i) { const int pc = tid + 512 * i; *(LAS u32x4*)(lds + S5_WB + (pc >> 5) * (S5_LDW * 2) + (pc & 31) * 16) = t[i]; } }
    __syncthreads();
    f32x4 G[8];
#pragma unroll
    for (int nt = 0; nt < 8; ++nt) { f32x4 acc = (f32x4){0.f, 0.f, 0.f, 0.f};
#pragma unroll
        for (int kk = 0; kk < 8; ++kk) acc = MFMA16(uf[kk], *(const LAS bf16x8*)(lds + S5_WB + ((16 * nt + c16) * S5_LDW + 32 * kk + 8 * q) * 2), acc);
        G[nt] = acc; }
    const float* tg = tab + (size_t)g * 6 * 64;
    float a16r[4], a16i[4], a64r[4], a64i[4];
#pragma unroll
    for (int n4 = 0; n4 < 4; ++n4) { const int p = 16 * n4 + c16; a16r[n4] = tg[0 * 64 + p]; a16i[n4] = tg[1 * 64 + p]; a64r[n4] = tg[2 * 64 + p]; a64i[n4] = tg[3 * 64 + p]; }
    float er[4], ei[4], ir[4], ii[4], cr[4], ci[4];
#pragma unroll
    for (int n4 = 0; n4 < 4; ++n4) { float hr = 0.f, hi = 0.f;
#pragma unroll
        for (int r = 0; r < 4; ++r) cmul_acc(hr, hi, a16r[n4], a16i[n4], G[n4][r], G[n4 + 4][r]);
        er[n4] = hr; ei[n4] = hi; ir[n4] = hr; ii[n4] = hi; }
#pragma unroll
    for (int s = 1; s < 4; ++s)
#pragma unroll
        for (int n4 = 0; n4 < 4; ++n4) { const float vr = __shfl(ir[n4], (lane - 16) & 63), vi = __shfl(ii[n4], (lane - 16) & 63);
            if (q == s) { ir[n4] = a64r[n4] * vr - a64i[n4] * vi + er[n4]; ii[n4] = a64r[n4] * vi + a64i[n4] * vr + ei[n4]; } }
#pragma unroll
    for (int n4 = 0; n4 < 4; ++n4) { const float vr = __shfl(ir[n4], (lane - 16) & 63), vi = __shfl(ii[n4], (lane - 16) & 63); cr[n4] = (q > 0) ? vr : 0.f; ci[n4] = (q > 0) ? vi : 0.f; }
    if (!OUT) {
        if (q == 3) {
#pragma unroll
            for (int n4 = 0; n4 < 4; ++n4) { SE[(size_t)id * 128 + 16 * n4 + c16] = ir[n4]; SE[(size_t)id * 128 + 64 + 16 * n4 + c16] = ii[n4]; } }
        __syncthreads();
        return;
    }
    float hinr[4] = {0.f, 0.f, 0.f, 0.f}, hini[4] = {0.f, 0.f, 0.f, 0.f};
    { float a256r[4], a256i[4];
#pragma unroll
      for (int n4 = 0; n4 < 4; ++n4) { const int p = 16 * n4 + c16; a256r[n4] = tg[4 * 64 + p]; a256i[n4] = tg[5 * 64 + p]; }
#pragma unroll 1
      for (int s0 = 0; s0 < seg; s0 += 4) { float evr[4][4], evi[4][4];
#pragma unroll
          for (int u = 0; u < 4; ++u) { const int sp = (s0 + u < seg) ? s0 + u : seg - 1; const float* e = SE + (size_t)(id - seg + sp) * 128;
#pragma unroll
              for (int n4 = 0; n4 < 4; ++n4) { evr[u][n4] = e[16 * n4 + c16]; evi[u][n4] = e[64 + 16 * n4 + c16]; } }
#pragma unroll
          for (int u = 0; u < 4; ++u) if (s0 + u < seg) {
#pragma unroll
              for (int n4 = 0; n4 < 4; ++n4) cmul_acc(hinr[n4], hini[n4], a256r[n4], a256i[n4], evr[u][n4], evi[u][n4]); } } }
    LAS bf16* Hs = (LAS bf16*)wscr;
#pragma unroll
    for (int n4 = 0; n4 < 4; ++n4) {
        float pr = 1.f, pi = 0.f;
#pragma unroll
        for (int i = 0; i < 3; ++i) if (i < q) { const float nr = pr * a64r[n4] - pi * a64i[n4], ni = pr * a64i[n4] + pi * a64r[n4]; pr = nr; pi = ni; }
        float hr = pr * hinr[n4] - pi * hini[n4] + cr[n4], hi = pr * hini[n4] + pi * hinr[n4] + ci[n4];
#pragma unroll
        for (int r = 0; r < 4; ++r) { Hs[(4 * q + r) * 136 + 16 * n4 + c16] = f2bf(hr); Hs[(4 * q + r) * 136 + 64 + 16 * n4 + c16] = f2bf(hi);
            cmul_acc(hr, hi, a16r[n4], a16i[n4], G[n4][r], G[n4 + 4][r]); } }
    asm volatile("" ::: "memory");
    bf16x8 hf[4];
#pragma unroll
    for (int kk = 0; kk < 4; ++kk) hf[kk] = *(const LAS bf16x8*)(wscr + (c16 * 136 + 32 * kk + 8 * q) * 2);
    const bf16* tz = TzT + (size_t)g * 65536; const bf16* cz = CzT + (size_t)g * 32768;
    unsigned ypk[16][2];
#pragma unroll
    for (int hl = 0; hl < 2; ++hl) {
        __syncthreads();
        { u32x4 t[8], tc[4];
          if (hl == 0) {
#pragma unroll
              for (int i = 0; i < 4; ++i) { const int pc = tid + 512 * i; t[i] = *(const u32x4*)(tz + (size_t)(pc >> 4) * 256 + (pc & 15) * 8); }
          } else {
#pragma unroll
              for (int i = 0; i < 8; ++i) { const int pc = tid + 512 * i; t[i] = *(const u32x4*)(tz + (size_t)(128 + (pc >> 5)) * 256 + (pc & 31) * 8); } }
#pragma unroll
          for (int i = 0; i < 4; ++i) { const int pc = tid + 512 * i; tc[i] = *(const u32x4*)(cz + (size_t)(128 * hl + (pc >> 4)) * 128 + (pc & 15) * 8); }
          if (hl == 0) {
#pragma unroll
              for (int i = 0; i < 4; ++i) { const int pc = tid + 512 * i; *(LAS u32x4*)(lds + S5_WB + (pc >> 4) * (S5_LDW * 2) + (pc & 15) * 16) = t[i]; }
          } else {
#pragma unroll
              for (int i = 0; i < 8; ++i) { const int pc = tid + 512 * i; *(LAS u32x4*)(lds + S5_WB + (pc >> 5) * (S5_LDW * 2) + (pc & 31) * 16) = t[i]; } }
#pragma unroll
          for (int i = 0; i < 4; ++i) { const int pc = tid + 512 * i; *(LAS u32x4*)(lds + S5_CZ + (pc >> 4) * (S5_LDC * 2) + (pc & 15) * 16) = tc[i]; } }
        __syncthreads();
#pragma unroll
        for (int n8 = 0; n8 < 8; ++n8) { const int nt = 8 * hl + n8; f32x4 acc = (f32x4){0.f, 0.f, 0.f, 0.f};
#pragma unroll
            for (int kk = 0; kk < 8; ++kk) if (kk <= (nt >> 1)) acc = MFMA16(uf[kk], *(const LAS bf16x8*)(lds + S5_WB + ((16 * n8 + c16) * S5_LDW + 32 * kk + 8 * q) * 2), acc);
#pragma unroll
            for (int kk = 0; kk < 4; ++kk) acc = MFMA16(hf[kk], *(const LAS bf16x8*)(lds + S5_CZ + ((16 * n8 + c16) * S5_LDC + 32 * kk + 8 * q) * 2), acc);
            float yv[4];
#pragma unroll
            for (int r = 0; r < 4; ++r) { const float y = acc[r], u2 = 1.5957691216057308f * (y + 0.044715f * y * y * y); yv[r] = y * sigmoidf_(u2); }
            ypk[nt][0] = pk2(yv[0], yv[1]); ypk[nt][1] = pk2(yv[2], yv[3]); }
    }
    __syncthreads();
    LAS bf16* Ys = (LAS bf16*)(lds + S5_WB + wid * 8192);
#pragma unroll
    for (int nt = 0; nt < 16; ++nt)
#pragma unroll
        for (int r = 0; r < 4; ++r) Ys[(16 * (4 * q + r) + nt) * 16 + c16] = (bf16)((r & 1) ? (ypk[nt][r >> 1] >> 16) : (ypk[nt][r >> 1] & 0xffffu));
    asm volatile("" ::: "memory");
#pragma unroll
    for (int i = 0; i < 8; ++i) { const int pc = lane + 64 * i, tk = pc >> 1, hf2 = pc & 1;
        *(u32x4*)(P + (tok0 + tk) * LDP + C_CU + 16 * g + 8 * hf2) = *(const LAS u32x4*)(lds + S5_WB + wid * 8192 + pc * 16); }
    __syncthreads();
}

template <bool SECOND>
#ifndef PROBE_TYPE
#define PROBE_TYPE -1
#endif
#define PBX(t) do { if ((t) == PROBE_TYPE) px_t0 = __builtin_amdgcn_s_memrealtime(); } while (0)
#define PEX(t) do { if ((t) == PROBE_TYPE) pacc += __builtin_amdgcn_s_memrealtime() - px_t0; } while (0)
__device__ __forceinline__ void mixers_phase(LAS unsigned char* lds, const float* const* in, unsigned char* ws, bf16* P, int l, int vcu, int G, int tid, int wid, int lane, unsigned long long& pacc) {
    unsigned long long px_t0 = 0; (void)px_t0;
    PBX(10); if (!SECOND && (PH_MASK & 0x100)) for (int it = vcu; it < 256; it += G) attn_item(lds, P, in[7] + l * 16, it, tid, wid, lane);
    PEX(10);
    float* GE = (float*)(ws + WS_GLAE); float* GD = (float*)(ws + WS_GLAD); float* SE = (float*)(ws + WS_S5E);
    const float* balpha = in[9] + l * 256; const float* gnorm = in[10] + l * 512;
    int tid1 = tid; asm volatile("" : "+v"(tid1));
    PBX(SECOND ? 13 : 11); if (PH_MASK & 0x200) for (int it = vcu; it < 256; it += G) gla_item<SECOND>(lds, P, balpha, gnorm, GE, GD, it, tid1, wid, tid1 & 63);
    PEX(SECOND ? 13 : 11);
    const bf16* TzT = (const bf16*)(ws + WS_S5M + (size_t)l * S5M_BYTES + S5M_TZ); const bf16* BzT = (const bf16*)(ws + WS_S5M + (size_t)l * S5M_BYTES + S5M_BZ);
    const bf16* CzT = (const bf16*)(ws + WS_S5M + (size_t)l * S5M_BYTES + S5M_CZ); const float* tab = (const float*)(ws + WS_TAB) + (size_t)l * 32 * 6 * 64;
    int tid2 = tid; asm volatile("" : "+v"(tid2));
    PBX(SECOND ? 14 : 12); if (PH_MASK & 0x400) for (int it = vcu; it < 256; it += G) s5_wg_item<SECOND>(lds, P, TzT, BzT, CzT, tab, SE, it, tid2, wid, tid2 & 63);
    PEX(SECOND ? 14 : 12);
}
#ifndef MK_MULTI
#define MK_MULTI 0
#endif
constexpr int N_PHASES = 2 + 6 * NLAYER;
struct Args { const float* in[22]; float* out; unsigned char* ws; int ph_lo, ph_hi; };
__global__ void __launch_bounds__(NWAVES * 64, 2) hybrid_fwd(Args args_) {
    extern __shared__ __attribute__((aligned(16))) unsigned char lds_raw[];
    const int G = gridDim.x; const int bx = blockIdx.x; const int vcu = (G % 8 == 0) ? (bx % 8) * (G / 8) + bx / 8 : bx;
    XcdBarrier bar;
    { LAS unsigned char* lds0 = (LAS unsigned char*)lds_raw;
      volatile LAS unsigned* MISC = (volatile LAS unsigned*)(lds0 + MISC_OFF);
      for (int u = threadIdx.x; u < (LDS_BYTES - LDSCTL_OFF) / 4; u += NWAVES * 64) ((LAS unsigned*)(lds0 + LDSCTL_OFF))[u] = 0u;
      __syncthreads();
      bar.bar = (unsigned*)(args_.ws + WS_CTL) + CW_BAR; bar.x = 0; bar.st = nullptr;
      if (!MK_MULTI) bar = xcd_barrier_post((unsigned*)(args_.ws + WS_CTL) + CW_BAR, MISC + 8); }
    const int lo = args_.ph_lo, hi = args_.ph_hi;
#ifndef PROBE_TYPE
#define PROBE_TYPE -1
#endif
#ifndef PROBE_K
#define PROBE_K 4
#endif
#ifndef PROBE_BLOCK
#define PROBE_BLOCK 0
#endif
    unsigned long long pr_acc = 0, pr_t0 = 0; (void)pr_t0;
#define PB(t) do { if ((t) == PROBE_TYPE) pr_t0 = __builtin_amdgcn_s_memrealtime(); } while (0)
#define PE(t) do { if ((t) == PROBE_TYPE) pr_acc += __builtin_amdgcn_s_memrealtime() - pr_t0; } while (0)
#define IN(k) (lo <= (k) && (k) < hi)
#if MK_MULTI
#define SEAM(k) do { } while (0)
#else
#define SEAM(k) do { if (IN(k) && IN((k) + 1)) xcd_barrier(bar); } while (0)
#endif
#define PHASE_IDS typedef const Args __attribute__((address_space(4)))* kargp_t; kargp_t ap = (kargp_t)__builtin_amdgcn_kernarg_segment_ptr(); asm volatile("" : "+s"(ap)); const Args& args = *(const Args*)ap; \
        int tid = threadIdx.x; asm volatile("" : "+v"(tid)); const int lane = tid & 63, wid = __builtin_amdgcn_readfirstlane(tid >> 6); (void)lane; (void)wid; \
        LAS unsigned char* lds = (LAS unsigned char*)lds_raw; asm volatile("" : "+s"(lds)); unsigned char* ws = args.ws; \
        bf16* const P = (bf16*)(ws + WS_P); bf16* const H = (bf16*)(ws + WS_H); float* const MOD = (float*)(ws + WS_MOD); (void)P; (void)H; (void)MOD;
#ifndef PH_MASK
#define PH_MASK 0xffff
#endif
    PB(0); if (IN(0) && (PH_MASK & 1)) { PHASE_IDS p0_mod_phase(lds, args.in, ws, vcu, G, tid, wid, lane); }
    SEAM(0); PE(0);
    PB(1); if (IN(1) && (PH_MASK & 2)) { PHASE_IDS
        if (G == 256) { if (vcu < 64) { PB(20); p0_s5_item(lds, args.in, ws, vcu >> 5, vcu & 31, tid); PE(20); }
                        else { const int gw = (vcu - 64) * NWAVES + wid; PB(21); p1_transposes(lds, args.in, ws, gw, 192 * NWAVES, wid, lane); __syncthreads(); PE(21); PB(25); prenorm_phase(args.in[0], MOD, H, gw, 192 * NWAVES, lane); __syncthreads(); PE(25); } }
        else { for (int it = vcu; it < 64; it += G) p0_s5_item(lds, args.in, ws, it >> 5, it & 31, tid);
               const int gw = vcu * NWAVES + wid; p1_transposes(lds, args.in, ws, gw, G * NWAVES, wid, lane); prenorm_phase(args.in[0], MOD, H, gw, G * NWAVES, lane); } }
    SEAM(1); PE(1);
#define LAYER(l, base) \
    PB(2); if (IN(base + 0) && (PH_MASK & 4)) { PHASE_IDS \
        pg8::Gemm g{H, (const bf16*)(ws + WS_WIN + (size_t)l * WIN_BYTES), TOK, LDP, DM, DM}; pg8::StaticOrder S; S.init(TOK, LDP, G, bx); \
        pg8::EpiBf16<0> E{P, LDP, nullptr, 0, 0, 1.f}; \
        pg8::gemm_phase<pg8::EpiBf16<0>, pg8::StaticOrder, true, true>(lds, g, S, E, tid); } \
    SEAM(base + 0); PE(2); \
    PB(3); if (IN(base + 1) && (PH_MASK & 8)) { PHASE_IDS mixers_phase<false>(lds, args.in, ws, P, l, vcu, G, tid, wid, lane, pr_acc); } \
    SEAM(base + 1); PE(3); \
    PB(4); if (IN(base + 2) && (PH_MASK & 8)) { PHASE_IDS mixers_phase<true>(lds, args.in, ws, P, l, vcu, G, tid, wid, lane, pr_acc); } \
    SEAM(base + 2); PE(4); \
    PB(5); if (IN(base + 3) && (PH_MASK & 16)) { PHASE_IDS \
        pg8::Gemm g{P + C_CU, (const bf16*)(ws + WS_WGLU + (size_t)l * WGLU_BYTES), TOK, 512, 512, LDP}; pg8::StaticOrder S; S.init(TOK, 512, G, bx); \
        pg8::EpiGlu E{P, LDP, C_CU, C_CG, args.in[20] + l * 512}; \
        PB(15); if (PH_MASK & 0x800) pg8::gemm_phase<pg8::EpiGlu, pg8::StaticOrder, true, true>(lds, g, S, E, tid); PE(15); PB(16); \
        if (!(PH_MASK & 0x1000)) {} else if (G == 256) { if (bx >= 128) { attn_item(lds, P, args.in[7] + l * 16, 256 + 2 * (bx - 128), tid, wid, lane); attn_item(lds, P, args.in[7] + l * 16, 257 + 2 * (bx - 128), tid, wid, lane); } } \
        else for (int it = 256 + vcu; it < 512; it += G) attn_item(lds, P, args.in[7] + l * 16, it, tid, wid, lane); PE(16); } \
    SEAM(base + 3); PE(5); \
    PB(6); if (IN(base + 4) && (PH_MASK & 32)) { PHASE_IDS \
        pg8::Gemm g{P, (const bf16*)(ws + WS_WOUT + (size_t)l * WOUT_BYTES), TOK, DM, 2048, LDP}; pg8::StaticOrder S; S.init(TOK, DM, G, bx); \
        pg8::EpiBf16<0> E{H, DM, nullptr, 0, 0, 1.f}; \
        pg8::gemm_phase<pg8::EpiBf16<0>, pg8::StaticOrder, true, true>(lds, g, S, E, tid); } \
    SEAM(base + 4); PE(6); \
    PB(7); if (IN(base + 5) && (PH_MASK & 64)) { PHASE_IDS \
        post_phase(l == 0 ? args.in[0] : args.out, args.out, H, args.in[5] + l * DM, MOD + (size_t)l * 4 * 3072, (l + 1 < NLAYER), args.in[4] + (l + 1 < NLAYER ? l + 1 : l) * DM, MOD + (size_t)(l + 1 < NLAYER ? l + 1 : l) * 4 * 3072, H, vcu, wid, lane); } \
    SEAM(base + 5); PE(7);
    LAYER(0, 2)
    LAYER(1, 8)
#undef LAYER
    if (PROBE_TYPE >= 0 && blockIdx.x == PROBE_BLOCK) { const unsigned long long te = __builtin_amdgcn_s_memrealtime(); while (__builtin_amdgcn_s_memrealtime() - te < (unsigned long long)PROBE_K * pr_acc) __builtin_amdgcn_s_sleep(20); }
#undef IN
#undef SEAM
}

extern "C" void kernel_launch(void* const* d_in, const int* in_sizes, int n_in, void* d_out, int out_size, void* d_ws, size_t ws_size, hipStream_t stream) {
    static int grid = 0;
    if (grid == 0) {
        if (n_in != 22 || in_sizes[0] != TOK * DM || out_size != TOK * DM || ws_size < WS_END) { fprintf(stderr, "kernel_launch: unexpected shapes (n_in %d, in0 %d, out %d, ws %zu)\n", n_in, n_in > 0 ? in_sizes[0] : -1, out_size, ws_size); grid = -1; return; }
        int dev = 0, cus = 0;
        if (hipGetDevice(&dev) != hipSuccess || hipDeviceGetAttribute(&cus, hipDeviceAttributeMultiprocessorCount, dev) != hipSuccess) { grid = -1; return; }
        if (hipFuncSetAttribute((const void*)hybrid_fwd, hipFuncAttributeMaxDynamicSharedMemorySize, LDS_BYTES) != hipSuccess) { fprintf(stderr, "kernel_launch: hipFuncSetAttribute failed\n"); grid = -1; return; }
        (void)hipGetLastError();
        grid = cus;
    }
    if (grid < 0) return;
    if (hipMemsetAsync((char*)d_ws + WS_CTL, 0, CTL_ZERO_BYTES, stream) != hipSuccess) { fprintf(stderr, "kernel_launch: memset failed\n"); return; }
    Args a{};
    for (int i = 0; i < 22; ++i) a.in[i] = (const float*)d_in[i];
    a.out = (float*)d_out; a.ws = (unsigned char*)d_ws;
#if MK_MULTI
    for (int ph = 0; ph < N_PHASES; ++ph) { a.ph_lo = ph; a.ph_hi = ph + 1; hipLaunchKernelGGL(hybrid_fwd, dim3(grid), dim3(NWAVES * 64), LDS_BYTES, stream, a); }
#else
    a.ph_lo = 0; a.ph_hi = N_PHASES;
    hipLaunchKernelGGL(hybrid_fwd, dim3(grid), dim3(NWAVES * 64), LDS_BYTES, stream, a);
#endif
    const hipError_t le = hipPeekAtLastError();
    if (le != hipSuccess) fprintf(stderr, "kernel_launch: launch failed: %s\n", hipGetErrorName(le));
}
```

```cpp
#include <hip/hip_runtime.h>
#include <cstdio>
#include <cstdint>
#include <cmath>
#define MK_MULTI 0
namespace pg8 {
#define PG8_LAS __attribute__((address_space(3)))
typedef unsigned short bf16_t;
typedef short bf16x8 __attribute__((ext_vector_type(8)));
typedef float f32x4 __attribute__((ext_vector_type(4)));
typedef unsigned u32x4 __attribute__((ext_vector_type(4)));
constexpr int BM = 256, BK = 64, HALF = 128, HTB = HALF * BK * 2  , STAGE_BYTES = 8 * HTB, NXCD = 8, WGM = 8;

__host__ __device__ __forceinline__ int lds_byte(int r, int c) { const int st = (r >> 4) * 2 + (c >> 5), rr = r & 15, cc = c & 31, ob = rr * 64 + cc * 2; return st * 1024 + (ob ^ (((ob >> 9) & 1) << 5)); }
__host__ __device__ __forceinline__ void stage_rc(int b, int& R, int& C) { const int st = b / 1024, sb = b % 1024, swz = sb ^ (((sb >> 9) & 1) << 5); R = (st >> 1) * 16 + swz / 64; C = (st & 1) * 32 + (swz % 64) / 2; }
__host__ __device__ __forceinline__ int perm32(int rho) { const int n = rho >> 4, i = rho & 15; return 8 * (i >> 2) + 4 * n + (i & 3); }

struct Unit { int pm, pn; };
struct Gemm { const bf16_t* A; const bf16_t* Bt; int M, N, K, lda; };

struct StaticOrder {
    int nM, nN, nwg, G, c;
    __host__ __device__ void init(int M, int N, int G_, int c_) { nM = M / BM; nN = N / BM; nwg = nM * nN; G = G_; c = c_; }
    __host__ __device__ bool next(int i, Unit& u) const {
        const long L = (long)i * G + c; if (L >= nwg) return false;
        int wgid = (int)L; { const int q = nwg / NXCD, r = nwg % NXCD, xcd = wgid % NXCD, off = wgid / NXCD; wgid = (xcd < r ? xcd * (q + 1) : r * (q + 1) + (xcd - r) * q) + off; }
        const int nig = WGM * nN, gid = wgid / nig, fm = gid * WGM, gsz = (nM - fm) < WGM ? (nM - fm) : WGM;
        u.pm = fm + ((wgid % nig) % gsz); u.pn = (wgid % nig) / gsz; return true;
    }
    __device__ __forceinline__ void a_ready(const Unit&) const {}
    __device__ __forceinline__ void done(const Unit&) const {}
};

__device__ __forceinline__ unsigned cvt_pk_bf16(float lo, float hi) { unsigned r; asm volatile("v_cvt_pk_bf16_f32 %0, %1, %2" : "=v"(r) : "v"(lo), "v"(hi)); return r; }
typedef float f32x2 __attribute__((ext_vector_type(2)));
__device__ __forceinline__ f32x2 gelu_pk(f32x2 v) {
    const f32x2 av = __builtin_elementwise_abs(v), d = av * 0.2316418882f + 1.0f;
    f32x2 t; t.x = __builtin_amdgcn_rcpf(d.x); t.y = __builtin_amdgcn_rcpf(d.y);
    f32x2 q = t * 0.5307027145f + (-0.7265760135f); q = q * t + 0.7107068705f; q = q * t + (-0.142248368f); q = q * t + 0.127414796f; q = q * t;
    const f32x2 s = (v * v) * (-0.72134752044f);
    f32x2 e; e.x = __builtin_amdgcn_exp2f(s.x); e.y = __builtin_amdgcn_exp2f(s.y);
    const f32x2 m = v * (q * e), r = v - m;
    f32x2 o; o.x = v.x < 0.f ? m.x : r.x; o.y = v.y < 0.f ? m.y : r.y; return o;
}

template <int ACT  > struct EpiBf16 {
    static constexpr bool PERM = true, AFTER_DRAIN = false; static_assert(ACT == 0 || ACT == 1, "EpiBf16: ACT is 0 (none) or 1 (gelu_pk)");
    bf16_t* O; int ldc; const float* bias; int split_cols; size_t split_stride; float scale0;
    __device__ __forceinline__ void operator()(const f32x4 (&acc)[2][2][4][2], const Unit& u, int wr, int wc, int fr, int fq) const {
        const int row0 = u.pm * BM + wr * 64 + fr; int colt = u.pn * BM; bf16_t* base = O;
        float sc = 1.f; if (split_cols) { const int t = colt / split_cols; base += (size_t)t * split_stride; colt -= t * split_cols; if (t == 0) sc = scale0; }
        const int col0 = colt + wc * 32 + 8 * fq, bcol0 = u.pn * BM + wc * 32 + 8 * fq;
        f32x4 bv[2][2];
#pragma unroll
        for (int bj = 0; bj < 2; ++bj)
#pragma unroll
            for (int n = 0; n < 2; ++n) bv[bj][n] = bias ? *(const f32x4*)(bias + bcol0 + bj * HALF + 4 * n) : (f32x4){0.f, 0.f, 0.f, 0.f};
#pragma unroll
        for (int ai = 0; ai < 2; ++ai)
#pragma unroll
            for (int m = 0; m < 4; ++m) { bf16_t* rowp = base + (size_t)(row0 + ai * HALF + m * 16) * ldc + col0;
#pragma unroll
                for (int bj = 0; bj < 2; ++bj) { f32x4 v0 = acc[ai][bj][m][0] + bv[bj][0], v1 = acc[ai][bj][m][1] + bv[bj][1];
                    if (ACT == 1) { f32x2 a = gelu_pk((f32x2){v0[0], v0[1]}), b = gelu_pk((f32x2){v0[2], v0[3]}), c = gelu_pk((f32x2){v1[0], v1[1]}), d = gelu_pk((f32x2){v1[2], v1[3]});
                        v0 = (f32x4){a.x, a.y, b.x, b.y}; v1 = (f32x4){c.x, c.y, d.x, d.y}; }
                    v0 = v0 * sc; v1 = v1 * sc; u32x4 w; w.x = cvt_pk_bf16(v0[0], v0[1]); w.y = cvt_pk_bf16(v0[2], v0[3]); w.z = cvt_pk_bf16(v1[0], v1[1]); w.w = cvt_pk_bf16(v1[2], v1[3]);
                    *(u32x4*)(rowp + bj * HALF) = w; } }
    }
};
struct EpiGlu {
    static constexpr bool PERM = true, AFTER_DRAIN = false;
    bf16_t* P; int ldp, col_y, col_g; const float* bglu;
    __device__ __forceinline__ void operator()(const f32x4 (&acc)[2][2][4][2], const Unit& u, int wr, int wc, int fr, int fq) const {
        const int row0 = u.pm * BM + wr * 64 + fr; const int col0 = u.pn * BM + wc * 32 + 8 * fq;
#pragma unroll
        for (int ai = 0; ai < 2; ++ai)
#pragma unroll
            for (int m = 0; m < 4; ++m) { bf16_t* rowp = P + (size_t)(row0 + ai * HALF + m * 16) * ldp;
#pragma unroll
                for (int bj = 0; bj < 2; ++bj) { const int col = col0 + bj * HALF;
                    const f32x4 b0 = *(const f32x4*)(bglu + col), b1 = *(const f32x4*)(bglu + col + 4);
                    const u32x4 yv = *(const u32x4*)(rowp + col_y + col), gv = *(const u32x4*)(rowp + col_g + col);
                    const f32x4 z0 = acc[ai][bj][m][0] + b0, z1 = acc[ai][bj][m][1] + b1;
                    float z[8] = {z0[0], z0[1], z0[2], z0[3], z1[0], z1[1], z1[2], z1[3]}; float o[8];
#pragma unroll
                    for (int e = 0; e < 8; ++e) { const unsigned yw = yv[e >> 1], gw = gv[e >> 1];
                        const float y = __uint_as_float((e & 1) ? (yw & 0xffff0000u) : (yw << 16)), g = __uint_as_float((e & 1) ? (gw & 0xffff0000u) : (gw << 16));
                        const float sz = __builtin_amdgcn_rcpf(1.0f + __expf(-z[e])), sg = __builtin_amdgcn_rcpf(1.0f + __expf(-g));
                        o[e] = y * sz * g * sg; }
                    u32x4 w; w.x = cvt_pk_bf16(o[0], o[1]); w.y = cvt_pk_bf16(o[2], o[3]); w.z = cvt_pk_bf16(o[4], o[5]); w.w = cvt_pk_bf16(o[6], o[7]);
                    *(u32x4*)(rowp + col_g + col) = w; } }
    }
};
template <class Epi, class Sched, bool ALIGN_EPI = false, bool SP2 = false>
__device__ __forceinline__ void gemm_phase(PG8_LAS unsigned char* lds, const Gemm g, const Sched& S, const Epi& E, int tid_in) {
    const int tid = tid_in, wid = __builtin_amdgcn_readfirstlane(tid >> 6), lane = tid & 63, wr = wid >> 2, wc = wid & 3, fr = lane & 15, fq = lane >> 4;
    const int K = g.K, nt = K / BK;
    unsigned voffA[2], voffB[2];
#pragma unroll
    for (int i = 0; i < 2; ++i) { int R, C; stage_rc(tid * 16 + i * 8192, R, C); const int Rb = Epi::PERM ? ((R & ~31) + perm32(R & 31)) : R;
        voffA[i] = (unsigned)(R * g.lda + C) * 2u; voffB[i] = (unsigned)(Rb * K + C) * 2u; }
    const size_t kstep = (size_t)(BK * 2);
    const size_t hstepB = (size_t)HALF * K * 2, hstepA = (size_t)HALF * g.lda * 2;
    const size_t tstepB = 2 * hstepB, tstepA = 2 * hstepA;
    const unsigned ldsw = (unsigned)wid * 1024u;
    const int aoff = lds_byte(wr * 64 + fr, fq * 8), boff = lds_byte(wc * 32 + fr, fq * 8);
#define PG8_SA(b, h) (((b) * 2 + (h)) * HTB)
#define PG8_SB(b, h) ((4 + (b) * 2 + (h)) * HTB)
#define PG8_STAGE(bufoff, gbase, voff) do { _Pragma("unroll") for (int _i = 0; _i < 2; ++_i) \
        __builtin_amdgcn_global_load_lds((const unsigned*)((const char*)(gbase) + (voff)[_i]), (PG8_LAS unsigned*)(lds + (bufoff) + ldsw + _i * 8192), 16, 0, 0); } while (0)
#define PG8_LDA(dst, b, h) do { _Pragma("unroll") for (int m = 0; m < 4; ++m) _Pragma("unroll") for (int k = 0; k < 2; ++k) dst[m][k] = *(const PG8_LAS bf16x8*)(lds + PG8_SA(b, h) + aoff + m * 2048 + k * 1024); } while (0)
#define PG8_LDB(dst, b, h) do { _Pragma("unroll") for (int n = 0; n < 2; ++n) _Pragma("unroll") for (int k = 0; k < 2; ++k) dst[n][k] = *(const PG8_LAS bf16x8*)(lds + PG8_SB(b, h) + boff + n * 2048 + k * 1024); } while (0)
#define PG8_MMA(ai, bj, At, Bt) do { __builtin_amdgcn_s_setprio(1); _Pragma("unroll") for (int m = 0; m < 4; ++m) _Pragma("unroll") for (int n = 0; n < 2; ++n) _Pragma("unroll") for (int k = 0; k < 2; ++k) \
        acc[ai][bj][m][n] = __builtin_amdgcn_mfma_f32_16x16x32_bf16(Bt[n][k], At[m][k], acc[ai][bj][m][n], 0, 0, 0); __builtin_amdgcn_s_setprio(0); } while (0)
#define PG8_WAIT_V(n) asm volatile("s_waitcnt vmcnt(" #n ")" ::: "memory")
#define PG8_WAIT_L(n) asm volatile("s_waitcnt lgkmcnt(" #n ")" ::: "memory")
#define PG8_BAR __builtin_amdgcn_s_barrier()
#define PG8_SCHED __builtin_amdgcn_sched_barrier(0)
    Unit cur, nxt; int ui = 0;
    if (!S.next(0, cur)) return;
    f32x4 acc[2][2][4][2];
#pragma unroll
    for (int a = 0; a < 2; ++a)
#pragma unroll
        for (int b = 0; b < 2; ++b)
#pragma unroll
            for (int m = 0; m < 4; ++m)
#pragma unroll
                for (int n = 0; n < 2; ++n) acc[a][b][m][n] = (f32x4){0.f, 0.f, 0.f, 0.f};
    bf16x8 At[4][2], B0[2][2], B1[2][2];
    const char* cA = (const char*)g.A + (size_t)cur.pm * tstepA; const char* cB = (const char*)g.Bt + (size_t)cur.pn * tstepB;
    S.a_ready(cur);
    if constexpr (SP2) {
        PG8_STAGE(PG8_SB(0, 0), cB, voffB); PG8_STAGE(PG8_SB(0, 1), cB + hstepB, voffB); PG8_STAGE(PG8_SA(0, 0), cA, voffA); PG8_STAGE(PG8_SA(0, 1), cA + hstepA, voffA);
        if (wr == 1) PG8_BAR;
        PG8_WAIT_V(2); PG8_BAR;
        PG8_STAGE(PG8_SB(1, 0), cB + kstep, voffB); PG8_STAGE(PG8_SA(1, 0), cA + kstep, voffA); PG8_STAGE(PG8_SB(1, 1), cB + hstepB + kstep, voffB);
        PG8_WAIT_V(6); PG8_BAR;
    } else {
        PG8_STAGE(PG8_SB(0, 0), cB, voffB); PG8_STAGE(PG8_SA(0, 0), cA, voffA); PG8_STAGE(PG8_SB(0, 1), cB + hstepB, voffB); PG8_STAGE(PG8_SA(0, 1), cA + hstepA, voffA);
        if (wr == 1) PG8_BAR;
        PG8_WAIT_V(4); PG8_BAR;
        PG8_STAGE(PG8_SB(1, 0), cB + kstep, voffB); PG8_STAGE(PG8_SA(1, 0), cA + kstep, voffA); PG8_STAGE(PG8_SB(1, 1), cB + hstepB + kstep, voffB);
        PG8_WAIT_V(6); PG8_BAR;
    }
    for (;;) {
        const bool has_next = S.next(ui + 1, nxt);
        const char* nA = has_next ? (const char*)g.A + (size_t)nxt.pm * tstepA : cA; const char* nB = has_next ? (const char*)g.Bt + (size_t)nxt.pn * tstepB : cB;
        for (int t = 0; t < nt; t += 2) {
            const bool last = (t == nt - 2);
            const char* a1 = cA + (size_t)(t + 1) * kstep;
            const char* a2 = last ? nA : cA + (size_t)(t + 2) * kstep; const char* b2 = last ? nB : cB + (size_t)(t + 2) * kstep;
            const char* a3 = a2 + kstep; const char* b3 = b2 + kstep;
            if (last && has_next) S.a_ready(nxt);
            if constexpr (SP2) {
            PG8_LDB(B0, 0, 0); PG8_LDB(B1, 0, 1); PG8_SCHED; PG8_LDA(At, 0, 0); PG8_STAGE(PG8_SA(1, 1), a1 + hstepA, voffA);
            PG8_WAIT_V(8); PG8_WAIT_L(0); PG8_BAR; PG8_MMA(0, 0, At, B0); PG8_MMA(0, 1, At, B1); PG8_BAR; PG8_SCHED;
            PG8_LDA(At, 0, 1); PG8_STAGE(PG8_SB(0, 0), b2, voffB); PG8_STAGE(PG8_SB(0, 1), b2 + hstepB, voffB); PG8_STAGE(PG8_SA(0, 0), a2, voffA);
            PG8_WAIT_V(8); PG8_WAIT_L(0); PG8_BAR; PG8_MMA(1, 0, At, B0); PG8_MMA(1, 1, At, B1); PG8_BAR; PG8_SCHED;
            PG8_LDB(B0, 1, 0); PG8_LDB(B1, 1, 1); PG8_SCHED; PG8_LDA(At, 1, 0); PG8_STAGE(PG8_SA(0, 1), a2 + hstepA, voffA);
            PG8_WAIT_V(8); PG8_WAIT_L(0); PG8_BAR; PG8_MMA(0, 0, At, B0); PG8_MMA(0, 1, At, B1); PG8_BAR; PG8_SCHED;
            PG8_LDA(At, 1, 1); PG8_STAGE(PG8_SB(1, 0), b3, voffB); PG8_STAGE(PG8_SB(1, 1), b3 + hstepB, voffB); PG8_STAGE(PG8_SA(1, 0), a3, voffA);
            PG8_WAIT_V(8); PG8_WAIT_L(0); PG8_BAR; PG8_MMA(1, 0, At, B0); PG8_MMA(1, 1, At, B1); PG8_BAR; PG8_SCHED;
            } else {
            PG8_LDB(B0, 0, 0); PG8_SCHED; PG8_LDA(At, 0, 0); PG8_STAGE(PG8_SA(1, 1), a1 + hstepA, voffA);
            PG8_WAIT_L(8); PG8_BAR; PG8_WAIT_L(0); PG8_MMA(0, 0, At, B0); PG8_BAR; PG8_SCHED;
            PG8_LDB(B1, 0, 1); PG8_STAGE(PG8_SB(0, 0), b2, voffB);
            PG8_BAR; PG8_WAIT_L(0); PG8_MMA(0, 1, At, B1); PG8_BAR;
            PG8_LDA(At, 0, 1); PG8_STAGE(PG8_SA(0, 0), a2, voffA);
            PG8_BAR; PG8_WAIT_L(0); PG8_MMA(1, 0, At, B0); PG8_BAR; PG8_SCHED;
            PG8_STAGE(PG8_SB(0, 1), b2 + hstepB, voffB);
            PG8_WAIT_V(6); PG8_BAR; PG8_MMA(1, 1, At, B1); PG8_BAR;
            PG8_LDB(B0, 1, 0); PG8_SCHED; PG8_LDA(At, 1, 0); PG8_STAGE(PG8_SA(0, 1), a2 + hstepA, voffA);
            PG8_WAIT_L(8); PG8_BAR; PG8_WAIT_L(0); PG8_MMA(0, 0, At, B0); PG8_BAR; PG8_SCHED;
            PG8_LDB(B1, 1, 1); PG8_STAGE(PG8_SB(1, 0), b3, voffB);
            PG8_BAR; PG8_WAIT_L(0); PG8_MMA(0, 1, At, B1); PG8_BAR;
            PG8_LDA(At, 1, 1); PG8_STAGE(PG8_SA(1, 0), a3, voffA);
            PG8_BAR; PG8_WAIT_L(0); PG8_MMA(1, 0, At, B0); PG8_BAR; PG8_SCHED;
            PG8_STAGE(PG8_SB(1, 1), b3 + hstepB, voffB);
            PG8_WAIT_V(6); PG8_BAR; PG8_MMA(1, 1, At, B1); PG8_BAR;
            }
        }
        if constexpr (ALIGN_EPI) { if (wr == 0) PG8_BAR; }
        if constexpr (!Epi::AFTER_DRAIN) { E(acc, cur, wr, wc, fr, fq); S.done(cur); }
        if (!has_next) break;
#pragma unroll
        for (int a = 0; a < 2; ++a)
#pragma unroll
            for (int b = 0; b < 2; ++b)
#pragma unroll
                for (int m = 0; m < 4; ++m)
#pragma unroll
                    for (int n = 0; n < 2; ++n) acc[a][b][m][n] = (f32x4){0.f, 0.f, 0.f, 0.f};
        cur = nxt; cA = nA; cB = nB; ++ui;
        if constexpr (ALIGN_EPI) { if (wr == 1) PG8_BAR; }
    }
    PG8_WAIT_V(0);
    if constexpr (!ALIGN_EPI) { if (wr == 0) PG8_BAR; }
    PG8_BAR;
    if constexpr (Epi::AFTER_DRAIN) { E.fused(acc, cur, wr, wc, fr, fq, lds, wid, lane); S.done(cur); }
#undef PG8_SA
#undef PG8_SB
#undef PG8_STAGE
#undef PG8_LDA
#undef PG8_LDB
#undef PG8_MMA
#undef PG8_WAIT_V
#undef PG8_WAIT_L
#undef PG8_BAR
#undef PG8_SCHED
}
}
#define GAS __attribute__((address_space(1)))
#define LAS __attribute__((address_space(3)))
typedef unsigned short bf16;
typedef short bf16x8 __attribute__((ext_vector_type(8)));
typedef float f32x4 __attribute__((ext_vector_type(4)));
typedef float f32x16 __attribute__((ext_vector_type(16)));
typedef unsigned u32x4 __attribute__((ext_vector_type(4)));
typedef unsigned u32x2 __attribute__((ext_vector_type(2)));
typedef short s16x4 __attribute__((ext_vector_type(4)));
typedef GAS unsigned gu32;
constexpr int NWAVES = 8;
constexpr int NBATCH = 4, SEQ = 4096, DM = 1024, TOK = NBATCH * SEQ, NLAYER = 2;
constexpr int LDP = 5376, WIN_COLS = 5136;
constexpr int C_AQ = 0, C_BV = 1024, C_CG = 1536, C_AK = 2048, C_AV = 2304, C_AG = 2560, C_BQ = 3584, C_BK = 3840, C_GL = 4096, C_BG = 4352, C_CU = 4864;
constexpr float EPS = 1e-6f, LOG2E = 1.4426950408889634f;
constexpr size_t MiB = 1u << 20;
constexpr size_t WS_CTL = 0, CTL_ZERO_BYTES = 64 * 1024;
constexpr int CW_BAR = 1024;
constexpr size_t WS_MOD = 1 * MiB;
constexpr size_t WS_TAB = 1 * MiB + 256 * 1024;
constexpr size_t WS_WIN = 2 * MiB, WIN_BYTES = (size_t)LDP * DM * 2;
constexpr size_t WS_WOUT = 23 * MiB, WOUT_BYTES = (size_t)DM * 2048 * 2;
constexpr size_t WS_WGLU = 31 * MiB, WGLU_BYTES = (size_t)512 * 512 * 2;
constexpr size_t WS_S5M = 32 * MiB, S5M_BYTES = 8 * MiB;
constexpr size_t S5M_TZ = 0, S5M_BZ = 4 * MiB, S5M_CZ = 6 * MiB;
constexpr size_t WS_H = 48 * MiB;
constexpr size_t WS_GLAE = 48 * MiB;
constexpr size_t WS_GLAD = 56 * MiB;
constexpr size_t WS_S5E = 57 * MiB;
constexpr size_t WS_P = 80 * MiB;
constexpr size_t WS_END = 248 * MiB;
static_assert(WS_WIN + 2 * WIN_BYTES <= WS_WOUT && WS_WOUT + 2 * WOUT_BYTES <= WS_WGLU && WS_WGLU + 2 * WGLU_BYTES <= WS_S5M && WS_S5M + 2 * S5M_BYTES <= WS_H, "ws map");
static_assert(WS_H + (size_t)TOK * DM * 2 <= WS_P && WS_P + (size_t)TOK * LDP * 2 <= WS_END && WS_S5E + 2048 * 128 * 4 <= WS_P, "ws map 2");
constexpr int RING_BYTES = 143360, LDSCTL_OFF = RING_BYTES, MISC_OFF = LDSCTL_OFF + 320, LDS_BYTES = 147456;

#define RLX_AGENT __ATOMIC_RELAXED, __HIP_MEMORY_SCOPE_AGENT
#define LDS_WAIT() asm volatile("s_waitcnt lgkmcnt(0)" ::: "memory")
typedef float f32x2_t __attribute__((ext_vector_type(2))); typedef __bf16 bf16x2_t __attribute__((ext_vector_type(2)));
__device__ __forceinline__ unsigned pk2(float lo, float hi) { f32x2_t v = {lo, hi}; bf16x2_t b = __builtin_convertvector(v, bf16x2_t); return __builtin_bit_cast(unsigned, b); }
__device__ __forceinline__ bf16 f2bf(float f) { return (bf16)(pk2(f, 0.f) & 0xffffu); }
__device__ __forceinline__ float bf2f(bf16 b) { return __uint_as_float((unsigned)b << 16); }
__device__ __forceinline__ float bflo(unsigned w) { return __uint_as_float(w << 16); }
__device__ __forceinline__ float bfhi(unsigned w) { return __uint_as_float(w & 0xffff0000u); }
__device__ __forceinline__ float sigmoidf_(float x) { return __builtin_amdgcn_rcpf(1.0f + __expf(-x)); }
__device__ __forceinline__ float wave_sum(float v) {
#pragma unroll
    for (int o = 1; o < 64; o <<= 1) v += __shfl_xor(v, o);
    return v;
}
#define MFMA16(a, b, c) __builtin_amdgcn_mfma_f32_16x16x32_bf16((a), (b), (c), 0, 0, 0)
#define MFMA32(a, b, c) __builtin_amdgcn_mfma_f32_32x32x16_bf16((a), (b), (c), 0, 0, 0)
#define XB_TMO      128
#define XB_XCNT(j)  (256  + 64 * (j))
#define XB_XSUB(j)  (1280 + 64 * (j))
#define XB_XGEN(j)  (2304 + 64 * (j))
#define XB_TOP      3328
#define XB_TOPGEN   3392
#define XCD_BAR_WORDS 3456
#define XB_SPIN_CAP (1u << 18)

__device__ __forceinline__ unsigned xb_ld(unsigned* p)              { return __hip_atomic_load(p, __ATOMIC_RELAXED, __HIP_MEMORY_SCOPE_AGENT); }
__device__ __forceinline__ unsigned xb_add(unsigned* p, unsigned v) { return __hip_atomic_fetch_add(p, v, __ATOMIC_RELAXED, __HIP_MEMORY_SCOPE_AGENT); }
__device__ __forceinline__ unsigned xb_xcc_id() { return (unsigned)__builtin_amdgcn_s_getreg((3 << 11) | 20) & 0xFu; }
#define XB_SPIN(cond, bar) do { unsigned _sp = 0; while (cond) { __builtin_amdgcn_s_sleep(1); \
    if ((++_sp & 255u) == 0u) { if (xb_ld(&(bar)[XB_TMO])) break; if (_sp > XB_SPIN_CAP) { atomicAdd(&(bar)[XB_TMO], 1u); break; } } } } while (0)

struct XcdBarrier {
    unsigned* bar; unsigned x;
    volatile LAS unsigned* st;
};

__device__ __forceinline__ XcdBarrier xcd_barrier_post(unsigned* bar, volatile LAS unsigned* st) {
    XcdBarrier b; b.bar = bar; b.x = xb_xcc_id(); b.st = st;
    if (threadIdx.x == 0) (void)xb_add(&bar[XB_XCNT(b.x)], 1u);
    return b;
}
__device__ __forceinline__ void xcd_barrier_complete(unsigned* bar, unsigned x, unsigned& nloc, unsigned& nx) {
    const unsigned G = gridDim.x * gridDim.y * gridDim.z;
    unsigned sum, cnt, mine, sp = 0u;
    for (;;) {
        sum = 0u; cnt = 0u; mine = 0u;
#pragma unroll
        for (unsigned j = 0; j < 16; ++j) { const unsigned c = xb_ld(&bar[XB_XCNT(j)]); sum += c; cnt += (c > 0u) ? 1u : 0u; mine = (j == x) ? c : mine; }
        if (sum == G) break;
        __builtin_amdgcn_s_sleep(1);
        if ((++sp & 255u) == 0u) { if (xb_ld(&bar[XB_TMO])) break; if (sp > XB_SPIN_CAP) { atomicAdd(&bar[XB_TMO], 1u); break; } }
    }
    nloc = mine > 0u ? mine : 1u; nx = cnt > 0u ? cnt : 1u;
}

__device__ __forceinline__ void xcd_barrier(const XcdBarrier& b) {
    asm volatile("s_waitcnt vmcnt(0)" ::: "memory");
    __syncthreads();
    if (threadIdx.x == 0) {
        unsigned* bar = b.bar;
        __builtin_amdgcn_s_waitcnt(0);
        unsigned nloc = b.st[0], nx = b.st[1];
        if (nloc == 0u) { xcd_barrier_complete(bar, b.x, nloc, nx); b.st[0] = nloc; b.st[1] = nx; }
        const unsigned old = xb_add(&bar[XB_XSUB(b.x)], 1u);
        const unsigned gen = old / nloc;
        if (old + 1u == (gen + 1u) * nloc) {
            __builtin_amdgcn_fence(__ATOMIC_RELEASE, "agent");
            asm volatile("s_waitcnt vmcnt(0)" ::: "memory");
            const unsigned og = xb_add(&bar[XB_TOP], 1u);
            const unsigned tg = og / nx;
            if (og + 1u == (tg + 1u) * nx) xb_add(&bar[XB_TOPGEN], 1u);
            else XB_SPIN(xb_ld(&bar[XB_TOPGEN]) == tg, bar);
            __builtin_amdgcn_fence(__ATOMIC_ACQUIRE, "agent");
            xb_add(&bar[XB_XGEN(b.x)], 1u);
            asm volatile("s_waitcnt vmcnt(0)" ::: "memory");
        } else {
            XB_SPIN(xb_ld(&bar[XB_XGEN(b.x)]) == gen, bar);
            __builtin_amdgcn_fence(__ATOMIC_ACQUIRE, "agent");
            asm volatile("s_waitcnt vmcnt(0)" ::: "memory");
        }
    }
    __syncthreads();
}
__device__ __forceinline__ int win_srccol(int n0) {
    if (n0 < 1024) return n0;
    if (n0 < 1536) return 3072 + (n0 - 1024);
    if (n0 < 2048) return 4624 + (n0 - 1536);
    if (n0 < 2304) return 1024 + (n0 - 2048);
    if (n0 < 2560) return 1280 + (n0 - 2304);
    if (n0 < 3584) return 1536 + (n0 - 2560);
    if (n0 < 3840) return 2560 + (n0 - 3584);
    if (n0 < 4096) return 2816 + (n0 - 3840);
    if (n0 < 4352) return -1;
    if (n0 < 4864) return 3600 + (n0 - 4352);
    return 4112 + (n0 - 4864);
}
__device__ __forceinline__ void p0_mod_item(LAS unsigned char* lds, const float* c, const float* wmod, const float* bmod, const float* gpre, float* mod, int it, int tid, int wid, int lane) {
    LAS float* sc = (LAS float*)lds; LAS float* part = (LAS float*)(lds + 16384);
    const int l = it / 96, nb = it % 96, col = nb * 32 + (lane & 31), ks = wid * 2 + (lane >> 5);
    const float* wp = wmod + (size_t)l * 1024 * 3072 + col + (size_t)ks * 64 * 3072;
    float w[64];
#pragma unroll
    for (int i = 0; i < 64; ++i) w[i] = wp[(size_t)i * 3072];
    for (int i = tid; i < 4096; i += 512) { const float cv = c[i]; sc[i] = cv * sigmoidf_(cv); }
    __syncthreads();
    float a0 = 0.f, a1 = 0.f, a2 = 0.f, a3 = 0.f;
#pragma unroll
    for (int i = 0; i < 64; ++i) { const int k = ks * 64 + i; a0 += sc[k] * w[i]; a1 += sc[1024 + k] * w[i]; a2 += sc[2048 + k] * w[i]; a3 += sc[3072 + k] * w[i]; }
    part[(ks * 4 + 0) * 32 + (lane & 31)] = a0; part[(ks * 4 + 1) * 32 + (lane & 31)] = a1; part[(ks * 4 + 2) * 32 + (lane & 31)] = a2; part[(ks * 4 + 3) * 32 + (lane & 31)] = a3;
    __syncthreads();
    if (tid < 128) { const int b = tid >> 5, n = nb * 32 + (tid & 31); float s = 0.f;
#pragma unroll
        for (int k = 0; k < 16; ++k) s += part[(k * 4 + b) * 32 + (tid & 31)];
        s += bmod[l * 3072 + n];
        if (n >= 1024 && n < 2048) s = gpre[l * 1024 + n - 1024] * (1.0f + s);
        mod[(size_t)(l * 4 + b) * 3072 + n] = s; }
    __syncthreads();
}

__device__ __forceinline__ void p0_s5_item(LAS unsigned char* lds, const float* const* in, unsigned char* ws, int l, int g, int tid) {
    LAS float* PWr = (LAS float*)lds; LAS float* PWi = PWr + 17 * 64; LAS float* BTr = PWi + 17 * 64; LAS float* BTi = BTr + 1024;
    LAS float* CRr = BTi + 1024; LAS float* CRi = CRr + 1024; LAS float* KC = CRi + 1024;
    const float* are = in[11] + (size_t)(l * 32 + g) * 64; const float* aim = in[12] + (size_t)(l * 32 + g) * 64;
    const double dt = exp((double)in[13][l * 32 + g]);
    const float* bre = in[14] + (size_t)(l * 32 + g) * 1024; const float* bim = in[15] + (size_t)(l * 32 + g) * 1024;
    const float* cre = in[16] + (size_t)(l * 32 + g) * 1024; const float* cim = in[17] + (size_t)(l * 32 + g) * 1024;
    const float* dd = in[18] + (size_t)l * 512 + g * 16;
    float* tab = (float*)(ws + WS_TAB) + (size_t)(l * 32 + g) * 6 * 64;
    if (tid < 64) { const int p = tid; const double ar = are[p], ai = aim[p];
        const double mag = exp(ar * dt), abr = mag * cos(ai * dt), abi = mag * sin(ai * dt), den = ar * ar + ai * ai, nr = abr - 1.0;
        const double fr = (nr * ar + abi * ai) / den, fi = (abi * ar - nr * ai) / den;
#pragma unroll 4
        for (int h = 0; h < 16; ++h) { const double br = bre[p * 16 + h], bi = bim[p * 16 + h]; BTr[p * 16 + h] = (float)(fr * br - fi * bi); BTi[p * 16 + h] = (float)(fr * bi + fi * br); }
        double pr = 1.0, pi = 0.0;
#pragma unroll 1
        for (int tau = 0; tau <= 16; ++tau) { PWr[tau * 64 + p] = (float)pr; PWi[tau * 64 + p] = (float)pi; const double t = pr * abr - pi * abi; pi = pr * abi + pi * abr; pr = t; }
        double qr = (double)0, qi = (double)0; { qr = 1.0; qi = 0.0; double xr = abr, xi = abi;
#pragma unroll 1
          for (int s2 = 0; s2 < 8; ++s2) { const double t = xr * xr - xi * xi; xi = 2.0 * xr * xi; xr = t;
              if (s2 == 3) { tab[0 * 64 + p] = (float)xr; tab[1 * 64 + p] = (float)xi; }
              if (s2 == 5) { tab[2 * 64 + p] = (float)xr; tab[3 * 64 + p] = (float)xi; }
              if (s2 == 7) { tab[4 * 64 + p] = (float)xr; tab[5 * 64 + p] = (float)xi; } } }
        (void)qr; (void)qi; }
    for (int idx = tid; idx < 1024; idx += 512) { CRr[idx] = cre[idx]; CRi[idx] = cim[idx]; }
    __syncthreads();
    { const int hp = tid & 15, tau = (tid >> 4) & 15, hh = __builtin_amdgcn_readfirstlane(tid >> 8); float acc[8];
#pragma unroll
      for (int j = 0; j < 8; ++j) acc[j] = 0.f;
#pragma unroll 4
      for (int p = 0; p < 64; ++p) { const float pr = PWr[tau * 64 + p], pi = PWi[tau * 64 + p], br = BTr[p * 16 + hp], bi = BTi[p * 16 + hp];
          const float xr = pr * br - pi * bi, xi = pr * bi + pi * br;
#pragma unroll
          for (int j = 0; j < 8; ++j) acc[j] += cre[(8 * hh + j) * 64 + p] * xr - cim[(8 * hh + j) * 64 + p] * xi; }
#pragma unroll
      for (int j = 0; j < 8; ++j) { const int h = 8 * hh + j; float s = acc[j]; if (tau == 0 && h == hp) s += dd[h]; KC[(tau * 16 + h) * 16 + hp] = s; } }
    __syncthreads();
    bf16* Tz = (bf16*)(ws + WS_S5M + (size_t)l * S5M_BYTES + S5M_TZ) + (size_t)g * 65536;
    bf16* Bz = (bf16*)(ws + WS_S5M + (size_t)l * S5M_BYTES + S5M_BZ) + (size_t)g * 32768;
    bf16* Cz = (bf16*)(ws + WS_S5M + (size_t)l * S5M_BYTES + S5M_CZ) + (size_t)g * 32768;
#pragma unroll 1
    for (int i = 0; i < 16; ++i) { const int idx = tid + 512 * i, n = idx >> 5, c = idx & 31, ii = n >> 4, h = n & 15, j = c >> 1, hp0 = 8 * (c & 1); float v[8];
#pragma unroll
        for (int e = 0; e < 8; ++e) v[e] = (j <= ii) ? KC[((ii - j) * 16 + h) * 16 + hp0 + e] : 0.f;
        u32x4 o; o.x = pk2(v[0], v[1]); o.y = pk2(v[2], v[3]); o.z = pk2(v[4], v[5]); o.w = pk2(v[6], v[7]); *(u32x4*)(Tz + (size_t)n * 256 + 8 * c) = o; }
#pragma unroll 1
    for (int i = 0; i < 8; ++i) { const int idx = tid + 512 * i, n = idx >> 5, c = idx & 31, p = n & 63, im = n >> 6, j = c >> 1, hp0 = 8 * (c & 1), tau = 15 - j; float v[8];
        const float pr = PWr[tau * 64 + p], pi = PWi[tau * 64 + p];
#pragma unroll
        for (int e = 0; e < 8; ++e) { const float br = BTr[p * 16 + hp0 + e], bi = BTi[p * 16 + hp0 + e]; v[e] = im ? (pr * bi + pi * br) : (pr * br - pi * bi); }
        u32x4 o; o.x = pk2(v[0], v[1]); o.y = pk2(v[2], v[3]); o.z = pk2(v[4], v[5]); o.w = pk2(v[6], v[7]); *(u32x4*)(Bz + (size_t)n * 256 + 8 * c) = o; }
#pragma unroll 1
    for (int i = 0; i < 8; ++i) { const int idx = tid + 512 * i, n = idx >> 4, c = idx & 15, ii = n >> 4, h = n & 15, im = c >> 3, tau = ii + 1; float v[8];
#pragma unroll
        for (int e = 0; e < 8; ++e) { const int p = (8 * c + e) & 63; const float cr = CRr[h * 64 + p], ci = CRi[h * 64 + p], pr = PWr[tau * 64 + p], pi = PWi[tau * 64 + p];
            v[e] = im ? -(cr * pi + ci * pr) : (cr * pr - ci * pi); }
        u32x4 o; o.x = pk2(v[0], v[1]); o.y = pk2(v[2], v[3]); o.z = pk2(v[4], v[5]); o.w = pk2(v[6], v[7]); *(u32x4*)(Cz + (size_t)n * 128 + 8 * c) = o; }
    __syncthreads();}

__device__ __forceinline__ void p0_mod_phase(LAS unsigned char* lds, const float* const* in, unsigned char* ws, int vcu, int G, int tid, int wid, int lane) {
    for (int it = vcu; it < 192; it += G) p0_mod_item(lds, in[1], in[2], in[3], in[4], (float*)(ws + WS_MOD), it, tid, wid, lane);
}
struct TrDesc { const float* src; bf16* dst; int ldw, K; const float* walpha; int acol; };
__device__ __forceinline__ TrDesc tr_decode(const float* const* in, unsigned char* ws, int it) {
    constexpr int I_IN = 16 * 168, I_OUT = 32 * 32, I_GLU = 8 * 16, I_L = I_IN + I_OUT + I_GLU;
    const int l = it / I_L; int r = it % I_L; TrDesc d; d.walpha = nullptr; d.acol = 0;
    if (r < I_IN) { const int nb = r % 168, kb = r / 168, n0 = nb * 32, sc = win_srccol(n0);
        const float* W = in[6] + (size_t)l * DM * WIN_COLS; bf16* WT = (bf16*)(ws + WS_WIN + (size_t)l * WIN_BYTES);
        d.ldw = WIN_COLS; d.K = DM; d.dst = WT + (size_t)n0 * DM + kb * 64;
        if (sc >= 0) d.src = W + (size_t)(kb * 64) * WIN_COLS + sc; else { d.src = W + (size_t)(kb * 64) * WIN_COLS + 3584; d.walpha = in[8] + (size_t)l * 16 * 256; d.acol = n0 - C_GL; }
        return d; }
    r -= I_IN;
    if (r < I_OUT) { const int nb = r % 32, kb = r / 32; d.ldw = DM; d.K = 2048; d.src = in[21] + (size_t)l * 2048 * DM + (size_t)(kb * 64) * DM + nb * 32; d.dst = (bf16*)(ws + WS_WOUT + (size_t)l * WOUT_BYTES) + (size_t)(nb * 32) * 2048 + kb * 64; return d; }
    r -= I_OUT;
    { const int nb = r % 16, kb = r / 16; d.ldw = 512; d.K = 512; d.src = in[19] + (size_t)l * 512 * 512 + (size_t)(kb * 64) * 512 + nb * 32; d.dst = (bf16*)(ws + WS_WGLU + (size_t)l * WGLU_BYTES) + (size_t)(nb * 32) * 512 + kb * 64; return d; }
}
__device__ __forceinline__ void tr_load(const TrDesc& d, f32x4 (&v)[8], int lane) {
    const int kr = lane >> 3, c4 = lane & 7;
#pragma unroll
    for (int i = 0; i < 8; ++i) v[i] = __builtin_nontemporal_load((const f32x4*)(d.src + (size_t)(8 * i + kr) * d.ldw + 4 * c4));
}
__device__ __forceinline__ void tr_lds_fill(const TrDesc& d, const f32x4 (&v)[8], LAS float* scr, int lane) {
    if (d.walpha == nullptr) { const int kr = lane >> 3, c4 = lane & 7;
#pragma unroll
        for (int i = 0; i < 8; ++i) { LAS float* q = scr + (8 * i + kr) * 33 + 4 * c4; q[0] = v[i][0]; q[1] = v[i][1]; q[2] = v[i][2]; q[3] = v[i][3]; } }
    else {
        float wa[16];
#pragma unroll
        for (int r = 0; r < 16; ++r) wa[r] = d.walpha[r * 256 + d.acol + (lane & 31)];
#pragma unroll 4
        for (int i = 0; i < 32; ++i) { const int kk = 2 * i + (lane >> 5); const f32x4* wr = (const f32x4*)(d.src + (size_t)kk * d.ldw);
            const f32x4 w0 = wr[0], w1 = wr[1], w2 = wr[2], w3 = wr[3];
            float s = (w0[0] * wa[0] + w0[1] * wa[1]) + (w0[2] * wa[2] + w0[3] * wa[3]); s += (w1[0] * wa[4] + w1[1] * wa[5]) + (w1[2] * wa[6] + w1[3] * wa[7]);
            s += (w2[0] * wa[8] + w2[1] * wa[9]) + (w2[2] * wa[10] + w2[3] * wa[11]); s += (w3[0] * wa[12] + w3[1] * wa[13]) + (w3[2] * wa[14] + w3[3] * wa[15]);
            scr[kk * 33 + (lane & 31)] = s; } }
}
__device__ __forceinline__ void tr_store(const TrDesc& d, LAS float* scr, int lane) {
    const int c = lane & 7;
#pragma unroll
    for (int j = 0; j < 4; ++j) { const int n = (lane >> 3) + 8 * j; const LAS float* s = scr + (8 * c) * 33 + n;
        u32x4 o; o.x = pk2(s[0 * 33], s[1 * 33]); o.y = pk2(s[2 * 33], s[3 * 33]); o.z = pk2(s[4 * 33], s[5 * 33]); o.w = pk2(s[6 * 33], s[7 * 33]);
        *(u32x4*)(d.dst + (size_t)n * d.K + 8 * c) = o; }
}
__device__ __forceinline__ void p1_transposes(LAS unsigned char* lds, const float* const* in, unsigned char* ws, int gw, int NGW, int wid, int lane, int it_lo, int NIT) {
    LAS float* scr = (LAS float*)(lds + wid * 16384);
    int it = it_lo + gw; if (it >= NIT) return;
    TrDesc d = tr_decode(in, ws, it); f32x4 v[8];
    if (d.walpha == nullptr) tr_load(d, v, lane);
    for (;;) {
        tr_lds_fill(d, v, scr, lane);
        const int nx = it + NGW; TrDesc dn = d; const bool more = nx < NIT;
        if (more) { dn = tr_decode(in, ws, nx); if (dn.walpha == nullptr) tr_load(dn, v, lane); }
        LDS_WAIT(); asm volatile("" ::: "memory");
        tr_store(d, scr, lane);
        LDS_WAIT(); asm volatile("" ::: "memory");
        if (!more) break;
        d = dn; it = nx;
    }
}
__device__ __forceinline__ void prenorm_phase(const float* x, const float* mod  , bf16* H, int gw, int NGW, int lane) {
    f32x4 v[4], n1[4], n2[4];
    int m = gw; if (m >= TOK) return;
#pragma unroll
    for (int j = 0; j < 4; ++j) { v[j] = *(const f32x4*)(x + (size_t)m * DM + 256 * j + 4 * lane); n1[j] = v[j]; n2[j] = v[j]; }
    if (m + NGW < TOK) {
#pragma unroll
        for (int j = 0; j < 4; ++j) n1[j] = *(const f32x4*)(x + (size_t)(m + NGW) * DM + 256 * j + 4 * lane); }
    for (; m < TOK; m += NGW) {
        if (m + 2 * NGW < TOK) {
#pragma unroll
            for (int j = 0; j < 4; ++j) n2[j] = *(const f32x4*)(x + (size_t)(m + 2 * NGW) * DM + 256 * j + 4 * lane); }
        const int b = m / SEQ; const float* mb = mod + (size_t)b * 3072; f32x4 ga[4], sh[4]; float ss = 0.f;
#pragma unroll
        for (int j = 0; j < 4; ++j) { ss += (v[j][0] * v[j][0] + v[j][1] * v[j][1]) + (v[j][2] * v[j][2] + v[j][3] * v[j][3]); ga[j] = *(const f32x4*)(mb + 1024 + 256 * j + 4 * lane); sh[j] = *(const f32x4*)(mb + 256 * j + 4 * lane); }
        const float r = rsqrtf(wave_sum(ss) * (1.0f / DM) + EPS);
#pragma unroll
        for (int j = 0; j < 4; ++j) { const f32x4 o = v[j] * r * ga[j] + sh[j]; u32x2 w; w.x = pk2(o[0], o[1]); w.y = pk2(o[2], o[3]); *(u32x2*)(H + (size_t)m * DM + 256 * j + 4 * lane) = w; }
#pragma unroll
        for (int j = 0; j < 4; ++j) { v[j] = n1[j]; n1[j] = n2[j]; }
    }
}
__device__ __forceinline__ void post_phase(const float* xin, float* xout, const bf16* Y, const float* gpost, const float* mod  , bool do_next, const float* gpre_n, const float* mod_n, bf16* Hn,
                                           int vcu, int wid, int lane) {
    const int gw = vcu * NWAVES + wid; const int m0 = gw * 8, b = m0 / SEQ;
    if (m0 >= TOK) return;
    f32x4 gp[4], gt[4];
#pragma unroll
    for (int j = 0; j < 4; ++j) { const int col = 256 * j + 4 * lane; gp[j] = *(const f32x4*)(gpost + col); gt[j] = *(const f32x4*)(mod + (size_t)b * 3072 + 2048 + col); }
    u32x2 yw[4], nyw[4]; f32x4 xv[4], nxv[4];
#pragma unroll
    for (int j = 0; j < 4; ++j) { yw[j] = *(const u32x2*)(Y + (size_t)m0 * DM + 256 * j + 4 * lane); xv[j] = *(const f32x4*)(xin + (size_t)m0 * DM + 256 * j + 4 * lane); nyw[j] = yw[j]; nxv[j] = xv[j]; }
#pragma unroll 1
    for (int i = 0; i < 8; ++i) { const int m = m0 + i; f32x4 y[4]; float ss = 0.f;
        if (i < 7) {
#pragma unroll
            for (int j = 0; j < 4; ++j) { nyw[j] = *(const u32x2*)(Y + (size_t)(m + 1) * DM + 256 * j + 4 * lane); nxv[j] = *(const f32x4*)(xin + (size_t)(m + 1) * DM + 256 * j + 4 * lane); } }
#pragma unroll
        for (int j = 0; j < 4; ++j) { y[j] = (f32x4){bflo(yw[j].x), bfhi(yw[j].x), bflo(yw[j].y), bfhi(yw[j].y)}; ss += (y[j][0] * y[j][0] + y[j][1] * y[j][1]) + (y[j][2] * y[j][2] + y[j][3] * y[j][3]); }
        const float r = rsqrtf(wave_sum(ss) * (1.0f / DM) + EPS); float s2 = 0.f;
#pragma unroll
        for (int j = 0; j < 4; ++j) { xv[j] = xv[j] + gt[j] * (y[j] * r * gp[j]); *(f32x4*)(xout + (size_t)m * DM + 256 * j + 4 * lane) = xv[j];
            s2 += (xv[j][0] * xv[j][0] + xv[j][1] * xv[j][1]) + (xv[j][2] * xv[j][2] + xv[j][3] * xv[j][3]); }
        if (do_next) { const float r2 = rsqrtf(wave_sum(s2) * (1.0f / DM) + EPS);
#pragma unroll
            for (int j = 0; j < 4; ++j) { const int col = 256 * j + 4 * lane; const f32x4 ga = *(const f32x4*)(mod_n + (size_t)b * 3072 + 1024 + col), sh = *(const f32x4*)(mod_n + (size_t)b * 3072 + col);
                const f32x4 o = xv[j] * r2 * ga + sh; u32x2 w; w.x = pk2(o[0], o[1]); w.y = pk2(o[2], o[3]); *(u32x2*)(Hn + (size_t)m * DM + 256 * j + 4 * lane) = w; } }
#pragma unroll
        for (int j = 0; j < 4; ++j) { yw[j] = nyw[j]; xv[j] = nxv[j]; }
    }
}
typedef short v4i16_t __attribute__((ext_vector_type(4)));
__device__ __forceinline__ s16x4 vtr(LAS unsigned char* p) { return __builtin_bit_cast(s16x4, __builtin_amdgcn_ds_read_tr16_b64_v4i16((LAS v4i16_t*)p)); }
__device__ __forceinline__ void attn_item(LAS unsigned char* lds, bf16* P, const float* sinks, int item, int tid, int wid, int lane) {
    const int r32 = lane & 31, hi = lane >> 5;
    const int qblk = item & 31, kvh = (item >> 5) & 3, b = item >> 7, q0 = qblk * 128;
    const size_t rowbase = (size_t)b * SEQ;
    LAS unsigned char* Ks = lds; LAS unsigned char* Vs = lds + 32768; LAS float* ost = (LAS float*)(lds + 65536 + wid * 8704);
    { const int kr = tid >> 1, hf = tid & 1, key = q0 - 128 + kr; u32x4 kv[4], vv[4];
      if (key >= 0) { const bf16* src = P + (rowbase + key) * LDP + kvh * 64 + hf * 32;
#pragma unroll
          for (int c = 0; c < 4; ++c) { kv[c] = *(const u32x4*)(src + C_AK + c * 8); vv[c] = *(const u32x4*)(src + C_AV + c * 8); } }
      else {
#pragma unroll
          for (int c = 0; c < 4; ++c) { kv[c] = (u32x4){0u, 0u, 0u, 0u}; vv[c] = (u32x4){0u, 0u, 0u, 0u}; } }
#pragma unroll
      for (int c = 0; c < 4; ++c) { const int ch = hf * 4 + c; *(LAS u32x4*)(Ks + kr * 128 + ((ch ^ (kr & 7)) << 4)) = kv[c]; *(LAS u32x4*)(Vs + kr * 128 + (ch << 4)) = vv[c]; } }
    __syncthreads();
    const int g = wid >> 1, half = wid & 1, head = kvh * 4 + g;
    const float slope2 = exp2f(-0.5f * (float)(head + 1)) * LOG2E, sink2 = sinks[head] * LOG2E;
    const int q16 = (lane & 15) >> 2, p16 = lane & 3, dblk = (lane >> 4) & 1;
#pragma unroll 1
    for (int sb = 0; sb < 2; ++sb) {
        const int qs = q0 + half * 64 + sb * 32, lrow0 = half * 64 + sb * 32;
        const bf16* qp = P + (rowbase + qs + r32) * LDP + C_AQ + head * 64 + hi * 8;
        bf16x8 qf[4];
#pragma unroll
        for (int kk = 0; kk < 4; ++kk) qf[kk] = *(const bf16x8*)(qp + kk * 16);
        f32x16 S[5]; float m = sink2; int e = r32 - 4 * hi; asm volatile("" : "+v"(e)); const float ef = (float)e;
#pragma unroll
        for (int kt = 0; kt < 5; ++kt) { f32x16 acc;
            const bool tile_ok = (qs - 128 + 32 * kt) >= 0;
            if (tile_ok) {
                const float base = -slope2 * ((float)(128 - 32 * kt) + ef);
#pragma unroll
                for (int r = 0; r < 16; ++r) acc[r] = fmaf(slope2, (float)((r & 3) + 8 * (r >> 2)), base);
                const int krow = lrow0 + 32 * kt + r32;
#pragma unroll
                for (int kk = 0; kk < 4; ++kk) { const int ch = 2 * kk + hi; const bf16x8 kf = *(const LAS bf16x8*)(Ks + krow * 128 + ((ch ^ (krow & 7)) << 4)); acc = MFMA32(kf, qf[kk], acc); }
#pragma unroll
                for (int r = 0; r < 16; ++r) { const int cr = (r & 3) + 8 * (r >> 2); float s = acc[r];
                    if (kt == 0) s = (e < cr) ? s : -INFINITY; if (kt == 4) s = (e >= cr) ? s : -INFINITY;
                    S[kt][r] = s; m = fmaxf(m, s); }
            } else {
#pragma unroll
                for (int r = 0; r < 16; ++r) S[kt][r] = -INFINITY;
            }
            __builtin_amdgcn_sched_barrier(0); }
        m = fmaxf(m, __shfl_xor(m, 32));
        float l = 0.f;
#pragma unroll
        for (int kt = 0; kt < 5; ++kt)
#pragma unroll
            for (int r = 0; r < 16; ++r) { const float p = __builtin_amdgcn_exp2f(S[kt][r] - m); S[kt][r] = p; l += p; }
        l += __shfl_xor(l, 32); l += __builtin_amdgcn_exp2f(sink2 - m);
        const float inv_l = 1.0f / l;
        f32x16 o0, o1;
#pragma unroll
        for (int r = 0; r < 16; ++r) { o0[r] = 0.f; o1[r] = 0.f; }
#pragma unroll
        for (int kt = 0; kt < 5; ++kt)
#pragma unroll
            for (int ks = 0; ks < 2; ++ks) { u32x4 pw; pw.x = pk2(S[kt][8 * ks + 0], S[kt][8 * ks + 1]); pw.y = pk2(S[kt][8 * ks + 2], S[kt][8 * ks + 3]); pw.z = pk2(S[kt][8 * ks + 4], S[kt][8 * ks + 5]); pw.w = pk2(S[kt][8 * ks + 6], S[kt][8 * ks + 7]);
                const bf16x8 pa = __builtin_bit_cast(bf16x8, pw);
                LAS unsigned char* vb = Vs + (lrow0 + 32 * kt + 16 * ks + 4 * hi + q16) * 128 + dblk * 32 + p16 * 8;
                const s16x4 a0 = vtr(vb), a1 = vtr(vb + 8 * 128), b0 = vtr(vb + 64), b1 = vtr(vb + 64 + 8 * 128);
                const bf16x8 v0 = __builtin_shufflevector(a0, a1, 0, 1, 2, 3, 4, 5, 6, 7), v1 = __builtin_shufflevector(b0, b1, 0, 1, 2, 3, 4, 5, 6, 7);
                o0 = MFMA32(pa, v0, o0); o1 = MFMA32(pa, v1, o1); __builtin_amdgcn_sched_barrier(0); }
#pragma unroll
        for (int r = 0; r < 16; ++r) { const int qr = (r & 3) + 8 * (r >> 2) + 4 * hi; ost[qr * 68 + r32] = o0[r]; ost[qr * 68 + 32 + r32] = o1[r]; }
        asm volatile("" ::: "memory");
        { const int row = lane >> 1, hf = lane & 1; const float sc = __shfl(inv_l, row);
          bf16* rp = P + (rowbase + qs + row) * LDP + head * 64 + hf * 32;
#pragma unroll
          for (int c = 0; c < 4; ++c) { const u32x4 gv = *(const u32x4*)(rp + C_AG + 8 * c);
              const f32x4 x0 = *(const LAS f32x4*)(ost + row * 68 + hf * 32 + 8 * c), x1 = *(const LAS f32x4*)(ost + row * 68 + hf * 32 + 8 * c + 4);
              float gg[8] = {bflo(gv.x), bfhi(gv.x), bflo(gv.y), bfhi(gv.y), bflo(gv.z), bfhi(gv.z), bflo(gv.w), bfhi(gv.w)};
              float xx[8] = {x0[0], x0[1], x0[2], x0[3], x1[0], x1[1], x1[2], x1[3]};
#pragma unroll
              for (int e = 0; e < 8; ++e) xx[e] = xx[e] * sc * gg[e] * sigmoidf_(gg[e]);
              u32x4 w; w.x = pk2(xx[0], xx[1]); w.y = pk2(xx[2], xx[3]); w.z = pk2(xx[4], xx[5]); w.w = pk2(xx[6], xx[7]);
              *(u32x4*)(rp + C_AQ + 8 * c) = w; } }
        asm volatile("" ::: "memory");
    }
    __syncthreads();
}
constexpr int GL_QT = 0, GL_KT = 9216, GL_KH = 18432, GL_AT = 27648, GL_VT = 36864, GL_ST = 55296, GL_PART = 73728, GL_BL = 75776, GL_SS = 76032, GL_RS = 78080, GL_LD = 72;
__device__ __forceinline__ bf16x8 ldsfrag(LAS unsigned char* base, int row, int kof) { return *(const LAS bf16x8*)(base + (row * GL_LD + kof) * 2); }
template <bool OUT>
__device__ __forceinline__ void gla_item(LAS unsigned char* lds, bf16* P, const float* balpha, const float* gnorm, float* GE, float* GD, int item, int tid, int wid, int lane) {
    const int c16 = lane & 15, q = lane >> 4;
    const int b = item >> 6, hd = (item >> 4) & 3, seg = item & 15;
    const size_t row0 = (size_t)b * SEQ + seg * 256;
    LAS bf16* QT = (LAS bf16*)(lds + GL_QT); LAS bf16* KT = (LAS bf16*)(lds + GL_KT); LAS bf16* AT = (LAS bf16*)(lds + GL_AT); LAS bf16* ST = (LAS bf16*)(lds + GL_ST);
    LAS float* PART = (LAS float*)(lds + GL_PART); LAS float* BL = (LAS float*)(lds + GL_BL); LAS float* SS = (LAS float*)(lds + GL_SS); LAS float* RS = (LAS float*)(lds + GL_RS);
    f32x4 S[4];
#pragma unroll
    for (int nt = 0; nt < 4; ++nt) S[nt] = (f32x4){0.f, 0.f, 0.f, 0.f};
    if (OUT) {
#pragma unroll 1
        for (int sp = 0; sp < seg; ++sp) { const float* e = GE + (size_t)(item - seg + sp) * 8192; const float* dd = GD + (size_t)(item - seg + sp) * 64;
#pragma unroll
            for (int nt = 0; nt < 4; ++nt) { const float dec = dd[16 * nt + c16];
#pragma unroll
                for (int r = 0; r < 4; ++r) S[nt][r] = S[nt][r] * dec + e[(16 * wid + 4 * q + r) * 64 + 16 * nt + c16]; } } }
    float dtot = 0.f;
    const int d = tid & 63, part = tid >> 6;
    const float ba = balpha[hd * 64 + d];
#pragma unroll 1
    for (int ch = 0; ch < 4; ++ch) {
        const size_t rowc = row0 + ch * 64;
        float bcs[8]; float run = 0.f;
#pragma unroll
        for (int i = 0; i < 8; ++i) { const float x = bf2f(P[(rowc + part * 8 + i) * LDP + C_GL + hd * 64 + d]) + ba;
            const float la = (fminf(x, 0.f) - __logf(1.0f + __expf(-fabsf(x)))) * 0.0625f; run += la; bcs[i] = run; }
        PART[part * 64 + d] = run;
        __syncthreads();
        float off = 0.f, tot = 0.f;
#pragma unroll
        for (int p = 0; p < 8; ++p) { const float v = PART[p * 64 + d]; tot += v; off += (p < part) ? v : 0.f; }
        if (part == 0) { BL[d] = tot; dtot += tot; }
        const float etot = __expf(tot);
        { float kh[8];
#pragma unroll
          for (int i = 0; i < 8; ++i) { const float bi = off + bcs[i]; const int tok = part * 8 + i; const float kx = bf2f(P[(rowc + tok) * LDP + C_BK + hd * 64 + d]);
              const float eb = __expf(bi), ieb = __builtin_amdgcn_rcpf(eb);
              if (OUT) { const float qx = bf2f(P[(rowc + tok) * LDP + C_BQ + hd * 64 + d]); QT[tok * GL_LD + d] = f2bf(qx * 0.125f * eb); KT[tok * GL_LD + d] = f2bf(kx * ieb); }
              kh[i] = kx * (etot * ieb); }
          u32x4 w; w.x = pk2(kh[0], kh[1]); w.y = pk2(kh[2], kh[3]); w.z = pk2(kh[4], kh[5]); w.w = pk2(kh[6], kh[7]);
          *(LAS u32x4*)(lds + GL_KH + (d * GL_LD + part * 8) * 2) = w; }
        { const int v = tid & 127, tp = tid >> 7; float vv[16];
#pragma unroll
          for (int i = 0; i < 16; ++i) vv[i] = bf2f(P[(rowc + tp * 16 + i) * LDP + C_BV + hd * 128 + v]);
          u32x4 w0, w1; w0.x = pk2(vv[0], vv[1]); w0.y = pk2(vv[2], vv[3]); w0.z = pk2(vv[4], vv[5]); w0.w = pk2(vv[6], vv[7]);
          w1.x = pk2(vv[8], vv[9]); w1.y = pk2(vv[10], vv[11]); w1.z = pk2(vv[12], vv[13]); w1.w = pk2(vv[14], vv[15]);
          *(LAS u32x4*)(lds + GL_VT + (v * GL_LD + tp * 16) * 2) = w0; *(LAS u32x4*)(lds + GL_VT + (v * GL_LD + tp * 16 + 8) * 2) = w1; }
        if (OUT) {
#pragma unroll
            for (int nt = 0; nt < 4; ++nt)
#pragma unroll
                for (int r = 0; r < 4; ++r) ST[(16 * wid + 4 * q + r) * GL_LD + 16 * nt + c16] = f2bf(S[nt][r]); }
        __syncthreads();
        if (OUT) {
            { const int mt = wid >> 1;
#pragma unroll
              for (int t = 0; t < 2; ++t) { const int nt = 2 * (wid & 1) + t; f32x4 acc = (f32x4){0.f, 0.f, 0.f, 0.f};
                  if (nt <= mt) {
#pragma unroll
                      for (int kk = 0; kk < 2; ++kk) acc = MFMA16(ldsfrag(lds + GL_QT, 16 * mt + c16, 32 * kk + 8 * q), ldsfrag(lds + GL_KT, 16 * nt + c16, 32 * kk + 8 * q), acc); }
#pragma unroll
                  for (int r = 0; r < 4; ++r) { const int i = 16 * mt + 4 * q + r, j = 16 * nt + c16; AT[i * GL_LD + j] = f2bf((j <= i) ? acc[r] : 0.f); } } }
            __syncthreads();
            f32x4 o[4];
#pragma unroll
            for (int mt = 0; mt < 4; ++mt) { f32x4 acc = (f32x4){0.f, 0.f, 0.f, 0.f};
#pragma unroll
                for (int kk = 0; kk < 2; ++kk) if (kk == 0 || mt >= 2) acc = MFMA16(ldsfrag(lds + GL_AT, 16 * mt + c16, 32 * kk + 8 * q), ldsfrag(lds + GL_VT, 16 * wid + c16, 32 * kk + 8 * q), acc);
#pragma unroll
                for (int kk = 0; kk < 2; ++kk) acc = MFMA16(ldsfrag(lds + GL_QT, 16 * mt + c16, 32 * kk + 8 * q), ldsfrag(lds + GL_ST, 16 * wid + c16, 32 * kk + 8 * q), acc);
                o[mt] = acc; }
#pragma unroll
            for (int mt = 0; mt < 4; ++mt)
#pragma unroll
                for (int r = 0; r < 4; ++r) { float s = o[mt][r] * o[mt][r]; s += __shfl_xor(s, 1); s += __shfl_xor(s, 2); s += __shfl_xor(s, 4); s += __shfl_xor(s, 8);
                    if (c16 == 0) SS[wid * 64 + 16 * mt + 4 * q + r] = s; }
            __syncthreads();
            if (tid < 64) { float t = 0.f;
#pragma unroll
                for (int w = 0; w < 8; ++w) t += SS[w * 64 + tid];
                RS[tid] = rsqrtf(t * (1.0f / 128.0f) + EPS); }
            __syncthreads();
            const float gn = gnorm[hd * 128 + 16 * wid + c16];
#pragma unroll
            for (int mt = 0; mt < 4; ++mt)
#pragma unroll
                for (int r = 0; r < 4; ++r) { const int i = 16 * mt + 4 * q + r; bf16* rp = P + (rowc + i) * LDP + hd * 128 + 16 * wid + c16; const float bg = bf2f(rp[C_BG]);
                    rp[C_BV] = f2bf(o[mt][r] * RS[i] * gn * bg * sigmoidf_(bg)); }
        }
#pragma unroll
        for (int nt = 0; nt < 4; ++nt) { const float dec = __expf(BL[16 * nt + c16]); f32x4 acc = S[nt] * dec;
#pragma unroll
            for (int kk = 0; kk < 2; ++kk) acc = MFMA16(ldsfrag(lds + GL_VT, 16 * wid + c16, 32 * kk + 8 * q), ldsfrag(lds + GL_KH, 16 * nt + c16, 32 * kk + 8 * q), acc);
            S[nt] = acc; }
        __syncthreads();
    }
    if (!OUT) {
#pragma unroll
        for (int nt = 0; nt < 4; ++nt)
#pragma unroll
            for (int r = 0; r < 4; ++r) GE[(size_t)item * 8192 + (16 * wid + 4 * q + r) * 64 + 16 * nt + c16] = S[nt][r];
        if (part == 0) GD[(size_t)item * 64 + d] = __expf(dtot);
    }
}
#ifndef PH_MASK
#define PH_MASK 0xffff
#endif
__device__ __forceinline__ void cmul_acc(float& hr, float& hi, float ar, float ai, float gr, float gi) { const float nr = ar * hr - ai * hi + gr, ni = ar * hi + ai * hr + gi; hr = nr; hi = ni; }
constexpr int S5_WB = 0, S5_CZ = 67584, S5_HS = 102400, S5_LDW = 264, S5_LDC = 136;
template <bool OUT>
__device__ __forceinline__ void s5_wg_item(LAS unsigned char* lds, bf16* P, const bf16* TzT, const bf16* BzT, const bf16* CzT, const float* tab, float* SE, int item, int tid, int wid, int lane) {
    const int c16 = lane & 15, q = lane >> 4;
    const int b = item >> 6, g = (item >> 1) & 31, seg = 8 * (item & 1) + wid;
    const int id = ((b * 32 + g) << 4) + seg;
    const size_t tok0 = (size_t)b * SEQ + seg * 256;
    LAS unsigned char* wscr = lds + S5_HS + wid * 4352;
    bf16x8 uf[8];
#pragma unroll
    for (int kk = 0; kk < 8; ++kk) uf[kk] = *(const bf16x8*)(P + (tok0 + 16 * c16 + 2 * kk + (q >> 1)) * LDP + C_CU + 16 * g + 8 * (q & 1));
    { const bf16* bz = BzT + (size_t)g * 32768; u32x4 t[8];
#pragma unroll
      for (int i = 0; i < 8; ++i) t[i] = *(const u32x4*)(bz + (size_t)(tid + 512 * i) * 8);
#pragma unroll
      for (int i = 0; i < 8; ++i) { const int pc = tid + 512 * i; *(LAS u32x4*)(lds + S5_WB + (pc >> 5) * (S5_LDW * 2) + (pc & 31) * 16) = t[i]; } }
    __syncthreads();
    f32x4 G[8];
#pragma unroll
    for (int nt = 0; nt < 8; ++nt) { f32x4 acc = (f32x4){0.f, 0.f, 0.f, 0.f};
#pragma unroll
        for (int kk = 0; kk < 8; ++kk) acc = MFMA16(uf[kk], *(const LAS bf16x8*)(lds + S5_WB + ((16 * nt + c16) * S5_LDW + 32 * kk + 8 * q) * 2), acc);
        G[nt] = acc; }
    const float* tg = tab + (size_t)g * 6 * 64;
    float a16r[4], a16i[4], a64r[4], a64i[4];
#pragma unroll
    for (int n4 = 0; n4 < 4; ++n4) { const int p = 16 * n4 + c16; a16r[n4] = tg[0 * 64 + p]; a16i[n4] = tg[1 * 64 + p]; a64r[n4] = tg[2 * 64 + p]; a64i[n4] = tg[3 * 64 + p]; }
    float er[4], ei[4], ir[4], ii[4], cr[4], ci[4];
#pragma unroll
    for (int n4 = 0; n4 < 4; ++n4) { float hr = 0.f, hi = 0.f;
#pragma unroll
        for (int r = 0; r < 4; ++r) cmul_acc(hr, hi, a16r[n4], a16i[n4], G[n4][r], G[n4 + 4][r]);
        er[n4] = hr; ei[n4] = hi; ir[n4] = hr; ii[n4] = hi; }
#pragma unroll
    for (int s = 1; s < 4; ++s)
#pragma unroll
        for (int n4 = 0; n4 < 4; ++n4) { const float vr = __shfl(ir[n4], (lane - 16) & 63), vi = __shfl(ii[n4], (lane - 16) & 63);
            if (q == s) { ir[n4] = a64r[n4] * vr - a64i[n4] * vi + er[n4]; ii[n4] = a64r[n4] * vi + a64i[n4] * vr + ei[n4]; } }
#pragma unroll
    for (int n4 = 0; n4 < 4; ++n4) { const float vr = __shfl(ir[n4], (lane - 16) & 63), vi = __shfl(ii[n4], (lane - 16) & 63); cr[n4] = (q > 0) ? vr : 0.f; ci[n4] = (q > 0) ? vi : 0.f; }
    if (!OUT) {
        if (q == 3) {
#pragma unroll
            for (int n4 = 0; n4 < 4; ++n4) { SE[(size_t)id * 128 + 16 * n4 + c16] = ir[n4]; SE[(size_t)id * 128 + 64 + 16 * n4 + c16] = ii[n4]; } }
        __syncthreads();
        return;
    }
    float hinr[4] = {0.f, 0.f, 0.f, 0.f}, hini[4] = {0.f, 0.f, 0.f, 0.f};
    { float a256r[4], a256i[4];
#pragma unroll
      for (int n4 = 0; n4 < 4; ++n4) { const int p = 16 * n4 + c16; a256r[n4] = tg[4 * 64 + p]; a256i[n4] = tg[5 * 64 + p]; }
#pragma unroll 1
      for (int s0 = 0; s0 < seg; s0 += 4) { float evr[4][4], evi[4][4];
#pragma unroll
          for (int u = 0; u < 4; ++u) { const int sp = (s0 + u < seg) ? s0 + u : seg - 1; const float* e = SE + (size_t)(id - seg + sp) * 128;
#pragma unroll
              for (int n4 = 0; n4 < 4; ++n4) { evr[u][n4] = e[16 * n4 + c16]; evi[u][n4] = e[64 + 16 * n4 + c16]; } }
#pragma unroll
          for (int u = 0; u < 4; ++u) if (s0 + u < seg) {
#pragma unroll
              for (int n4 = 0; n4 < 4; ++n4) cmul_acc(hinr[n4], hini[n4], a256r[n4], a256i[n4], evr[u][n4], evi[u][n4]); } } }
    LAS bf16* Hs = (LAS bf16*)wscr;
#pragma unroll
    for (int n4 = 0; n4 < 4; ++n4) {
        float pr = 1.f, pi = 0.f;
#pragma unroll
        for (int i = 0; i < 3; ++i) if (i < q) { const float nr = pr * a64r[n4] - pi * a64i[n4], ni = pr * a64i[n4] + pi * a64r[n4]; pr = nr; pi = ni; }
        float hr = pr * hinr[n4] - pi * hini[n4] + cr[n4], hi = pr * hini[n4] + pi * hinr[n4] + ci[n4];
#pragma unroll
        for (int r = 0; r < 4; ++r) { Hs[(4 * q + r) * 136 + 16 * n4 + c16] = f2bf(hr); Hs[(4 * q + r) * 136 + 64 + 16 * n4 + c16] = f2bf(hi);
            cmul_acc(hr, hi, a16r[n4], a16i[n4], G[n4][r], G[n4 + 4][r]); } }
    asm volatile("" ::: "memory");
    bf16x8 hf[4];
#pragma unroll
    for (int kk = 0; kk < 4; ++kk) hf[kk] = *(const LAS bf16x8*)(wscr + (c16 * 136 + 32 * kk + 8 * q) * 2);
    const bf16* tz = TzT + (size_t)g * 65536; const bf16* cz = CzT + (size_t)g * 32768;
    unsigned ypk[16][2];
#pragma unroll
    for (int hl = 0; hl < 2; ++hl) {
        __syncthreads();
        { u32x4 t[8], tc[4];
          if (hl == 0) {
#pragma unroll
              for (int i = 0; i < 4; ++i) { const int pc = tid + 512 * i; t[i] = *(const u32x4*)(tz + (size_t)(pc >> 4) * 256 + (pc & 15) * 8); }
          } else {
#pragma unroll
              for (int i = 0; i < 8; ++i) { const int pc = tid + 512 * i; t[i] = *(const u32x4*)(tz + (size_t)(128 + (pc >> 5)) * 256 + (pc & 31) * 8); } }
#pragma unroll
          for (int i = 0; i < 4; ++i) { const int pc = tid + 512 * i; tc[i] = *(const u32x4*)(cz + (size_t)(128 * hl + (pc >> 4)) * 128 + (pc & 15) * 8); }
          if (hl == 0) {
#pragma unroll
              for (int i = 0; i < 4; ++i) { const int pc = tid + 512 * i; *(LAS u32x4*)(lds + S5_WB + (pc >> 4) * (S5_LDW * 2) + (pc & 15) * 16) = t[i]; }
          } else {
#pragma unroll
              for (int i = 0; i < 8; ++i) { const int pc = tid + 512 * i; *(LAS u32x4*)(lds + S5_WB + (pc >> 5) * (S5_LDW * 2) + (pc & 31) * 16) = t[i]; } }
#pragma unroll
          for (int i = 0; i < 4; ++i) { const int pc = tid + 512 * i; *(LAS u32x4*)(lds + S5_CZ + (pc >> 4) * (S5_LDC * 2) + (pc & 15) * 16) = tc[i]; } }
        __syncthreads();
#pragma unroll
        for (int n8 = 0; n8 < 8; ++n8) { const int nt = 8 * hl + n8; f32x4 acc = (f32x4){0.f, 0.f, 0.f, 0.f};
#pragma unroll
            for (int kk = 0; kk < 8; ++kk) if (kk <= (nt >> 1)) acc = MFMA16(uf[kk], *(const LAS bf16x8*)(lds + S5_WB + ((16 * n8 + c16) * S5_LDW + 32 * kk + 8 * q) * 2), acc);
#pragma unroll
            for (int kk = 0; kk < 4; ++kk) acc = MFMA16(hf[kk], *(const LAS bf16x8*)(lds + S5_CZ + ((16 * n8 + c16) * S5_LDC + 32 * kk + 8 * q) * 2), acc);
            float yv[4];
#pragma unroll
            for (int r = 0; r < 4; ++r) { const float y = acc[r], u2 = 1.5957691216057308f * (y + 0.044715f * y * y * y); yv[r] = y * sigmoidf_(u2); }
            ypk[nt][0] = pk2(yv[0], yv[1]); ypk[nt][1] = pk2(yv[2], yv[3]); }
    }
    __syncthreads();
    LAS bf16* Ys = (LAS bf16*)(lds + S5_WB + wid * 8192);
#pragma unroll
    for (int nt = 0; nt < 16; ++nt)
#pragma unroll
        for (int r = 0; r < 4; ++r) Ys[(16 * (4 * q + r) + nt) * 16 + c16] = (bf16)((r & 1) ? (ypk[nt][r >> 1] >> 16) : (ypk[nt][r >> 1] & 0xffffu));
    asm volatile("" ::: "memory");
#pragma unroll
    for (int i = 0; i < 8; ++i) { const int pc = lane + 64 * i, tk = pc >> 1, hf2 = pc & 1;
        *(u32x4*)(P + (tok0 + tk) * LDP + C_CU + 16 * g + 8 * hf2) = *(const LAS u32x4*)(lds + S5_WB + wid * 8192 + pc * 16); }
    __syncthreads();
}

template <bool SECOND>
#ifndef PROBE_TYPE
#define PROBE_TYPE -1
#endif
#define PBX(t) do { if ((t) == PROBE_TYPE) px_t0 = __builtin_amdgcn_s_memrealtime(); } while (0)
#define PEX(t) do { if ((t) == PROBE_TYPE) pacc += __builtin_amdgcn_s_memrealtime() - px_t0; } while (0)
__device__ __forceinline__ void mixers_phase(LAS unsigned char* lds, const float* const* in, unsigned char* ws, bf16* P, int l, int vcu, int G, int tid, int wid, int lane, unsigned long long& pacc) {
    unsigned long long px_t0 = 0; (void)px_t0;
    PBX(10); if (!SECOND && (PH_MASK & 0x100)) for (int it = vcu; it < 256; it += G) attn_item(lds, P, in[7] + l * 16, it, tid, wid, lane);
    PEX(10);
    float* GE = (float*)(ws + WS_GLAE); float* GD = (float*)(ws + WS_GLAD); float* SE = (float*)(ws + WS_S5E);
    const float* balpha = in[9] + l * 256; const float* gnorm = in[10] + l * 512;
    int tid1 = tid; asm volatile("" : "+v"(tid1));
    PBX(SECOND ? 13 : 11); if (PH_MASK & 0x200) for (int it = vcu; it < 256; it += G) gla_item<SECOND>(lds, P, balpha, gnorm, GE, GD, it, tid1, wid, tid1 & 63);
    PEX(SECOND ? 13 : 11);
    const bf16* TzT = (const bf16*)(ws + WS_S5M + (size_t)l * S5M_BYTES + S5M_TZ); const bf16* BzT = (const bf16*)(ws + WS_S5M + (size_t)l * S5M_BYTES + S5M_BZ);
    const bf16* CzT = (const bf16*)(ws + WS_S5M + (size_t)l * S5M_BYTES + S5M_CZ); const float* tab = (const float*)(ws + WS_TAB) + (size_t)l * 32 * 6 * 64;
    int tid2 = tid; asm volatile("" : "+v"(tid2));
    PBX(SECOND ? 14 : 12); if (PH_MASK & 0x400) for (int it = vcu; it < 256; it += G) s5_wg_item<SECOND>(lds, P, TzT, BzT, CzT, tab, SE, it, tid2, wid, tid2 & 63);
    PEX(SECOND ? 14 : 12);
}
#ifndef MK_MULTI
#define MK_MULTI 0
#endif
constexpr int N_PHASES = 2 + 6 * NLAYER;
struct Args { const float* in[22]; float* out; unsigned char* ws; int ph_lo, ph_hi; };
__global__ void __launch_bounds__(NWAVES * 64, 2) hybrid_fwd(Args args_) {
    extern __shared__ __attribute__((aligned(16))) unsigned char lds_raw[];
    const int G = gridDim.x; const int bx = blockIdx.x; const int vcu = (G % 8 == 0) ? (bx % 8) * (G / 8) + bx / 8 : bx;
    XcdBarrier bar;
    { LAS unsigned char* lds0 = (LAS unsigned char*)lds_raw;
      volatile LAS unsigned* MISC = (volatile LAS unsigned*)(lds0 + MISC_OFF);
      for (int u = threadIdx.x; u < (LDS_BYTES - LDSCTL_OFF) / 4; u += NWAVES * 64) ((LAS unsigned*)(lds0 + LDSCTL_OFF))[u] = 0u;
      __syncthreads();
      bar.bar = (unsigned*)(args_.ws + WS_CTL) + CW_BAR; bar.x = 0; bar.st = nullptr;
      if (!MK_MULTI) bar = xcd_barrier_post((unsigned*)(args_.ws + WS_CTL) + CW_BAR, MISC + 8); }
    const int lo = args_.ph_lo, hi = args_.ph_hi;
#ifndef PROBE_TYPE
#define PROBE_TYPE -1
#endif
#ifndef PROBE_K
#define PROBE_K 4
#endif
#ifndef PROBE_BLOCK
#define PROBE_BLOCK 0
#endif
    unsigned long long pr_acc = 0, pr_t0 = 0; (void)pr_t0;
#define PB(t) do { if ((t) == PROBE_TYPE) pr_t0 = __builtin_amdgcn_s_memrealtime(); } while (0)
#define PE(t) do { if ((t) == PROBE_TYPE) pr_acc += __builtin_amdgcn_s_memrealtime() - pr_t0; } while (0)
#define IN(k) (lo <= (k) && (k) < hi)
#if MK_MULTI
#define SEAM(k) do { } while (0)
#else
#define SEAM(k) do { if (IN(k) && IN((k) + 1)) xcd_barrier(bar); } while (0)
#endif
#define PHASE_IDS typedef const Args __attribute__((address_space(4)))* kargp_t; kargp_t ap = (kargp_t)__builtin_amdgcn_kernarg_segment_ptr(); asm volatile("" : "+s"(ap)); const Args& args = *(const Args*)ap; \
        int tid = threadIdx.x; asm volatile("" : "+v"(tid)); const int lane = tid & 63, wid = __builtin_amdgcn_readfirstlane(tid >> 6); (void)lane; (void)wid; \
        LAS unsigned char* lds = (LAS unsigned char*)lds_raw; asm volatile("" : "+s"(lds)); unsigned char* ws = args.ws; \
        bf16* const P = (bf16*)(ws + WS_P); bf16* const H = (bf16*)(ws + WS_H); float* const MOD = (float*)(ws + WS_MOD); (void)P; (void)H; (void)MOD;
#ifndef PH_MASK
#define PH_MASK 0xffff
#endif
    PB(0); if (IN(0) && (PH_MASK & 1)) { PHASE_IDS p0_mod_phase(lds, args.in, ws, vcu, G, tid, wid, lane); }
    SEAM(0); PE(0);
    PB(1); if (IN(1) && (PH_MASK & 2)) { PHASE_IDS
        if (G == 256) { if (vcu < 64) { PB(20); p0_s5_item(lds, args.in, ws, vcu >> 5, vcu & 31, tid); PE(20); }
                        else { const int gw = (vcu - 64) * NWAVES + wid; PB(21); p1_transposes(lds, args.in, ws, gw, 192 * NWAVES, wid, lane, 0, (16 * 168 + 32 * 32 + 8 * 16)); __syncthreads(); PE(21); PB(25); prenorm_phase(args.in[0], MOD, H, gw, 192 * NWAVES, lane); __syncthreads(); PE(25); } }
        else { for (int it = vcu; it < 64; it += G) p0_s5_item(lds, args.in, ws, it >> 5, it & 31, tid);
               const int gw = vcu * NWAVES + wid; p1_transposes(lds, args.in, ws, gw, G * NWAVES, wid, lane, 0, NLAYER * (16 * 168 + 32 * 32 + 8 * 16)); prenorm_phase(args.in[0], MOD, H, gw, G * NWAVES, lane); } }
    SEAM(1); PE(1);
#define LAYER(l, base) \
    PB(2); if (IN(base + 0) && (PH_MASK & 4)) { PHASE_IDS \
        pg8::Gemm g{H, (const bf16*)(ws + WS_WIN + (size_t)l * WIN_BYTES), TOK, LDP, DM, DM}; pg8::StaticOrder S; S.init(TOK, LDP, G, bx); \
        pg8::EpiBf16<0> E{P, LDP, nullptr, 1024, 1024, 0.125f * LOG2E};        \
        pg8::gemm_phase<pg8::EpiBf16<0>, pg8::StaticOrder, true, true>(lds, g, S, E, tid); \
        if (l == 0 && G == 256 && bx >= 64) p1_transposes(lds, args.in, ws, (bx - 64) * NWAVES + wid, 192 * NWAVES, wid, lane, (16 * 168 + 32 * 32 + 8 * 16), NLAYER * (16 * 168 + 32 * 32 + 8 * 16)); } \
    SEAM(base + 0); PE(2); \
    PB(3); if (IN(base + 1) && (PH_MASK & 8)) { PHASE_IDS mixers_phase<false>(lds, args.in, ws, P, l, vcu, G, tid, wid, lane, pr_acc); } \
    SEAM(base + 1); PE(3); \
    PB(4); if (IN(base + 2) && (PH_MASK & 8)) { PHASE_IDS mixers_phase<true>(lds, args.in, ws, P, l, vcu, G, tid, wid, lane, pr_acc); } \
    SEAM(base + 2); PE(4); \
    PB(5); if (IN(base + 3) && (PH_MASK & 16)) { PHASE_IDS \
        pg8::Gemm g{P + C_CU, (const bf16*)(ws + WS_WGLU + (size_t)l * WGLU_BYTES), TOK, 512, 512, LDP}; pg8::StaticOrder S; S.init(TOK, 512, G, bx); \
        pg8::EpiGlu E{P, LDP, C_CU, C_CG, args.in[20] + l * 512}; \
        PB(15); if (PH_MASK & 0x800) pg8::gemm_phase<pg8::EpiGlu, pg8::StaticOrder, true, true>(lds, g, S, E, tid); PE(15); PB(16); \
        if (!(PH_MASK & 0x1000)) {} else if (G == 256) { if (bx >= 128) { attn_item(lds, P, args.in[7] + l * 16, 256 + 2 * (bx - 128), tid, wid, lane); attn_item(lds, P, args.in[7] + l * 16, 257 + 2 * (bx - 128), tid, wid, lane); } } \
        else for (int it = 256 + vcu; it < 512; it += G) attn_item(lds, P, args.in[7] + l * 16, it, tid, wid, lane); PE(16); } \
    SEAM(base + 3); PE(5); \
    PB(6); if (IN(base + 4) && (PH_MASK & 32)) { PHASE_IDS \
        pg8::Gemm g{P, (const bf16*)(ws + WS_WOUT + (size_t)l * WOUT_BYTES), TOK, DM, 2048, LDP}; pg8::StaticOrder S; S.init(TOK, DM, G, bx); \
        pg8::EpiBf16<0> E{H, DM, nullptr, 0, 0, 1.f}; \
        pg8::gemm_phase<pg8::EpiBf16<0>, pg8::StaticOrder, true, true>(lds, g, S, E, tid); } \
    SEAM(base + 4); PE(6); \
    PB(7); if (IN(base + 5) && (PH_MASK & 64)) { PHASE_IDS \
        post_phase(l == 0 ? args.in[0] : args.out, args.out, H, args.in[5] + l * DM, MOD + (size_t)l * 4 * 3072, (l + 1 < NLAYER), args.in[4] + (l + 1 < NLAYER ? l + 1 : l) * DM, MOD + (size_t)(l + 1 < NLAYER ? l + 1 : l) * 4 * 3072, H, vcu, wid, lane); } \
    SEAM(base + 5); PE(7);
    LAYER(0, 2)
    LAYER(1, 8)
#undef LAYER
    if (PROBE_TYPE >= 0 && blockIdx.x == PROBE_BLOCK) { const unsigned long long te = __builtin_amdgcn_s_memrealtime(); while (__builtin_amdgcn_s_memrealtime() - te < (unsigned long long)PROBE_K * pr_acc) __builtin_amdgcn_s_sleep(20); }
#undef IN
#undef SEAM
}

extern "C" void kernel_launch(void* const* d_in, const int* in_sizes, int n_in, void* d_out, int out_size, void* d_ws, size_t ws_size, hipStream_t stream) {
    static int grid = 0;
    if (grid == 0) {
        if (n_in != 22 || in_sizes[0] != TOK * DM || out_size != TOK * DM || ws_size < WS_END) { fprintf(stderr, "kernel_launch: unexpected shapes (n_in %d, in0 %d, out %d, ws %zu)\n", n_in, n_in > 0 ? in_sizes[0] : -1, out_size, ws_size); grid = -1; return; }
        int dev = 0, cus = 0;
        if (hipGetDevice(&dev) != hipSuccess || hipDeviceGetAttribute(&cus, hipDeviceAttributeMultiprocessorCount, dev) != hipSuccess) { grid = -1; return; }
        if (hipFuncSetAttribute((const void*)hybrid_fwd, hipFuncAttributeMaxDynamicSharedMemorySize, LDS_BYTES) != hipSuccess) { fprintf(stderr, "kernel_launch: hipFuncSetAttribute failed\n"); grid = -1; return; }
        (void)hipGetLastError();
        grid = cus;
    }
    if (grid < 0) return;
    if (hipMemsetAsync((char*)d_ws + WS_CTL, 0, CTL_ZERO_BYTES, stream) != hipSuccess) { fprintf(stderr, "kernel_launch: memset failed\n"); return; }
    Args a{};
    for (int i = 0; i < 22; ++i) a.in[i] = (const float*)d_in[i];
    a.out = (float*)d_out; a.ws = (unsigned char*)d_ws;
#if MK_MULTI
    for (int ph = 0; ph < N_PHASES; ++ph) { a.ph_lo = ph; a.ph_hi = ph + 1; hipLaunchKernelGGL(hybrid_fwd, dim3(grid), dim3(NWAVES * 64), LDS_BYTES, stream, a); }
#else
    a.ph_lo = 0; a.ph_hi = N_PHASES;
    hipLaunchKernelGGL(hybrid_fwd, dim3(grid), dim3(NWAVES * 64), LDS_BYTES, stream, a);
#endif
    const hipError_t le = hipPeekAtLastError();
    if (le != hipSuccess) fprintf(stderr, "kernel_launch: launch failed: %s\n", hipGetErrorName(le));
}
```

```cpp
#include <hip/hip_runtime.h>
#include <cstdio>
#include <cstdint>
#include <cmath>
#define MK_MULTI 0
namespace pg8 {
#define PG8_LAS __attribute__((address_space(3)))
typedef unsigned short bf16_t;
typedef short bf16x8 __attribute__((ext_vector_type(8)));
typedef float f32x4 __attribute__((ext_vector_type(4)));
typedef unsigned u32x4 __attribute__((ext_vector_type(4)));
constexpr int BM = 256, BK = 64, HALF = 128, HTB = HALF * BK * 2  , STAGE_BYTES = 8 * HTB, NXCD = 8, WGM = 8;

__host__ __device__ __forceinline__ int lds_byte(int r, int c) { const int st = (r >> 4) * 2 + (c >> 5), rr = r & 15, cc = c & 31, ob = rr * 64 + cc * 2; return st * 1024 + (ob ^ (((ob >> 9) & 1) << 5)); }
__host__ __device__ __forceinline__ void stage_rc(int b, int& R, int& C) { const int st = b / 1024, sb = b % 1024, swz = sb ^ (((sb >> 9) & 1) << 5); R = (st >> 1) * 16 + swz / 64; C = (st & 1) * 32 + (swz % 64) / 2; }
__host__ __device__ __forceinline__ int perm32(int rho) { const int n = rho >> 4, i = rho & 15; return 8 * (i >> 2) + 4 * n + (i & 3); }

struct Unit { int pm, pn; };
struct Gemm { const bf16_t* A; const bf16_t* Bt; int M, N, K, lda; };

struct StaticOrder {
    int nM, nN, nwg, G, c;
    __host__ __device__ void init(int M, int N, int G_, int c_) { nM = M / BM; nN = N / BM; nwg = nM * nN; G = G_; c = c_; }
    __host__ __device__ bool next(int i, Unit& u) const {
        const long L = (long)i * G + c; if (L >= nwg) return false;
        int wgid = (int)L; { const int q = nwg / NXCD, r = nwg % NXCD, xcd = wgid % NXCD, off = wgid / NXCD; wgid = (xcd < r ? xcd * (q + 1) : r * (q + 1) + (xcd - r) * q) + off; }
        const int nig = WGM * nN, gid = wgid / nig, fm = gid * WGM, gsz = (nM - fm) < WGM ? (nM - fm) : WGM;
        u.pm = fm + ((wgid % nig) % gsz); u.pn = (wgid % nig) / gsz; return true;
    }
    __device__ __forceinline__ void a_ready(const Unit&) const {}
    __device__ __forceinline__ void done(const Unit&) const {}
};

__device__ __forceinline__ unsigned cvt_pk_bf16(float lo, float hi) { unsigned r; asm volatile("v_cvt_pk_bf16_f32 %0, %1, %2" : "=v"(r) : "v"(lo), "v"(hi)); return r; }
typedef float f32x2 __attribute__((ext_vector_type(2)));
__device__ __forceinline__ f32x2 gelu_pk(f32x2 v) {
    const f32x2 av = __builtin_elementwise_abs(v), d = av * 0.2316418882f + 1.0f;
    f32x2 t; t.x = __builtin_amdgcn_rcpf(d.x); t.y = __builtin_amdgcn_rcpf(d.y);
    f32x2 q = t * 0.5307027145f + (-0.7265760135f); q = q * t + 0.7107068705f; q = q * t + (-0.142248368f); q = q * t + 0.127414796f; q = q * t;
    const f32x2 s = (v * v) * (-0.72134752044f);
    f32x2 e; e.x = __builtin_amdgcn_exp2f(s.x); e.y = __builtin_amdgcn_exp2f(s.y);
    const f32x2 m = v * (q * e), r = v - m;
    f32x2 o; o.x = v.x < 0.f ? m.x : r.x; o.y = v.y < 0.f ? m.y : r.y; return o;
}

template <int ACT  > struct EpiBf16 {
    static constexpr bool PERM = true, AFTER_DRAIN = false; static_assert(ACT == 0 || ACT == 1, "EpiBf16: ACT is 0 (none) or 1 (gelu_pk)");
    bf16_t* O; int ldc; const float* bias; int split_cols; size_t split_stride; float scale0;
    __device__ __forceinline__ void operator()(const f32x4 (&acc)[2][2][4][2], const Unit& u, int wr, int wc, int fr, int fq) const {
        const int row0 = u.pm * BM + wr * 64 + fr; int colt = u.pn * BM; bf16_t* base = O;
        float sc = 1.f; if (split_cols) { const int t = colt / split_cols; base += (size_t)t * split_stride; colt -= t * split_cols; if (t == 0) sc = scale0; }
        const int col0 = colt + wc * 32 + 8 * fq, bcol0 = u.pn * BM + wc * 32 + 8 * fq;
        f32x4 bv[2][2];
#pragma unroll
        for (int bj = 0; bj < 2; ++bj)
#pragma unroll
            for (int n = 0; n < 2; ++n) bv[bj][n] = bias ? *(const f32x4*)(bias + bcol0 + bj * HALF + 4 * n) : (f32x4){0.f, 0.f, 0.f, 0.f};
#pragma unroll
        for (int ai = 0; ai < 2; ++ai)
#pragma unroll
            for (int m = 0; m < 4; ++m) { bf16_t* rowp = base + (size_t)(row0 + ai * HALF + m * 16) * ldc + col0;
#pragma unroll
                for (int bj = 0; bj < 2; ++bj) { f32x4 v0 = acc[ai][bj][m][0] + bv[bj][0], v1 = acc[ai][bj][m][1] + bv[bj][1];
                    if (ACT == 1) { f32x2 a = gelu_pk((f32x2){v0[0], v0[1]}), b = gelu_pk((f32x2){v0[2], v0[3]}), c = gelu_pk((f32x2){v1[0], v1[1]}), d = gelu_pk((f32x2){v1[2], v1[3]});
                        v0 = (f32x4){a.x, a.y, b.x, b.y}; v1 = (f32x4){c.x, c.y, d.x, d.y}; }
                    v0 = v0 * sc; v1 = v1 * sc; u32x4 w; w.x = cvt_pk_bf16(v0[0], v0[1]); w.y = cvt_pk_bf16(v0[2], v0[3]); w.z = cvt_pk_bf16(v1[0], v1[1]); w.w = cvt_pk_bf16(v1[2], v1[3]);
                    *(u32x4*)(rowp + bj * HALF) = w; } }
    }
};
struct EpiGlu {
    static constexpr bool PERM = true, AFTER_DRAIN = false;
    bf16_t* P; int ldp, col_y, col_g; const float* bglu;
    __device__ __forceinline__ void operator()(const f32x4 (&acc)[2][2][4][2], const Unit& u, int wr, int wc, int fr, int fq) const {
        const int row0 = u.pm * BM + wr * 64 + fr; const int col0 = u.pn * BM + wc * 32 + 8 * fq;
#pragma unroll
        for (int ai = 0; ai < 2; ++ai)
#pragma unroll
            for (int m = 0; m < 4; ++m) { bf16_t* rowp = P + (size_t)(row0 + ai * HALF + m * 16) * ldp;
#pragma unroll
                for (int bj = 0; bj < 2; ++bj) { const int col = col0 + bj * HALF;
                    const f32x4 b0 = *(const f32x4*)(bglu + col), b1 = *(const f32x4*)(bglu + col + 4);
                    const u32x4 yv = *(const u32x4*)(rowp + col_y + col), gv = *(const u32x4*)(rowp + col_g + col);
                    const f32x4 z0 = acc[ai][bj][m][0] + b0, z1 = acc[ai][bj][m][1] + b1;
                    float z[8] = {z0[0], z0[1], z0[2], z0[3], z1[0], z1[1], z1[2], z1[3]}; float o[8];
#pragma unroll
                    for (int e = 0; e < 8; ++e) { const unsigned yw = yv[e >> 1], gw = gv[e >> 1];
                        const float y = __uint_as_float((e & 1) ? (yw & 0xffff0000u) : (yw << 16)), g = __uint_as_float((e & 1) ? (gw & 0xffff0000u) : (gw << 16));
                        const float sz = __builtin_amdgcn_rcpf(1.0f + __expf(-z[e])), sg = __builtin_amdgcn_rcpf(1.0f + __expf(-g));
                        o[e] = y * sz * g * sg; }
                    u32x4 w; w.x = cvt_pk_bf16(o[0], o[1]); w.y = cvt_pk_bf16(o[2], o[3]); w.z = cvt_pk_bf16(o[4], o[5]); w.w = cvt_pk_bf16(o[6], o[7]);
                    *(u32x4*)(rowp + col_g + col) = w; } }
    }
};
template <class Epi, class Sched, bool ALIGN_EPI = false, bool SP2 = false>
__device__ __forceinline__ void gemm_phase(PG8_LAS unsigned char* lds, const Gemm g, const Sched& S, const Epi& E, int tid_in) {
    const int tid = tid_in, wid = __builtin_amdgcn_readfirstlane(tid >> 6), lane = tid & 63, wr = wid >> 2, wc = wid & 3, fr = lane & 15, fq = lane >> 4;
    const int K = g.K, nt = K / BK;
    unsigned voffA[2], voffB[2];
#pragma unroll
    for (int i = 0; i < 2; ++i) { int R, C; stage_rc(tid * 16 + i * 8192, R, C); const int Rb = Epi::PERM ? ((R & ~31) + perm32(R & 31)) : R;
        voffA[i] = (unsigned)(R * g.lda + C) * 2u; voffB[i] = (unsigned)(Rb * K + C) * 2u; }
    const size_t kstep = (size_t)(BK * 2);
    const size_t hstepB = (size_t)HALF * K * 2, hstepA = (size_t)HALF * g.lda * 2;
    const size_t tstepB = 2 * hstepB, tstepA = 2 * hstepA;
    const unsigned ldsw = (unsigned)wid * 1024u;
    const int aoff = lds_byte(wr * 64 + fr, fq * 8), boff = lds_byte(wc * 32 + fr, fq * 8);
#define PG8_SA(b, h) (((b) * 2 + (h)) * HTB)
#define PG8_SB(b, h) ((4 + (b) * 2 + (h)) * HTB)
#define PG8_STAGE(bufoff, gbase, voff) do { _Pragma("unroll") for (int _i = 0; _i < 2; ++_i) \
        __builtin_amdgcn_global_load_lds((const unsigned*)((const char*)(gbase) + (voff)[_i]), (PG8_LAS unsigned*)(lds + (bufoff) + ldsw + _i * 8192), 16, 0, 0); } while (0)
#define PG8_LDA(dst, b, h) do { _Pragma("unroll") for (int m = 0; m < 4; ++m) _Pragma("unroll") for (int k = 0; k < 2; ++k) dst[m][k] = *(const PG8_LAS bf16x8*)(lds + PG8_SA(b, h) + aoff + m * 2048 + k * 1024); } while (0)
#define PG8_LDB(dst, b, h) do { _Pragma("unroll") for (int n = 0; n < 2; ++n) _Pragma("unroll") for (int k = 0; k < 2; ++k) dst[n][k] = *(const PG8_LAS bf16x8*)(lds + PG8_SB(b, h) + boff + n * 2048 + k * 1024); } while (0)
#define PG8_MMA(ai, bj, At, Bt) do { __builtin_amdgcn_s_setprio(1); _Pragma("unroll") for (int m = 0; m < 4; ++m) _Pragma("unroll") for (int n = 0; n < 2; ++n) _Pragma("unroll") for (int k = 0; k < 2; ++k) \
        acc[ai][bj][m][n] = __builtin_amdgcn_mfma_f32_16x16x32_bf16(Bt[n][k], At[m][k], acc[ai][bj][m][n], 0, 0, 0); __builtin_amdgcn_s_setprio(0); } while (0)
#define PG8_WAIT_V(n) asm volatile("s_waitcnt vmcnt(" #n ")" ::: "memory")
#define PG8_WAIT_L(n) asm volatile("s_waitcnt lgkmcnt(" #n ")" ::: "memory")
#define PG8_BAR __builtin_amdgcn_s_barrier()
#define PG8_SCHED __builtin_amdgcn_sched_barrier(0)
    Unit cur, nxt; int ui = 0;
    if (!S.next(0, cur)) return;
    f32x4 acc[2][2][4][2];
#pragma unroll
    for (int a = 0; a < 2; ++a)
#pragma unroll
        for (int b = 0; b < 2; ++b)
#pragma unroll
            for (int m = 0; m < 4; ++m)
#pragma unroll
                for (int n = 0; n < 2; ++n) acc[a][b][m][n] = (f32x4){0.f, 0.f, 0.f, 0.f};
    bf16x8 At[4][2], B0[2][2], B1[2][2];
    const char* cA = (const char*)g.A + (size_t)cur.pm * tstepA; const char* cB = (const char*)g.Bt + (size_t)cur.pn * tstepB;
    S.a_ready(cur);
    if constexpr (SP2) {
        PG8_STAGE(PG8_SB(0, 0), cB, voffB); PG8_STAGE(PG8_SB(0, 1), cB + hstepB, voffB); PG8_STAGE(PG8_SA(0, 0), cA, voffA); PG8_STAGE(PG8_SA(0, 1), cA + hstepA, voffA);
        if (wr == 1) PG8_BAR;
        PG8_WAIT_V(2); PG8_BAR;
        PG8_STAGE(PG8_SB(1, 0), cB + kstep, voffB); PG8_STAGE(PG8_SA(1, 0), cA + kstep, voffA); PG8_STAGE(PG8_SB(1, 1), cB + hstepB + kstep, voffB);
        PG8_WAIT_V(6); PG8_BAR;
    } else {
        PG8_STAGE(PG8_SB(0, 0), cB, voffB); PG8_STAGE(PG8_SA(0, 0), cA, voffA); PG8_STAGE(PG8_SB(0, 1), cB + hstepB, voffB); PG8_STAGE(PG8_SA(0, 1), cA + hstepA, voffA);
        if (wr == 1) PG8_BAR;
        PG8_WAIT_V(4); PG8_BAR;
        PG8_STAGE(PG8_SB(1, 0), cB + kstep, voffB); PG8_STAGE(PG8_SA(1, 0), cA + kstep, voffA); PG8_STAGE(PG8_SB(1, 1), cB + hstepB + kstep, voffB);
        PG8_WAIT_V(6); PG8_BAR;
    }
    for (;;) {
        const bool has_next = S.next(ui + 1, nxt);
        const char* nA = has_next ? (const char*)g.A + (size_t)nxt.pm * tstepA : cA; const char* nB = has_next ? (const char*)g.Bt + (size_t)nxt.pn * tstepB : cB;
        for (int t = 0; t < nt; t += 2) {
            const bool last = (t == nt - 2);
            const char* a1 = cA + (size_t)(t + 1) * kstep;
            const char* a2 = last ? nA : cA + (size_t)(t + 2) * kstep; const char* b2 = last ? nB : cB + (size_t)(t + 2) * kstep;
            const char* a3 = a2 + kstep; const char* b3 = b2 + kstep;
            if (last && has_next) S.a_ready(nxt);
            if constexpr (SP2) {
            PG8_LDB(B0, 0, 0); PG8_LDB(B1, 0, 1); PG8_SCHED; PG8_LDA(At, 0, 0); PG8_STAGE(PG8_SA(1, 1), a1 + hstepA, voffA);
            PG8_WAIT_V(8); PG8_WAIT_L(0); PG8_BAR; PG8_MMA(0, 0, At, B0); PG8_MMA(0, 1, At, B1); PG8_BAR; PG8_SCHED;
            PG8_LDA(At, 0, 1); PG8_STAGE(PG8_SB(0, 0), b2, voffB); PG8_STAGE(PG8_SB(0, 1), b2 + hstepB, voffB); PG8_STAGE(PG8_SA(0, 0), a2, voffA);
            PG8_WAIT_V(8); PG8_WAIT_L(0); PG8_BAR; PG8_MMA(1, 0, At, B0); PG8_MMA(1, 1, At, B1); PG8_BAR; PG8_SCHED;
            PG8_LDB(B0, 1, 0); PG8_LDB(B1, 1, 1); PG8_SCHED; PG8_LDA(At, 1, 0); PG8_STAGE(PG8_SA(0, 1), a2 + hstepA, voffA);
            PG8_WAIT_V(8); PG8_WAIT_L(0); PG8_BAR; PG8_MMA(0, 0, At, B0); PG8_MMA(0, 1, At, B1); PG8_BAR; PG8_SCHED;
            PG8_LDA(At, 1, 1); PG8_STAGE(PG8_SB(1, 0), b3, voffB); PG8_STAGE(PG8_SB(1, 1), b3 + hstepB, voffB); PG8_STAGE(PG8_SA(1, 0), a3, voffA);
            PG8_WAIT_V(8); PG8_WAIT_L(0); PG8_BAR; PG8_MMA(1, 0, At, B0); PG8_MMA(1, 1, At, B1); PG8_BAR; PG8_SCHED;
            } else {
            PG8_LDB(B0, 0, 0); PG8_SCHED; PG8_LDA(At, 0, 0); PG8_STAGE(PG8_SA(1, 1), a1 + hstepA, voffA);
            PG8_WAIT_L(8); PG8_BAR; PG8_WAIT_L(0); PG8_MMA(0, 0, At, B0); PG8_BAR; PG8_SCHED;
            PG8_LDB(B1, 0, 1); PG8_STAGE(PG8_SB(0, 0), b2, voffB);
            PG8_BAR; PG8_WAIT_L(0); PG8_MMA(0, 1, At, B1); PG8_BAR;
            PG8_LDA(At, 0, 1); PG8_STAGE(PG8_SA(0, 0), a2, voffA);
            PG8_BAR; PG8_WAIT_L(0); PG8_MMA(1, 0, At, B0); PG8_BAR; PG8_SCHED;
            PG8_STAGE(PG8_SB(0, 1), b2 + hstepB, voffB);
            PG8_WAIT_V(6); PG8_BAR; PG8_MMA(1, 1, At, B1); PG8_BAR;
            PG8_LDB(B0, 1, 0); PG8_SCHED; PG8_LDA(At, 1, 0); PG8_STAGE(PG8_SA(0, 1), a2 + hstepA, voffA);
            PG8_WAIT_L(8); PG8_BAR; PG8_WAIT_L(0); PG8_MMA(0, 0, At, B0); PG8_BAR; PG8_SCHED;
            PG8_LDB(B1, 1, 1); PG8_STAGE(PG8_SB(1, 0), b3, voffB);
            PG8_BAR; PG8_WAIT_L(0); PG8_MMA(0, 1, At, B1); PG8_BAR;
            PG8_LDA(At, 1, 1); PG8_STAGE(PG8_SA(1, 0), a3, voffA);
            PG8_BAR; PG8_WAIT_L(0); PG8_MMA(1, 0, At, B0); PG8_BAR; PG8_SCHED;
            PG8_STAGE(PG8_SB(1, 1), b3 + hstepB, voffB);
            PG8_WAIT_V(6); PG8_BAR; PG8_MMA(1, 1, At, B1); PG8_BAR;
            }
        }
        if constexpr (ALIGN_EPI) { if (wr == 0) PG8_BAR; }
        if constexpr (!Epi::AFTER_DRAIN) { E(acc, cur, wr, wc, fr, fq); S.done(cur); }
        if (!has_next) break;
#pragma unroll
        for (int a = 0; a < 2; ++a)
#pragma unroll
            for (int b = 0; b < 2; ++b)
#pragma unroll
                for (int m = 0; m < 4; ++m)
#pragma unroll
                    for (int n = 0; n < 2; ++n) acc[a][b][m][n] = (f32x4){0.f, 0.f, 0.f, 0.f};
        cur = nxt; cA = nA; cB = nB; ++ui;
        if constexpr (ALIGN_EPI) { if (wr == 1) PG8_BAR; }
    }
    PG8_WAIT_V(0);
    if constexpr (!ALIGN_EPI) { if (wr == 0) PG8_BAR; }
    PG8_BAR;
    if constexpr (Epi::AFTER_DRAIN) { E.fused(acc, cur, wr, wc, fr, fq, lds, wid, lane); S.done(cur); }
#undef PG8_SA
#undef PG8_SB
#undef PG8_STAGE
#undef PG8_LDA
#undef PG8_LDB
#undef PG8_MMA
#undef PG8_WAIT_V
#undef PG8_WAIT_L
#undef PG8_BAR
#undef PG8_SCHED
}
}
#define GAS __attribute__((address_space(1)))
#define LAS __attribute__((address_space(3)))
typedef unsigned short bf16;
typedef short bf16x8 __attribute__((ext_vector_type(8)));
typedef float f32x4 __attribute__((ext_vector_type(4)));
typedef float f32x16 __attribute__((ext_vector_type(16)));
typedef unsigned u32x4 __attribute__((ext_vector_type(4)));
typedef unsigned u32x2 __attribute__((ext_vector_type(2)));
typedef short s16x4 __attribute__((ext_vector_type(4)));
typedef GAS unsigned gu32;
constexpr int NWAVES = 8;
constexpr int NBATCH = 4, SEQ = 4096, DM = 1024, TOK = NBATCH * SEQ, NLAYER = 2;
constexpr int LDP = 5376, WIN_COLS = 5136;
constexpr int C_AQ = 0, C_BV = 1024, C_CG = 1536, C_AK = 2048, C_AV = 2304, C_AG = 2560, C_BQ = 3584, C_BK = 3840, C_GL = 4096, C_BG = 4352, C_CU = 4864;
constexpr float EPS = 1e-6f, LOG2E = 1.4426950408889634f;
constexpr size_t MiB = 1u << 20;
constexpr size_t WS_CTL = 0, CTL_ZERO_BYTES = 64 * 1024;
constexpr int CW_BAR = 1024;
constexpr size_t WS_MOD = 1 * MiB;
constexpr size_t WS_TAB = 1 * MiB + 256 * 1024;
constexpr size_t WS_WIN = 2 * MiB, WIN_BYTES = (size_t)LDP * DM * 2;
constexpr size_t WS_WOUT = 23 * MiB, WOUT_BYTES = (size_t)DM * 2048 * 2;
constexpr size_t WS_WGLU = 31 * MiB, WGLU_BYTES = (size_t)512 * 512 * 2;
constexpr size_t WS_S5M = 32 * MiB, S5M_BYTES = 8 * MiB;
constexpr size_t S5M_TZ = 0, S5M_BZ = 4 * MiB, S5M_CZ = 6 * MiB;
constexpr size_t WS_H = 48 * MiB;
constexpr size_t WS_GLAE = 48 * MiB;
constexpr size_t WS_GLAD = 56 * MiB;
constexpr size_t WS_S5E = 57 * MiB;
constexpr size_t WS_P = 80 * MiB;
constexpr size_t WS_END = 248 * MiB;
static_assert(WS_WIN + 2 * WIN_BYTES <= WS_WOUT && WS_WOUT + 2 * WOUT_BYTES <= WS_WGLU && WS_WGLU + 2 * WGLU_BYTES <= WS_S5M && WS_S5M + 2 * S5M_BYTES <= WS_H, "ws map");
static_assert(WS_H + (size_t)TOK * DM * 2 <= WS_P && WS_P + (size_t)TOK * LDP * 2 <= WS_END && WS_S5E + 2048 * 128 * 4 <= WS_P, "ws map 2");
constexpr int RING_BYTES = 143360, LDSCTL_OFF = RING_BYTES, MISC_OFF = LDSCTL_OFF + 320, LDS_BYTES = 147456;

#define RLX_AGENT __ATOMIC_RELAXED, __HIP_MEMORY_SCOPE_AGENT
#define LDS_WAIT() asm volatile("s_waitcnt lgkmcnt(0)" ::: "memory")
typedef float f32x2_t __attribute__((ext_vector_type(2))); typedef __bf16 bf16x2_t __attribute__((ext_vector_type(2)));
__device__ __forceinline__ unsigned pk2(float lo, float hi) { f32x2_t v = {lo, hi}; bf16x2_t b = __builtin_convertvector(v, bf16x2_t); return __builtin_bit_cast(unsigned, b); }
__device__ __forceinline__ bf16 f2bf(float f) { return (bf16)(pk2(f, 0.f) & 0xffffu); }
__device__ __forceinline__ float bf2f(bf16 b) { return __uint_as_float((unsigned)b << 16); }
__device__ __forceinline__ float bflo(unsigned w) { return __uint_as_float(w << 16); }
__device__ __forceinline__ float bfhi(unsigned w) { return __uint_as_float(w & 0xffff0000u); }
__device__ __forceinline__ float sigmoidf_(float x) { return __builtin_amdgcn_rcpf(1.0f + __expf(-x)); }
__device__ __forceinline__ float wave_sum(float v) {
#pragma unroll
    for (int o = 1; o < 64; o <<= 1) v += __shfl_xor(v, o);
    return v;
}
#define MFMA16(a, b, c) __builtin_amdgcn_mfma_f32_16x16x32_bf16((a), (b), (c), 0, 0, 0)
#define MFMA32(a, b, c) __builtin_amdgcn_mfma_f32_32x32x16_bf16((a), (b), (c), 0, 0, 0)
#define XB_TMO      128
#define XB_XCNT(j)  (256  + 64 * (j))
#define XB_XSUB(j)  (1280 + 64 * (j))
#define XB_XGEN(j)  (2304 + 64 * (j))
#define XB_TOP      3328
#define XB_TOPGEN   3392
#define XCD_BAR_WORDS 3456
#define XB_SPIN_CAP (1u << 18)

__device__ __forceinline__ unsigned xb_ld(unsigned* p)              { return __hip_atomic_load(p, __ATOMIC_RELAXED, __HIP_MEMORY_SCOPE_AGENT); }
__device__ __forceinline__ unsigned xb_add(unsigned* p, unsigned v) { return __hip_atomic_fetch_add(p, v, __ATOMIC_RELAXED, __HIP_MEMORY_SCOPE_AGENT); }
__device__ __forceinline__ unsigned xb_xcc_id() { return (unsigned)__builtin_amdgcn_s_getreg((3 << 11) | 20) & 0xFu; }
#define XB_SPIN(cond, bar) do { unsigned _sp = 0; while (cond) { __builtin_amdgcn_s_sleep(1); \
    if ((++_sp & 255u) == 0u) { if (xb_ld(&(bar)[XB_TMO])) break; if (_sp > XB_SPIN_CAP) { atomicAdd(&(bar)[XB_TMO], 1u); break; } } } } while (0)

struct XcdBarrier {
    unsigned* bar; unsigned x;
    volatile LAS unsigned* st;
};

__device__ __forceinline__ XcdBarrier xcd_barrier_post(unsigned* bar, volatile LAS unsigned* st) {
    XcdBarrier b; b.bar = bar; b.x = xb_xcc_id(); b.st = st;
    if (threadIdx.x == 0) (void)xb_add(&bar[XB_XCNT(b.x)], 1u);
    return b;
}
__device__ __forceinline__ void xcd_barrier_complete(unsigned* bar, unsigned x, unsigned& nloc, unsigned& nx) {
    const unsigned G = gridDim.x * gridDim.y * gridDim.z;
    unsigned sum, cnt, mine, sp = 0u;
    for (;;) {
        sum = 0u; cnt = 0u; mine = 0u;
#pragma unroll
        for (unsigned j = 0; j < 16; ++j) { const unsigned c = xb_ld(&bar[XB_XCNT(j)]); sum += c; cnt += (c > 0u) ? 1u : 0u; mine = (j == x) ? c : mine; }
        if (sum == G) break;
        __builtin_amdgcn_s_sleep(1);
        if ((++sp & 255u) == 0u) { if (xb_ld(&bar[XB_TMO])) break; if (sp > XB_SPIN_CAP) { atomicAdd(&bar[XB_TMO], 1u); break; } }
    }
    nloc = mine > 0u ? mine : 1u; nx = cnt > 0u ? cnt : 1u;
}

__device__ __forceinline__ void xcd_barrier(const XcdBarrier& b) {
    asm volatile("s_waitcnt vmcnt(0)" ::: "memory");
    __syncthreads();
    if (threadIdx.x == 0) {
        unsigned* bar = b.bar;
        __builtin_amdgcn_s_waitcnt(0);
        unsigned nloc = b.st[0], nx = b.st[1];
        if (nloc == 0u) { xcd_barrier_complete(bar, b.x, nloc, nx); b.st[0] = nloc; b.st[1] = nx; }
        const unsigned old = xb_add(&bar[XB_XSUB(b.x)], 1u);
        const unsigned gen = old / nloc;
        if (old + 1u == (gen + 1u) * nloc) {
            __builtin_amdgcn_fence(__ATOMIC_RELEASE, "agent");
            asm volatile("s_waitcnt vmcnt(0)" ::: "memory");
            const unsigned og = xb_add(&bar[XB_TOP], 1u);
            const unsigned tg = og / nx;
            if (og + 1u == (tg + 1u) * nx) xb_add(&bar[XB_TOPGEN], 1u);
            else XB_SPIN(xb_ld(&bar[XB_TOPGEN]) == tg, bar);
            __builtin_amdgcn_fence(__ATOMIC_ACQUIRE, "agent");
            xb_add(&bar[XB_XGEN(b.x)], 1u);
            asm volatile("s_waitcnt vmcnt(0)" ::: "memory");
        } else {
            XB_SPIN(xb_ld(&bar[XB_XGEN(b.x)]) == gen, bar);
            __builtin_amdgcn_fence(__ATOMIC_ACQUIRE, "agent");
            asm volatile("s_waitcnt vmcnt(0)" ::: "memory");
        }
    }
    __syncthreads();
}
__device__ __forceinline__ int win_srccol(int n0) {
    if (n0 < 1024) return n0;
    if (n0 < 1536) return 3072 + (n0 - 1024);
    if (n0 < 2048) return 4624 + (n0 - 1536);
    if (n0 < 2304) return 1024 + (n0 - 2048);
    if (n0 < 2560) return 1280 + (n0 - 2304);
    if (n0 < 3584) return 1536 + (n0 - 2560);
    if (n0 < 3840) return 2560 + (n0 - 3584);
    if (n0 < 4096) return 2816 + (n0 - 3840);
    if (n0 < 4352) return -1;
    if (n0 < 4864) return 3600 + (n0 - 4352);
    return 4112 + (n0 - 4864);
}
__device__ __forceinline__ void p0_mod_item(LAS unsigned char* lds, const float* c, const float* wmod, const float* bmod, const float* gpre, float* mod, int it, int tid, int wid, int lane) {
    LAS float* sc = (LAS float*)lds; LAS float* part = (LAS float*)(lds + 16384);
    const int l = it / 96, nb = it % 96, col = nb * 32 + (lane & 31), ks = wid * 2 + (lane >> 5);
    const float* wp = wmod + (size_t)l * 1024 * 3072 + col + (size_t)ks * 64 * 3072;
    float w[64];
#pragma unroll
    for (int i = 0; i < 64; ++i) w[i] = __builtin_nontemporal_load(wp + (size_t)i * 3072);
    for (int i = tid; i < 4096; i += 512) { const float cv = c[i]; sc[i] = cv * sigmoidf_(cv); }
    __syncthreads();
    float a0 = 0.f, a1 = 0.f, a2 = 0.f, a3 = 0.f;
#pragma unroll
    for (int i = 0; i < 64; ++i) { const int k = ks * 64 + i; a0 += sc[k] * w[i]; a1 += sc[1024 + k] * w[i]; a2 += sc[2048 + k] * w[i]; a3 += sc[3072 + k] * w[i]; }
    part[(ks * 4 + 0) * 32 + (lane & 31)] = a0; part[(ks * 4 + 1) * 32 + (lane & 31)] = a1; part[(ks * 4 + 2) * 32 + (lane & 31)] = a2; part[(ks * 4 + 3) * 32 + (lane & 31)] = a3;
    __syncthreads();
    if (tid < 128) { const int b = tid >> 5, n = nb * 32 + (tid & 31); float s = 0.f;
#pragma unroll
        for (int k = 0; k < 16; ++k) s += part[(k * 4 + b) * 32 + (tid & 31)];
        s += bmod[l * 3072 + n];
        if (n >= 1024 && n < 2048) s = gpre[l * 1024 + n - 1024] * (1.0f + s);
        mod[(size_t)(l * 4 + b) * 3072 + n] = s; }
    __syncthreads();
}

__device__ __forceinline__ void p0_s5_item(LAS unsigned char* lds, const float* const* in, unsigned char* ws, int l, int g, int tid) {
    LAS float* PWr = (LAS float*)lds; LAS float* PWi = PWr + 17 * 64; LAS float* BTr = PWi + 17 * 64; LAS float* BTi = BTr + 1024;
    LAS float* CRr = BTi + 1024; LAS float* CRi = CRr + 1024; LAS float* KC = CRi + 1024;
    const float* are = in[11] + (size_t)(l * 32 + g) * 64; const float* aim = in[12] + (size_t)(l * 32 + g) * 64;
    const double dt = exp((double)in[13][l * 32 + g]);
    const float* bre = in[14] + (size_t)(l * 32 + g) * 1024; const float* bim = in[15] + (size_t)(l * 32 + g) * 1024;
    const float* cre = in[16] + (size_t)(l * 32 + g) * 1024; const float* cim = in[17] + (size_t)(l * 32 + g) * 1024;
    const float* dd = in[18] + (size_t)l * 512 + g * 16;
    float* tab = (float*)(ws + WS_TAB) + (size_t)(l * 32 + g) * 6 * 64;
    if (tid < 64) { const int p = tid; const double ar = are[p], ai = aim[p];
        const double mag = exp(ar * dt), abr = mag * cos(ai * dt), abi = mag * sin(ai * dt), den = ar * ar + ai * ai, nr = abr - 1.0;
        const double fr = (nr * ar + abi * ai) / den, fi = (abi * ar - nr * ai) / den;
#pragma unroll 4
        for (int h = 0; h < 16; ++h) { const double br = bre[p * 16 + h], bi = bim[p * 16 + h]; BTr[p * 16 + h] = (float)(fr * br - fi * bi); BTi[p * 16 + h] = (float)(fr * bi + fi * br); }
        double pr = 1.0, pi = 0.0;
#pragma unroll 1
        for (int tau = 0; tau <= 16; ++tau) { PWr[tau * 64 + p] = (float)pr; PWi[tau * 64 + p] = (float)pi; const double t = pr * abr - pi * abi; pi = pr * abi + pi * abr; pr = t; }
        double qr = (double)0, qi = (double)0; { qr = 1.0; qi = 0.0; double xr = abr, xi = abi;
#pragma unroll 1
          for (int s2 = 0; s2 < 8; ++s2) { const double t = xr * xr - xi * xi; xi = 2.0 * xr * xi; xr = t;
              if (s2 == 3) { tab[0 * 64 + p] = (float)xr; tab[1 * 64 + p] = (float)xi; }
              if (s2 == 5) { tab[2 * 64 + p] = (float)xr; tab[3 * 64 + p] = (float)xi; }
              if (s2 == 7) { tab[4 * 64 + p] = (float)xr; tab[5 * 64 + p] = (float)xi; } } }
        (void)qr; (void)qi; }
    for (int idx = tid; idx < 1024; idx += 512) { CRr[idx] = cre[idx]; CRi[idx] = cim[idx]; }
    __syncthreads();
    { const int hp = tid & 15, tau = (tid >> 4) & 15, hh = __builtin_amdgcn_readfirstlane(tid >> 8); float acc[8];
#pragma unroll
      for (int j = 0; j < 8; ++j) acc[j] = 0.f;
#pragma unroll 4
      for (int p = 0; p < 64; ++p) { const float pr = PWr[tau * 64 + p], pi = PWi[tau * 64 + p], br = BTr[p * 16 + hp], bi = BTi[p * 16 + hp];
          const float xr = pr * br - pi * bi, xi = pr * bi + pi * br;
#pragma unroll
          for (int j = 0; j < 8; ++j) acc[j] += cre[(8 * hh + j) * 64 + p] * xr - cim[(8 * hh + j) * 64 + p] * xi; }
#pragma unroll
      for (int j = 0; j < 8; ++j) { const int h = 8 * hh + j; float s = acc[j]; if (tau == 0 && h == hp) s += dd[h]; KC[(tau * 16 + h) * 16 + hp] = s; } }
    __syncthreads();
    bf16* Tz = (bf16*)(ws + WS_S5M + (size_t)l * S5M_BYTES + S5M_TZ) + (size_t)g * 65536;
    bf16* Bz = (bf16*)(ws + WS_S5M + (size_t)l * S5M_BYTES + S5M_BZ) + (size_t)g * 32768;
    bf16* Cz = (bf16*)(ws + WS_S5M + (size_t)l * S5M_BYTES + S5M_CZ) + (size_t)g * 32768;
#pragma unroll 1
    for (int i = 0; i < 16; ++i) { const int idx = tid + 512 * i, n = idx >> 5, c = idx & 31, ii = n >> 4, h = n & 15, j = c >> 1, hp0 = 8 * (c & 1); float v[8];
#pragma unroll
        for (int e = 0; e < 8; ++e) v[e] = (j <= ii) ? KC[((ii - j) * 16 + h) * 16 + hp0 + e] : 0.f;
        u32x4 o; o.x = pk2(v[0], v[1]); o.y = pk2(v[2], v[3]); o.z = pk2(v[4], v[5]); o.w = pk2(v[6], v[7]); *(u32x4*)(Tz + (size_t)n * 256 + 8 * c) = o; }
#pragma unroll 1
    for (int i = 0; i < 8; ++i) { const int idx = tid + 512 * i, n = idx >> 5, c = idx & 31, p = n & 63, im = n >> 6, j = c >> 1, hp0 = 8 * (c & 1), tau = 15 - j; float v[8];
        const float pr = PWr[tau * 64 + p], pi = PWi[tau * 64 + p];
#pragma unroll
        for (int e = 0; e < 8; ++e) { const float br = BTr[p * 16 + hp0 + e], bi = BTi[p * 16 + hp0 + e]; v[e] = im ? (pr * bi + pi * br) : (pr * br - pi * bi); }
        u32x4 o; o.x = pk2(v[0], v[1]); o.y = pk2(v[2], v[3]); o.z = pk2(v[4], v[5]); o.w = pk2(v[6], v[7]); *(u32x4*)(Bz + (size_t)n * 256 + 8 * c) = o; }
#pragma unroll 1
    for (int i = 0; i < 8; ++i) { const int idx = tid + 512 * i, n = idx >> 4, c = idx & 15, ii = n >> 4, h = n & 15, im = c >> 3, tau = ii + 1; float v[8];
#pragma unroll
        for (int e = 0; e < 8; ++e) { const int p = (8 * c + e) & 63; const float cr = CRr[h * 64 + p], ci = CRi[h * 64 + p], pr = PWr[tau * 64 + p], pi = PWi[tau * 64 + p];
            v[e] = im ? -(cr * pi + ci * pr) : (cr * pr - ci * pi); }
        u32x4 o; o.x = pk2(v[0], v[1]); o.y = pk2(v[2], v[3]); o.z = pk2(v[4], v[5]); o.w = pk2(v[6], v[7]); *(u32x4*)(Cz + (size_t)n * 128 + 8 * c) = o; }
    __syncthreads();}

__device__ __forceinline__ void p0_mod_phase(LAS unsigned char* lds, const float* const* in, unsigned char* ws, int vcu, int G, int tid, int wid, int lane) {
    for (int it = vcu; it < 192; it += G) p0_mod_item(lds, in[1], in[2], in[3], in[4], (float*)(ws + WS_MOD), it, tid, wid, lane);
}
struct TrDesc { const float* src; bf16* dst; int ldw, K; const float* walpha; int acol; };
__device__ __forceinline__ TrDesc tr_decode(const float* const* in, unsigned char* ws, int it) {
    constexpr int I_IN = 16 * 168, I_OUT = 32 * 32, I_GLU = 8 * 16, I_L = I_IN + I_OUT + I_GLU;
    const int l = it / I_L; int r = it % I_L; TrDesc d; d.walpha = nullptr; d.acol = 0;
    if (r < I_IN) { const int nb = r % 168, kb = r / 168, n0 = nb * 32, sc = win_srccol(n0);
        const float* W = in[6] + (size_t)l * DM * WIN_COLS; bf16* WT = (bf16*)(ws + WS_WIN + (size_t)l * WIN_BYTES);
        d.ldw = WIN_COLS; d.K = DM; d.dst = WT + (size_t)n0 * DM + kb * 64;
        if (sc >= 0) d.src = W + (size_t)(kb * 64) * WIN_COLS + sc; else { d.src = W + (size_t)(kb * 64) * WIN_COLS + 3584; d.walpha = in[8] + (size_t)l * 16 * 256; d.acol = n0 - C_GL; }
        return d; }
    r -= I_IN;
    if (r < I_OUT) { const int nb = r % 32, kb = r / 32; d.ldw = DM; d.K = 2048; d.src = in[21] + (size_t)l * 2048 * DM + (size_t)(kb * 64) * DM + nb * 32; d.dst = (bf16*)(ws + WS_WOUT + (size_t)l * WOUT_BYTES) + (size_t)(nb * 32) * 2048 + kb * 64; return d; }
    r -= I_OUT;
    { const int nb = r % 16, kb = r / 16; d.ldw = 512; d.K = 512; d.src = in[19] + (size_t)l * 512 * 512 + (size_t)(kb * 64) * 512 + nb * 32; d.dst = (bf16*)(ws + WS_WGLU + (size_t)l * WGLU_BYTES) + (size_t)(nb * 32) * 512 + kb * 64; return d; }
}
__device__ __forceinline__ void tr_load(const TrDesc& d, f32x4 (&v)[8], int lane) {
    const int kr = lane >> 3, c4 = lane & 7;
#pragma unroll
    for (int i = 0; i < 8; ++i) v[i] = __builtin_nontemporal_load((const f32x4*)(d.src + (size_t)(8 * i + kr) * d.ldw + 4 * c4));
}
__device__ __forceinline__ void tr_lds_fill(const TrDesc& d, const f32x4 (&v)[8], LAS float* scr, int lane) {
    if (d.walpha == nullptr) { const int kr = lane >> 3, c4 = lane & 7;
#pragma unroll
        for (int i = 0; i < 8; ++i) { LAS float* q = scr + (8 * i + kr) * 33 + 4 * c4; q[0] = v[i][0]; q[1] = v[i][1]; q[2] = v[i][2]; q[3] = v[i][3]; } }
    else {
        float wa[16];
#pragma unroll
        for (int r = 0; r < 16; ++r) wa[r] = d.walpha[r * 256 + d.acol + (lane & 31)];
#pragma unroll 4
        for (int i = 0; i < 32; ++i) { const int kk = 2 * i + (lane >> 5); const f32x4* wr = (const f32x4*)(d.src + (size_t)kk * d.ldw);
            const f32x4 w0 = wr[0], w1 = wr[1], w2 = wr[2], w3 = wr[3];
            float s = (w0[0] * wa[0] + w0[1] * wa[1]) + (w0[2] * wa[2] + w0[3] * wa[3]); s += (w1[0] * wa[4] + w1[1] * wa[5]) + (w1[2] * wa[6] + w1[3] * wa[7]);
            s += (w2[0] * wa[8] + w2[1] * wa[9]) + (w2[2] * wa[10] + w2[3] * wa[11]); s += (w3[0] * wa[12] + w3[1] * wa[13]) + (w3[2] * wa[14] + w3[3] * wa[15]);
            scr[kk * 33 + (lane & 31)] = s; } }
}
__device__ __forceinline__ void tr_store(const TrDesc& d, LAS float* scr, int lane) {
    const int c = lane & 7;
#pragma unroll
    for (int j = 0; j < 4; ++j) { const int n = (lane >> 3) + 8 * j; const LAS float* s = scr + (8 * c) * 33 + n;
        u32x4 o; o.x = pk2(s[0 * 33], s[1 * 33]); o.y = pk2(s[2 * 33], s[3 * 33]); o.z = pk2(s[4 * 33], s[5 * 33]); o.w = pk2(s[6 * 33], s[7 * 33]);
        *(u32x4*)(d.dst + (size_t)n * d.K + 8 * c) = o; }
}
__device__ __forceinline__ void p1_transposes(LAS unsigned char* lds, const float* const* in, unsigned char* ws, int gw, int NGW, int wid, int lane, int it_lo, int NIT) {
    LAS float* scr = (LAS float*)(lds + wid * 16384);
    int it = it_lo + gw; if (it >= NIT) return;
    TrDesc d = tr_decode(in, ws, it); f32x4 v[8];
    if (d.walpha == nullptr) tr_load(d, v, lane);
    for (;;) {
        tr_lds_fill(d, v, scr, lane);
        const int nx = it + NGW; TrDesc dn = d; const bool more = nx < NIT;
        if (more) { dn = tr_decode(in, ws, nx); if (dn.walpha == nullptr) tr_load(dn, v, lane); }
        LDS_WAIT(); asm volatile("" ::: "memory");
        tr_store(d, scr, lane);
        LDS_WAIT(); asm volatile("" ::: "memory");
        if (!more) break;
        d = dn; it = nx;
    }
}
__device__ __forceinline__ void prenorm_phase(const float* x, const float* mod  , bf16* H, int gw, int NGW, int lane) {
    f32x4 v[4], n1[4], n2[4];
    int m = gw; if (m >= TOK) return;
#pragma unroll
    for (int j = 0; j < 4; ++j) { v[j] = __builtin_nontemporal_load((const f32x4*)(x + (size_t)m * DM + 256 * j + 4 * lane)); n1[j] = v[j]; n2[j] = v[j]; }
    if (m + NGW < TOK) {
#pragma unroll
        for (int j = 0; j < 4; ++j) n1[j] = __builtin_nontemporal_load((const f32x4*)(x + (size_t)(m + NGW) * DM + 256 * j + 4 * lane)); }
    for (; m < TOK; m += NGW) {
        if (m + 2 * NGW < TOK) {
#pragma unroll
            for (int j = 0; j < 4; ++j) n2[j] = __builtin_nontemporal_load((const f32x4*)(x + (size_t)(m + 2 * NGW) * DM + 256 * j + 4 * lane)); }
        const int b = m / SEQ; const float* mb = mod + (size_t)b * 3072; f32x4 ga[4], sh[4]; float ss = 0.f;
#pragma unroll
        for (int j = 0; j < 4; ++j) { ss += (v[j][0] * v[j][0] + v[j][1] * v[j][1]) + (v[j][2] * v[j][2] + v[j][3] * v[j][3]); ga[j] = *(const f32x4*)(mb + 1024 + 256 * j + 4 * lane); sh[j] = *(const f32x4*)(mb + 256 * j + 4 * lane); }
        const float r = rsqrtf(wave_sum(ss) * (1.0f / DM) + EPS);
#pragma unroll
        for (int j = 0; j < 4; ++j) { const f32x4 o = v[j] * r * ga[j] + sh[j]; u32x2 w; w.x = pk2(o[0], o[1]); w.y = pk2(o[2], o[3]); *(u32x2*)(H + (size_t)m * DM + 256 * j + 4 * lane) = w; }
#pragma unroll
        for (int j = 0; j < 4; ++j) { v[j] = n1[j]; n1[j] = n2[j]; }
    }
}
__device__ __forceinline__ void post_phase(const float* xin, float* xout, const bf16* Y, const float* gpost, const float* mod  , bool do_next, const float* gpre_n, const float* mod_n, bf16* Hn,
                                           int vcu, int wid, int lane) {
    const int gw = vcu * NWAVES + wid; const int m0 = gw * 8, b = m0 / SEQ;
    if (m0 >= TOK) return;
    f32x4 gp[4], gt[4];
#pragma unroll
    for (int j = 0; j < 4; ++j) { const int col = 256 * j + 4 * lane; gp[j] = *(const f32x4*)(gpost + col); gt[j] = *(const f32x4*)(mod + (size_t)b * 3072 + 2048 + col); }
    u32x2 yw[4], nyw[4]; f32x4 xv[4], nxv[4];
#pragma unroll
    for (int j = 0; j < 4; ++j) { yw[j] = *(const u32x2*)(Y + (size_t)m0 * DM + 256 * j + 4 * lane); xv[j] = __builtin_nontemporal_load((const f32x4*)(xin + (size_t)m0 * DM + 256 * j + 4 * lane)); nyw[j] = yw[j]; nxv[j] = xv[j]; }
#pragma unroll 1
    for (int i = 0; i < 8; ++i) { const int m = m0 + i; f32x4 y[4]; float ss = 0.f;
        if (i < 7) {
#pragma unroll
            for (int j = 0; j < 4; ++j) { nyw[j] = *(const u32x2*)(Y + (size_t)(m + 1) * DM + 256 * j + 4 * lane); nxv[j] = __builtin_nontemporal_load((const f32x4*)(xin + (size_t)(m + 1) * DM + 256 * j + 4 * lane)); } }
#pragma unroll
        for (int j = 0; j < 4; ++j) { y[j] = (f32x4){bflo(yw[j].x), bfhi(yw[j].x), bflo(yw[j].y), bfhi(yw[j].y)}; ss += (y[j][0] * y[j][0] + y[j][1] * y[j][1]) + (y[j][2] * y[j][2] + y[j][3] * y[j][3]); }
        const float r = rsqrtf(wave_sum(ss) * (1.0f / DM) + EPS); float s2 = 0.f;
#pragma unroll
        for (int j = 0; j < 4; ++j) { xv[j] = xv[j] + gt[j] * (y[j] * r * gp[j]); __builtin_nontemporal_store(xv[j], (f32x4*)(xout + (size_t)m * DM + 256 * j + 4 * lane));
            s2 += (xv[j][0] * xv[j][0] + xv[j][1] * xv[j][1]) + (xv[j][2] * xv[j][2] + xv[j][3] * xv[j][3]); }
        if (do_next) { const float r2 = rsqrtf(wave_sum(s2) * (1.0f / DM) + EPS);
#pragma unroll
            for (int j = 0; j < 4; ++j) { const int col = 256 * j + 4 * lane; const f32x4 ga = *(const f32x4*)(mod_n + (size_t)b * 3072 + 1024 + col), sh = *(const f32x4*)(mod_n + (size_t)b * 3072 + col);
                const f32x4 o = xv[j] * r2 * ga + sh; u32x2 w; w.x = pk2(o[0], o[1]); w.y = pk2(o[2], o[3]); *(u32x2*)(Hn + (size_t)m * DM + 256 * j + 4 * lane) = w; } }
#pragma unroll
        for (int j = 0; j < 4; ++j) { yw[j] = nyw[j]; xv[j] = nxv[j]; }
    }
}
typedef short v4i16_t __attribute__((ext_vector_type(4)));
__device__ __forceinline__ s16x4 vtr(LAS unsigned char* p) { return __builtin_bit_cast(s16x4, __builtin_amdgcn_ds_read_tr16_b64_v4i16((LAS v4i16_t*)p)); }
__device__ __forceinline__ void attn_item(LAS unsigned char* lds, bf16* P, const float* sinks, int item, int tid, int wid, int lane) {
    const int r32 = lane & 31, hi = lane >> 5;
    const int qblk = item & 31, kvh = (item >> 5) & 3, b = item >> 7, q0 = qblk * 128;
    const size_t rowbase = (size_t)b * SEQ;
    LAS unsigned char* Ks = lds; LAS unsigned char* Vs = lds + 32768; LAS float* ost = (LAS float*)(lds + 65536 + wid * 8704);
    { const int kr = tid >> 1, hf = tid & 1, key = q0 - 128 + kr; u32x4 kv[4], vv[4];
      if (key >= 0) { const bf16* src = P + (rowbase + key) * LDP + kvh * 64 + hf * 32;
#pragma unroll
          for (int c = 0; c < 4; ++c) { kv[c] = *(const u32x4*)(src + C_AK + c * 8); vv[c] = *(const u32x4*)(src + C_AV + c * 8); } }
      else {
#pragma unroll
          for (int c = 0; c < 4; ++c) { kv[c] = (u32x4){0u, 0u, 0u, 0u}; vv[c] = (u32x4){0u, 0u, 0u, 0u}; } }
#pragma unroll
      for (int c = 0; c < 4; ++c) { const int ch = hf * 4 + c; *(LAS u32x4*)(Ks + kr * 128 + ((ch ^ (kr & 7)) << 4)) = kv[c]; *(LAS u32x4*)(Vs + kr * 128 + (ch << 4)) = vv[c]; } }
    __syncthreads();
    const int g = wid >> 1, half = wid & 1, head = kvh * 4 + g;
    const float slope2 = exp2f(-0.5f * (float)(head + 1)) * LOG2E, sink2 = sinks[head] * LOG2E;
    const int q16 = (lane & 15) >> 2, p16 = lane & 3, dblk = (lane >> 4) & 1;
#pragma unroll 1
    for (int sb = 0; sb < 2; ++sb) {
        const int qs = q0 + half * 64 + sb * 32, lrow0 = half * 64 + sb * 32;
        const bf16* qp = P + (rowbase + qs + r32) * LDP + C_AQ + head * 64 + hi * 8;
        bf16x8 qf[4];
#pragma unroll
        for (int kk = 0; kk < 4; ++kk) qf[kk] = *(const bf16x8*)(qp + kk * 16);
        f32x16 S[5]; float m = sink2; int e = r32 - 4 * hi; asm volatile("" : "+v"(e)); const float ef = (float)e;
#pragma unroll
        for (int kt = 0; kt < 5; ++kt) { f32x16 acc;
            const bool tile_ok = (qs - 128 + 32 * kt) >= 0;
            if (tile_ok) {
                const float base = -slope2 * ((float)(128 - 32 * kt) + ef);
#pragma unroll
                for (int r = 0; r < 16; ++r) acc[r] = fmaf(slope2, (float)((r & 3) + 8 * (r >> 2)), base);
                const int krow = lrow0 + 32 * kt + r32;
#pragma unroll
                for (int kk = 0; kk < 4; ++kk) { const int ch = 2 * kk + hi; const bf16x8 kf = *(const LAS bf16x8*)(Ks + krow * 128 + ((ch ^ (krow & 7)) << 4)); acc = MFMA32(kf, qf[kk], acc); }
#pragma unroll
                for (int r = 0; r < 16; ++r) { const int cr = (r & 3) + 8 * (r >> 2); float s = acc[r];
                    if (kt == 0) s = (e < cr) ? s : -INFINITY; if (kt == 4) s = (e >= cr) ? s : -INFINITY;
                    S[kt][r] = s; m = fmaxf(m, s); }
            } else {
#pragma unroll
                for (int r = 0; r < 16; ++r) S[kt][r] = -INFINITY;
            }
            __builtin_amdgcn_sched_barrier(0); }
        m = fmaxf(m, __shfl_xor(m, 32));
        float l = 0.f;
#pragma unroll
        for (int kt = 0; kt < 5; ++kt)
#pragma unroll
            for (int r = 0; r < 16; ++r) { const float p = __builtin_amdgcn_exp2f(S[kt][r] - m); S[kt][r] = p; l += p; }
        l += __shfl_xor(l, 32); l += __builtin_amdgcn_exp2f(sink2 - m);
        const float inv_l = 1.0f / l;
        f32x16 o0, o1;
#pragma unroll
        for (int r = 0; r < 16; ++r) { o0[r] = 0.f; o1[r] = 0.f; }
#pragma unroll
        for (int kt = 0; kt < 5; ++kt)
#pragma unroll
            for (int ks = 0; ks < 2; ++ks) { u32x4 pw; pw.x = pk2(S[kt][8 * ks + 0], S[kt][8 * ks + 1]); pw.y = pk2(S[kt][8 * ks + 2], S[kt][8 * ks + 3]); pw.z = pk2(S[kt][8 * ks + 4], S[kt][8 * ks + 5]); pw.w = pk2(S[kt][8 * ks + 6], S[kt][8 * ks + 7]);
                const bf16x8 pa = __builtin_bit_cast(bf16x8, pw);
                LAS unsigned char* vb = Vs + (lrow0 + 32 * kt + 16 * ks + 4 * hi + q16) * 128 + dblk * 32 + p16 * 8;
                const s16x4 a0 = vtr(vb), a1 = vtr(vb + 8 * 128), b0 = vtr(vb + 64), b1 = vtr(vb + 64 + 8 * 128);
                const bf16x8 v0 = __builtin_shufflevector(a0, a1, 0, 1, 2, 3, 4, 5, 6, 7), v1 = __builtin_shufflevector(b0, b1, 0, 1, 2, 3, 4, 5, 6, 7);
                o0 = MFMA32(pa, v0, o0); o1 = MFMA32(pa, v1, o1); __builtin_amdgcn_sched_barrier(0); }
#pragma unroll
        for (int r = 0; r < 16; ++r) { const int qr = (r & 3) + 8 * (r >> 2) + 4 * hi; ost[qr * 68 + r32] = o0[r]; ost[qr * 68 + 32 + r32] = o1[r]; }
        asm volatile("" ::: "memory");
        { const int row = lane >> 1, hf = lane & 1; const float sc = __shfl(inv_l, row);
          bf16* rp = P + (rowbase + qs + row) * LDP + head * 64 + hf * 32;
#pragma unroll
          for (int c = 0; c < 4; ++c) { const u32x4 gv = *(const u32x4*)(rp + C_AG + 8 * c);
              const f32x4 x0 = *(const LAS f32x4*)(ost + row * 68 + hf * 32 + 8 * c), x1 = *(const LAS f32x4*)(ost + row * 68 + hf * 32 + 8 * c + 4);
              float gg[8] = {bflo(gv.x), bfhi(gv.x), bflo(gv.y), bfhi(gv.y), bflo(gv.z), bfhi(gv.z), bflo(gv.w), bfhi(gv.w)};
              float xx[8] = {x0[0], x0[1], x0[2], x0[3], x1[0], x1[1], x1[2], x1[3]};
#pragma unroll
              for (int e = 0; e < 8; ++e) xx[e] = xx[e] * sc * gg[e] * sigmoidf_(gg[e]);
              u32x4 w; w.x = pk2(xx[0], xx[1]); w.y = pk2(xx[2], xx[3]); w.z = pk2(xx[4], xx[5]); w.w = pk2(xx[6], xx[7]);
              *(u32x4*)(rp + C_AQ + 8 * c) = w; } }
        asm volatile("" ::: "memory");
    }
    __syncthreads();
}
constexpr int GL_QT = 0, GL_KT = 9216, GL_KH = 18432, GL_AT = 27648, GL_VT = 36864, GL_ST = 55296, GL_PART = 73728, GL_BL = 75776, GL_SS = 76032, GL_RS = 78080, GL_LD = 72;
__device__ __forceinline__ bf16x8 ldsfrag(LAS unsigned char* base, int row, int kof) { return *(const LAS bf16x8*)(base + (row * GL_LD + kof) * 2); }
template <bool OUT>
__device__ __forceinline__ void gla_item(LAS unsigned char* lds, bf16* P, const float* balpha, const float* gnorm, float* GE, float* GD, int item, int tid, int wid, int lane) {
    const int c16 = lane & 15, q = lane >> 4;
    const int b = item >> 6, hd = (item >> 4) & 3, seg = item & 15;
    const size_t row0 = (size_t)b * SEQ + seg * 256;
    LAS bf16* QT = (LAS bf16*)(lds + GL_QT); LAS bf16* KT = (LAS bf16*)(lds + GL_KT); LAS bf16* AT = (LAS bf16*)(lds + GL_AT); LAS bf16* ST = (LAS bf16*)(lds + GL_ST);
    LAS float* PART = (LAS float*)(lds + GL_PART); LAS float* BL = (LAS float*)(lds + GL_BL); LAS float* SS = (LAS float*)(lds + GL_SS); LAS float* RS = (LAS float*)(lds + GL_RS);
    f32x4 S[4];
#pragma unroll
    for (int nt = 0; nt < 4; ++nt) S[nt] = (f32x4){0.f, 0.f, 0.f, 0.f};
    if (OUT) {
#pragma unroll 1
        for (int sp = 0; sp < seg; ++sp) { const float* e = GE + (size_t)(item - seg + sp) * 8192; const float* dd = GD + (size_t)(item - seg + sp) * 64;
#pragma unroll
            for (int nt = 0; nt < 4; ++nt) { const float dec = dd[16 * nt + c16];
#pragma unroll
                for (int r = 0; r < 4; ++r) S[nt][r] = S[nt][r] * dec + e[(16 * wid + 4 * q + r) * 64 + 16 * nt + c16]; } } }
    float dtot = 0.f;
    const int d = tid & 63, part = tid >> 6;
    const float ba = balpha[hd * 64 + d];
#pragma unroll 1
    for (int ch = 0; ch < 4; ++ch) {
        const size_t rowc = row0 + ch * 64;
        float bcs[8]; float run = 0.f;
#pragma unroll
        for (int i = 0; i < 8; ++i) { const float x = bf2f(P[(rowc + part * 8 + i) * LDP + C_GL + hd * 64 + d]) + ba;
            const float la = (fminf(x, 0.f) - __logf(1.0f + __expf(-fabsf(x)))) * 0.0625f; run += la; bcs[i] = run; }
        PART[part * 64 + d] = run;
        __syncthreads();
        float off = 0.f, tot = 0.f;
#pragma unroll
        for (int p = 0; p < 8; ++p) { const float v = PART[p * 64 + d]; tot += v; off += (p < part) ? v : 0.f; }
        if (part == 0) { BL[d] = tot; dtot += tot; }
        const float etot = __expf(tot);
        { float kh[8];
#pragma unroll
          for (int i = 0; i < 8; ++i) { const float bi = off + bcs[i]; const int tok = part * 8 + i; const float kx = bf2f(P[(rowc + tok) * LDP + C_BK + hd * 64 + d]);
              const float eb = __expf(bi), ieb = __builtin_amdgcn_rcpf(eb);
              if (OUT) { const float qx = bf2f(P[(rowc + tok) * LDP + C_BQ + hd * 64 + d]); QT[tok * GL_LD + d] = f2bf(qx * 0.125f * eb); KT[tok * GL_LD + d] = f2bf(kx * ieb); }
              kh[i] = kx * (etot * ieb); }
          u32x4 w; w.x = pk2(kh[0], kh[1]); w.y = pk2(kh[2], kh[3]); w.z = pk2(kh[4], kh[5]); w.w = pk2(kh[6], kh[7]);
          *(LAS u32x4*)(lds + GL_KH + (d * GL_LD + part * 8) * 2) = w; }
        { const int v = tid & 127, tp = tid >> 7; float vv[16];
#pragma unroll
          for (int i = 0; i < 16; ++i) vv[i] = bf2f(P[(rowc + tp * 16 + i) * LDP + C_BV + hd * 128 + v]);
          u32x4 w0, w1; w0.x = pk2(vv[0], vv[1]); w0.y = pk2(vv[2], vv[3]); w0.z = pk2(vv[4], vv[5]); w0.w = pk2(vv[6], vv[7]);
          w1.x = pk2(vv[8], vv[9]); w1.y = pk2(vv[10], vv[11]); w1.z = pk2(vv[12], vv[13]); w1.w = pk2(vv[14], vv[15]);
          *(LAS u32x4*)(lds + GL_VT + (v * GL_LD + tp * 16) * 2) = w0; *(LAS u32x4*)(lds + GL_VT + (v * GL_LD + tp * 16 + 8) * 2) = w1; }
        if (OUT) {
#pragma unroll
            for (int nt = 0; nt < 4; ++nt)
#pragma unroll
                for (int r = 0; r < 4; ++r) ST[(16 * wid + 4 * q + r) * GL_LD + 16 * nt + c16] = f2bf(S[nt][r]); }
        __syncthreads();
        if (OUT) {
            { const int mt = wid >> 1;
#pragma unroll
              for (int t = 0; t < 2; ++t) { const int nt = 2 * (wid & 1) + t; f32x4 acc = (f32x4){0.f, 0.f, 0.f, 0.f};
                  if (nt <= mt) {
#pragma unroll
                      for (int kk = 0; kk < 2; ++kk) acc = MFMA16(ldsfrag(lds + GL_QT, 16 * mt + c16, 32 * kk + 8 * q), ldsfrag(lds + GL_KT, 16 * nt + c16, 32 * kk + 8 * q), acc); }
#pragma unroll
                  for (int r = 0; r < 4; ++r) { const int i = 16 * mt + 4 * q + r, j = 16 * nt + c16; AT[i * GL_LD + j] = f2bf((j <= i) ? acc[r] : 0.f); } } }
            __syncthreads();
            f32x4 o[4];
#pragma unroll
            for (int mt = 0; mt < 4; ++mt) { f32x4 acc = (f32x4){0.f, 0.f, 0.f, 0.f};
#pragma unroll
                for (int kk = 0; kk < 2; ++kk) if (kk == 0 || mt >= 2) acc = MFMA16(ldsfrag(lds + GL_AT, 16 * mt + c16, 32 * kk + 8 * q), ldsfrag(lds + GL_VT, 16 * wid + c16, 32 * kk + 8 * q), acc);
#pragma unroll
                for (int kk = 0; kk < 2; ++kk) acc = MFMA16(ldsfrag(lds + GL_QT, 16 * mt + c16, 32 * kk + 8 * q), ldsfrag(lds + GL_ST, 16 * wid + c16, 32 * kk + 8 * q), acc);
                o[mt] = acc; }
#pragma unroll
            for (int mt = 0; mt < 4; ++mt)
#pragma unroll
                for (int r = 0; r < 4; ++r) { float s = o[mt][r] * o[mt][r]; s += __shfl_xor(s, 1); s += __shfl_xor(s, 2); s += __shfl_xor(s, 4); s += __shfl_xor(s, 8);
                    if (c16 == 0) SS[wid * 64 + 16 * mt + 4 * q + r] = s; }
            __syncthreads();
            if (tid < 64) { float t = 0.f;
#pragma unroll
                for (int w = 0; w < 8; ++w) t += SS[w * 64 + tid];
                RS[tid] = rsqrtf(t * (1.0f / 128.0f) + EPS); }
            __syncthreads();
            const float gn = gnorm[hd * 128 + 16 * wid + c16];
#pragma unroll
            for (int mt = 0; mt < 4; ++mt)
#pragma unroll
                for (int r = 0; r < 4; ++r) { const int i = 16 * mt + 4 * q + r; bf16* rp = P + (rowc + i) * LDP + hd * 128 + 16 * wid + c16; const float bg = bf2f(rp[C_BG]);
                    rp[C_BV] = f2bf(o[mt][r] * RS[i] * gn * bg * sigmoidf_(bg)); }
        }
#pragma unroll
        for (int nt = 0; nt < 4; ++nt) { const float dec = __expf(BL[16 * nt + c16]); f32x4 acc = S[nt] * dec;
#pragma unroll
            for (int kk = 0; kk < 2; ++kk) acc = MFMA16(ldsfrag(lds + GL_VT, 16 * wid + c16, 32 * kk + 8 * q), ldsfrag(lds + GL_KH, 16 * nt + c16, 32 * kk + 8 * q), acc);
            S[nt] = acc; }
        __syncthreads();
    }
    if (!OUT) {
#pragma unroll
        for (int nt = 0; nt < 4; ++nt)
#pragma unroll
            for (int r = 0; r < 4; ++r) GE[(size_t)item * 8192 + (16 * wid + 4 * q + r) * 64 + 16 * nt + c16] = S[nt][r];
        if (part == 0) GD[(size_t)item * 64 + d] = __expf(dtot);
    }
}
#ifndef PH_MASK
#define PH_MASK 0xffff
#endif
__device__ __forceinline__ void cmul_acc(float& hr, float& hi, float ar, float ai, float gr, float gi) { const float nr = ar * hr - ai * hi + gr, ni = ar * hi + ai * hr + gi; hr = nr; hi = ni; }
constexpr int S5_WB = 0, S5_CZ = 67584, S5_HS = 102400, S5_LDW = 264, S5_LDC = 136;
template <bool OUT>
__device__ __forceinline__ void s5_wg_item(LAS unsigned char* lds, bf16* P, const bf16* TzT, const bf16* BzT, const bf16* CzT, const float* tab, float* SE, int item, int tid, int wid, int lane) {
    const int c16 = lane & 15, q = lane >> 4;
    const int b = item >> 6, g = (item >> 1) & 31, seg = 8 * (item & 1) + wid;
    const int id = ((b * 32 + g) << 4) + seg;
    const size_t tok0 = (size_t)b * SEQ + seg * 256;
    LAS unsigned char* wscr = lds + S5_HS + wid * 4352;
    bf16x8 uf[8];
#pragma unroll
    for (int kk = 0; kk < 8; ++kk) uf[kk] = *(const bf16x8*)(P + (tok0 + 16 * c16 + 2 * kk + (q >> 1)) * LDP + C_CU + 16 * g + 8 * (q & 1));
    { const bf16* bz = BzT + (size_t)g * 32768; u32x4 t[8];
#pragma unroll
      for (int i = 0; i < 8; ++i) t[i] = *(const u32x4*)(bz + (size_t)(tid + 512 * i) * 8);
#pragma unroll
      for (int i = 0; i < 8; ++i) { const int pc = tid + 512 * i; *(LAS u32x4*)(lds + S5_WB + (pc >> 5) * (S5_LDW * 2) + (pc & 31) * 16) = t[i]; } }
    __syncthreads();
    f32x4 G[8];
#pragma unroll
    for (int nt = 0; nt < 8; ++nt) { f32x4 acc = (f32x4){0.f, 0.f, 0.f, 0.f};
#pragma unroll
        for (int kk = 0; kk < 8; ++kk) acc = MFMA16(uf[kk], *(const LAS bf16x8*)(lds + S5_WB + ((16 * nt + c16) * S5_LDW + 32 * kk + 8 * q) * 2), acc);
        G[nt] = acc; }
    const float* tg = tab + (size_t)g * 6 * 64;
    float a16r[4], a16i[4], a64r[4], a64i[4];
#pragma unroll
    for (int n4 = 0; n4 < 4; ++n4) { const int p = 16 * n4 + c16; a16r[n4] = tg[0 * 64 + p]; a16i[n4] = tg[1 * 64 + p]; a64r[n4] = tg[2 * 64 + p]; a64i[n4] = tg[3 * 64 + p]; }
    float er[4], ei[4], ir[4], ii[4], cr[4], ci[4];
#pragma unroll
    for (int n4 = 0; n4 < 4; ++n4) { float hr = 0.f, hi = 0.f;
#pragma unroll
        for (int r = 0; r < 4; ++r) cmul_acc(hr, hi, a16r[n4], a16i[n4], G[n4][r], G[n4 + 4][r]);
        er[n4] = hr; ei[n4] = hi; ir[n4] = hr; ii[n4] = hi; }
#pragma unroll
    for (int s = 1; s < 4; ++s)
#pragma unroll
        for (int n4 = 0; n4 < 4; ++n4) { const float vr = __shfl(ir[n4], (lane - 16) & 63), vi = __shfl(ii[n4], (lane - 16) & 63);
            if (q == s) { ir[n4] = a64r[n4] * vr - a64i[n4] * vi + er[n4]; ii[n4] = a64r[n4] * vi + a64i[n4] * vr + ei[n4]; } }
#pragma unroll
    for (int n4 = 0; n4 < 4; ++n4) { const float vr = __shfl(ir[n4], (lane - 16) & 63), vi = __shfl(ii[n4], (lane - 16) & 63); cr[n4] = (q > 0) ? vr : 0.f; ci[n4] = (q > 0) ? vi : 0.f; }
    if (!OUT) {
        if (q == 3) {
#pragma unroll
            for (int n4 = 0; n4 < 4; ++n4) { SE[(size_t)id * 128 + 16 * n4 + c16] = ir[n4]; SE[(size_t)id * 128 + 64 + 16 * n4 + c16] = ii[n4]; } }
        __syncthreads();
        return;
    }
    float hinr[4] = {0.f, 0.f, 0.f, 0.f}, hini[4] = {0.f, 0.f, 0.f, 0.f};
    { float a256r[4], a256i[4];
#pragma unroll
      for (int n4 = 0; n4 < 4; ++n4) { const int p = 16 * n4 + c16; a256r[n4] = tg[4 * 64 + p]; a256i[n4] = tg[5 * 64 + p]; }
#pragma unroll 1
      for (int s0 = 0; s0 < seg; s0 += 4) { float evr[4][4], evi[4][4];
#pragma unroll
          for (int u = 0; u < 4; ++u) { const int sp = (s0 + u < seg) ? s0 + u : seg - 1; const float* e = SE + (size_t)(id - seg + sp) * 128;
#pragma unroll
              for (int n4 = 0; n4 < 4; ++n4) { evr[u][n4] = e[16 * n4 + c16]; evi[u][n4] = e[64 + 16 * n4 + c16]; } }
#pragma unroll
          for (int u = 0; u < 4; ++u) if (s0 + u < seg) {
#pragma unroll
              for (int n4 = 0; n4 < 4; ++n4) cmul_acc(hinr[n4], hini[n4], a256r[n4], a256i[n4], evr[u][n4], evi[u][n4]); } } }
    LAS bf16* Hs = (LAS bf16*)wscr;
#pragma unroll
    for (int n4 = 0; n4 < 4; ++n4) {
        float pr = 1.f, pi = 0.f;
#pragma unroll
        for (int i = 0; i < 3; ++i) if (i < q) { const float nr = pr * a64r[n4] - pi * a64i[n4], ni = pr * a64i[n4] + pi * a64r[n4]; pr = nr; pi = ni; }
        float hr = pr * hinr[n4] - pi * hini[n4] + cr[n4], hi = pr * hini[n4] + pi * hinr[n4] + ci[n4];
#pragma unroll
        for (int r = 0; r < 4; ++r) { Hs[(4 * q + r) * 136 + 16 * n4 + c16] = f2bf(hr); Hs[(4 * q + r) * 136 + 64 + 16 * n4 + c16] = f2bf(hi);
            cmul_acc(hr, hi, a16r[n4], a16i[n4], G[n4][r], G[n4 + 4][r]); } }
    asm volatile("" ::: "memory");
    bf16x8 hf[4];
#pragma unroll
    for (int kk = 0; kk < 4; ++kk) hf[kk] = *(const LAS bf16x8*)(wscr + (c16 * 136 + 32 * kk + 8 * q) * 2);
    const bf16* tz = TzT + (size_t)g * 65536; const bf16* cz = CzT + (size_t)g * 32768;
    unsigned ypk[16][2];
#pragma unroll
    for (int hl = 0; hl < 2; ++hl) {
        __syncthreads();
        { u32x4 t[8], tc[4];
          if (hl == 0) {
#pragma unroll
              for (int i = 0; i < 4; ++i) { const int pc = tid + 512 * i; t[i] = *(const u32x4*)(tz + (size_t)(pc >> 4) * 256 + (pc & 15) * 8); }
          } else {
#pragma unroll
              for (int i = 0; i < 8; ++i) { const int pc = tid + 512 * i; t[i] = *(const u32x4*)(tz + (size_t)(128 + (pc >> 5)) * 256 + (pc & 31) * 8); } }
#pragma unroll
          for (int i = 0; i < 4; ++i) { const int pc = tid + 512 * i; tc[i] = *(const u32x4*)(cz + (size_t)(128 * hl + (pc >> 4)) * 128 + (pc & 15) * 8); }
          if (hl == 0) {
#pragma unroll
              for (int i = 0; i < 4; ++i) { const int pc = tid + 512 * i; *(LAS u32x4*)(lds + S5_WB + (pc >> 4) * (S5_LDW * 2) + (pc & 15) * 16) = t[i]; }
          } else {
#pragma unroll
              for (int i = 0; i < 8; ++i) { const int pc = tid + 512 * i; *(LAS u32x4*)(lds + S5_WB + (pc >> 5) * (S5_LDW * 2) + (pc & 31) * 16) = t[i]; } }
#pragma unroll
          for (int i = 0; i < 4; ++i) { const int pc = tid + 512 * i; *(LAS u32x4*)(lds + S5_CZ + (pc >> 4) * (S5_LDC * 2) + (pc & 15) * 16) = tc[i]; } }
        __syncthreads();
#pragma unroll
        for (int n8 = 0; n8 < 8; ++n8) { const int nt = 8 * hl + n8; f32x4 acc = (f32x4){0.f, 0.f, 0.f, 0.f};
#pragma unroll
            for (int kk = 0; kk < 8; ++kk) if (kk <= (nt >> 1)) acc = MFMA16(uf[kk], *(const LAS bf16x8*)(lds + S5_WB + ((16 * n8 + c16) * S5_LDW + 32 * kk + 8 * q) * 2), acc);
#pragma unroll
            for (int kk = 0; kk < 4; ++kk) acc = MFMA16(hf[kk], *(const LAS bf16x8*)(lds + S5_CZ + ((16 * n8 + c16) * S5_LDC + 32 * kk + 8 * q) * 2), acc);
            float yv[4];
#pragma unroll
            for (int r = 0; r < 4; ++r) { const float y = acc[r], u2 = 1.5957691216057308f * (y + 0.044715f * y * y * y); yv[r] = y * sigmoidf_(u2); }
            ypk[nt][0] = pk2(yv[0], yv[1]); ypk[nt][1] = pk2(yv[2], yv[3]); }
    }
    __syncthreads();
    LAS bf16* Ys = (LAS bf16*)(lds + S5_WB + wid * 8192);
#pragma unroll
    for (int nt = 0; nt < 16; ++nt)
#pragma unroll
        for (int r = 0; r < 4; ++r) Ys[(16 * (4 * q + r) + nt) * 16 + c16] = (bf16)((r & 1) ? (ypk[nt][r >> 1] >> 16) : (ypk[nt][r >> 1] & 0xffffu));
    asm volatile("" ::: "memory");
#pragma unroll
    for (int i = 0; i < 8; ++i) { const int pc = lane + 64 * i, tk = pc >> 1, hf2 = pc & 1;
        *(u32x4*)(P + (tok0 + tk) * LDP + C_CU + 16 * g + 8 * hf2) = *(const LAS u32x4*)(lds + S5_WB + wid * 8192 + pc * 16); }
    __syncthreads();
}

template <bool SECOND>
#ifndef PROBE_TYPE
#define PROBE_TYPE -1
#endif
#define PBX(t) do { if ((t) == PROBE_TYPE) px_t0 = __builtin_amdgcn_s_memrealtime(); } while (0)
#define PEX(t) do { if ((t) == PROBE_TYPE) pacc += __builtin_amdgcn_s_memrealtime() - px_t0; } while (0)
__device__ __forceinline__ void mixers_phase(LAS unsigned char* lds, const float* const* in, unsigned char* ws, bf16* P, int l, int vcu, int G, int tid, int wid, int lane, unsigned long long& pacc) {
    unsigned long long px_t0 = 0; (void)px_t0;
    PBX(10); if (!SECOND && (PH_MASK & 0x100)) for (int it = vcu; it < 256; it += G) attn_item(lds, P, in[7] + l * 16, it, tid, wid, lane);
    PEX(10);
    float* GE = (float*)(ws + WS_GLAE); float* GD = (float*)(ws + WS_GLAD); float* SE = (float*)(ws + WS_S5E);
    const float* balpha = in[9] + l * 256; const float* gnorm = in[10] + l * 512;
    int tid1 = tid; asm volatile("" : "+v"(tid1));
    PBX(SECOND ? 13 : 11); if (PH_MASK & 0x200) for (int it = vcu; it < 256; it += G) gla_item<SECOND>(lds, P, balpha, gnorm, GE, GD, it, tid1, wid, tid1 & 63);
    PEX(SECOND ? 13 : 11);
    const bf16* TzT = (const bf16*)(ws + WS_S5M + (size_t)l * S5M_BYTES + S5M_TZ); const bf16* BzT = (const bf16*)(ws + WS_S5M + (size_t)l * S5M_BYTES + S5M_BZ);
    const bf16* CzT = (const bf16*)(ws + WS_S5M + (size_t)l * S5M_BYTES + S5M_CZ); const float* tab = (const float*)(ws + WS_TAB) + (size_t)l * 32 * 6 * 64;
    int tid2 = tid; asm volatile("" : "+v"(tid2));
    PBX(SECOND ? 14 : 12); if (PH_MASK & 0x400) for (int it = vcu; it < 256; it += G) s5_wg_item<SECOND>(lds, P, TzT, BzT, CzT, tab, SE, it, tid2, wid, tid2 & 63);
    PEX(SECOND ? 14 : 12);
}
#ifndef MK_MULTI
#define MK_MULTI 0
#endif
constexpr int N_PHASES = 2 + 6 * NLAYER;
struct Args { const float* in[22]; float* out; unsigned char* ws; int ph_lo, ph_hi; };
__global__ void __launch_bounds__(NWAVES * 64, 2) hybrid_fwd(Args args_) {
    extern __shared__ __attribute__((aligned(16))) unsigned char lds_raw[];
    const int G = gridDim.x; const int bx = blockIdx.x; const int vcu = (G % 8 == 0) ? (bx % 8) * (G / 8) + bx / 8 : bx;
    XcdBarrier bar;
    { LAS unsigned char* lds0 = (LAS unsigned char*)lds_raw;
      volatile LAS unsigned* MISC = (volatile LAS unsigned*)(lds0 + MISC_OFF);
      for (int u = threadIdx.x; u < (LDS_BYTES - LDSCTL_OFF) / 4; u += NWAVES * 64) ((LAS unsigned*)(lds0 + LDSCTL_OFF))[u] = 0u;
      __syncthreads();
      bar.bar = (unsigned*)(args_.ws + WS_CTL) + CW_BAR; bar.x = 0; bar.st = nullptr;
      if (!MK_MULTI) bar = xcd_barrier_post((unsigned*)(args_.ws + WS_CTL) + CW_BAR, MISC + 8); }
    const int lo = args_.ph_lo, hi = args_.ph_hi;
#ifndef PROBE_TYPE
#define PROBE_TYPE -1
#endif
#ifndef PROBE_K
#define PROBE_K 4
#endif
#ifndef PROBE_BLOCK
#define PROBE_BLOCK 0
#endif
    unsigned long long pr_acc = 0, pr_t0 = 0; (void)pr_t0;
#define PB(t) do { if ((t) == PROBE_TYPE) pr_t0 = __builtin_amdgcn_s_memrealtime(); } while (0)
#define PE(t) do { if ((t) == PROBE_TYPE) pr_acc += __builtin_amdgcn_s_memrealtime() - pr_t0; } while (0)
#define IN(k) (lo <= (k) && (k) < hi)
#if MK_MULTI
#define SEAM(k) do { } while (0)
#else
#define SEAM(k) do { if (IN(k) && IN((k) + 1)) xcd_barrier(bar); } while (0)
#endif
#define PHASE_IDS typedef const Args __attribute__((address_space(4)))* kargp_t; kargp_t ap = (kargp_t)__builtin_amdgcn_kernarg_segment_ptr(); asm volatile("" : "+s"(ap)); const Args& args = *(const Args*)ap; \
        int tid = threadIdx.x; asm volatile("" : "+v"(tid)); const int lane = tid & 63, wid = __builtin_amdgcn_readfirstlane(tid >> 6); (void)lane; (void)wid; \
        LAS unsigned char* lds = (LAS unsigned char*)lds_raw; asm volatile("" : "+s"(lds)); unsigned char* ws = args.ws; \
        bf16* const P = (bf16*)(ws + WS_P); bf16* const H = (bf16*)(ws + WS_H); float* const MOD = (float*)(ws + WS_MOD); (void)P; (void)H; (void)MOD;
#ifndef PH_MASK
#define PH_MASK 0xffff
#endif
    PB(0); if (IN(0) && (PH_MASK & 1)) { PHASE_IDS p0_mod_phase(lds, args.in, ws, vcu, G, tid, wid, lane); }
    SEAM(0); PE(0);
    PB(1); if (IN(1) && (PH_MASK & 2)) { PHASE_IDS
        if (G == 256) { if (vcu < 64) { PB(20); p0_s5_item(lds, args.in, ws, vcu >> 5, vcu & 31, tid); PE(20); }
                        else { const int gw = (vcu - 64) * NWAVES + wid; PB(21); p1_transposes(lds, args.in, ws, gw, 192 * NWAVES, wid, lane, 0, (16 * 168 + 32 * 32 + 8 * 16)); __syncthreads(); PE(21); PB(25); prenorm_phase(args.in[0], MOD, H, gw, 192 * NWAVES, lane); __syncthreads(); PE(25); } }
        else { for (int it = vcu; it < 64; it += G) p0_s5_item(lds, args.in, ws, it >> 5, it & 31, tid);
               const int gw = vcu * NWAVES + wid; p1_transposes(lds, args.in, ws, gw, G * NWAVES, wid, lane, 0, NLAYER * (16 * 168 + 32 * 32 + 8 * 16)); prenorm_phase(args.in[0], MOD, H, gw, G * NWAVES, lane); } }
    SEAM(1); PE(1);
#define LAYER(l, base) \
    PB(2); if (IN(base + 0) && (PH_MASK & 4)) { PHASE_IDS \
        pg8::Gemm g{H, (const bf16*)(ws + WS_WIN + (size_t)l * WIN_BYTES), TOK, LDP, DM, DM}; pg8::StaticOrder S; S.init(TOK, LDP, G, bx); \
        pg8::EpiBf16<0> E{P, LDP, nullptr, 1024, 1024, 0.125f * LOG2E};        \
        pg8::gemm_phase<pg8::EpiBf16<0>, pg8::StaticOrder, true, true>(lds, g, S, E, tid); \
        if (l == 0 && G == 256 && bx >= 64) p1_transposes(lds, args.in, ws, (bx - 64) * NWAVES + wid, 192 * NWAVES, wid, lane, (16 * 168 + 32 * 32 + 8 * 16), NLAYER * (16 * 168 + 32 * 32 + 8 * 16)); } \
    SEAM(base + 0); PE(2); \
    PB(3); if (IN(base + 1) && (PH_MASK & 8)) { PHASE_IDS mixers_phase<false>(lds, args.in, ws, P, l, vcu, G, tid, wid, lane, pr_acc); } \
    SEAM(base + 1); PE(3); \
    PB(4); if (IN(base + 2) && (PH_MASK & 8)) { PHASE_IDS mixers_phase<true>(lds, args.in, ws, P, l, vcu, G, tid, wid, lane, pr_acc); } \
    SEAM(base + 2); PE(4); \
    PB(5); if (IN(base + 3) && (PH_MASK & 16)) { PHASE_IDS \
        pg8::Gemm g{P + C_CU, (const bf16*)(ws + WS_WGLU + (size_t)l * WGLU_BYTES), TOK, 512, 512, LDP}; pg8::StaticOrder S; S.init(TOK, 512, G, bx); \
        pg8::EpiGlu E{P, LDP, C_CU, C_CG, args.in[20] + l * 512}; \
        PB(15); if (PH_MASK & 0x800) pg8::gemm_phase<pg8::EpiGlu, pg8::StaticOrder, true, true>(lds, g, S, E, tid); PE(15); PB(16); \
        if (!(PH_MASK & 0x1000)) {} else if (G == 256) { if (bx >= 128) { attn_item(lds, P, args.in[7] + l * 16, 256 + 2 * (bx - 128), tid, wid, lane); attn_item(lds, P, args.in[7] + l * 16, 257 + 2 * (bx - 128), tid, wid, lane); } } \
        else for (int it = 256 + vcu; it < 512; it += G) attn_item(lds, P, args.in[7] + l * 16, it, tid, wid, lane); PE(16); } \
    SEAM(base + 3); PE(5); \
    PB(6); if (IN(base + 4) && (PH_MASK & 32)) { PHASE_IDS \
        pg8::Gemm g{P, (const bf16*)(ws + WS_WOUT + (size_t)l * WOUT_BYTES), TOK, DM, 2048, LDP}; pg8::StaticOrder S; S.init(TOK, DM, G, bx); \
        pg8::EpiBf16<0> E{H, DM, nullptr, 0, 0, 1.f}; \
        pg8::gemm_phase<pg8::EpiBf16<0>, pg8::StaticOrder, true, true>(lds, g, S, E, tid); } \
    SEAM(base + 4); PE(6); \
    PB(7); if (IN(base + 5) && (PH_MASK & 64)) { PHASE_IDS \
        post_phase(l == 0 ? args.in[0] : args.out, args.out, H, args.in[5] + l * DM, MOD + (size_t)l * 4 * 3072, (l + 1 < NLAYER), args.in[4] + (l + 1 < NLAYER ? l + 1 : l) * DM, MOD + (size_t)(l + 1 < NLAYER ? l + 1 : l) * 4 * 3072, H, vcu, wid, lane); } \
    SEAM(base + 5); PE(7);
    LAYER(0, 2)
    LAYER(1, 8)
#undef LAYER
    if (PROBE_TYPE >= 0 && blockIdx.x == PROBE_BLOCK) { const unsigned long long te = __builtin_amdgcn_s_memrealtime(); while (__builtin_amdgcn_s_memrealtime() - te < (unsigned long long)PROBE_K * pr_acc) __builtin_amdgcn_s_sleep(20); }
#undef IN
#undef SEAM
}

extern "C" void kernel_launch(void* const* d_in, const int* in_sizes, int n_in, void* d_out, int out_size, void* d_ws, size_t ws_size, hipStream_t stream) {
    static int grid = 0;
    if (grid == 0) {
        if (n_in != 22 || in_sizes[0] != TOK * DM || out_size != TOK * DM || ws_size < WS_END) { fprintf(stderr, "kernel_launch: unexpected shapes (n_in %d, in0 %d, out %d, ws %zu)\n", n_in, n_in > 0 ? in_sizes[0] : -1, out_size, ws_size); grid = -1; return; }
        int dev = 0, cus = 0;
        if (hipGetDevice(&dev) != hipSuccess || hipDeviceGetAttribute(&cus, hipDeviceAttributeMultiprocessorCount, dev) != hipSuccess) { grid = -1; return; }
        if (hipFuncSetAttribute((const void*)hybrid_fwd, hipFuncAttributeMaxDynamicSharedMemorySize, LDS_BYTES) != hipSuccess) { fprintf(stderr, "kernel_launch: hipFuncSetAttribute failed\n"); grid = -1; return; }
        (void)hipGetLastError();
        grid = cus;
    }
    if (grid < 0) return;
    if (hipMemsetAsync((char*)d_ws + WS_CTL, 0, CTL_ZERO_BYTES, stream) != hipSuccess) { fprintf(stderr, "kernel_launch: memset failed\n"); return; }
    Args a{};
    for (int i = 0; i < 22; ++i) a.in[i] = (const float*)d_in[i];
    a.out = (float*)d_out; a.ws = (unsigned char*)d_ws;
#if MK_MULTI
    for (int ph = 0; ph < N_PHASES; ++ph) { a.ph_lo = ph; a.ph_hi = ph + 1; hipLaunchKernelGGL(hybrid_fwd, dim3(grid), dim3(NWAVES * 64), LDS_BYTES, stream, a); }
#else
    a.ph_lo = 0; a.ph_hi = N_PHASES;
    hipLaunchKernelGGL(hybrid_fwd, dim3(grid), dim3(NWAVES * 64), LDS_BYTES, stream, a);
#endif
    const hipError_t le = hipPeekAtLastError();
    if (le != hipSuccess) fprintf(stderr, "kernel_launch: launch failed: %s\n", hipGetErrorName(le));
}
```

```cpp
#include <hip/hip_runtime.h>
#include <cstdio>
#include <cstdint>
#include <cmath>
#define MK_MULTI 0
namespace pg8 {
#define PG8_LAS __attribute__((address_space(3)))
typedef unsigned short bf16_t;
typedef short bf16x8 __attribute__((ext_vector_type(8)));
typedef float f32x4 __attribute__((ext_vector_type(4)));
typedef unsigned u32x4 __attribute__((ext_vector_type(4)));
constexpr int BM = 256, BK = 64, HALF = 128, HTB = HALF * BK * 2  , STAGE_BYTES = 8 * HTB, NXCD = 8, WGM = 8;

__host__ __device__ __forceinline__ int lds_byte(int r, int c) { const int st = (r >> 4) * 2 + (c >> 5), rr = r & 15, cc = c & 31, ob = rr * 64 + cc * 2; return st * 1024 + (ob ^ (((ob >> 9) & 1) << 5)); }
__host__ __device__ __forceinline__ void stage_rc(int b, int& R, int& C) { const int st = b / 1024, sb = b % 1024, swz = sb ^ (((sb >> 9) & 1) << 5); R = (st >> 1) * 16 + swz / 64; C = (st & 1) * 32 + (swz % 64) / 2; }
__host__ __device__ __forceinline__ int perm32(int rho) { const int n = rho >> 4, i = rho & 15; return 8 * (i >> 2) + 4 * n + (i & 3); }

struct Unit { int pm, pn; };
struct Gemm { const bf16_t* A; const bf16_t* Bt; int M, N, K, lda; };

struct StaticOrder {
    int nM, nN, nwg, G, c;
    __host__ __device__ void init(int M, int N, int G_, int c_) { nM = M / BM; nN = N / BM; nwg = nM * nN; G = G_; c = c_; }
    __host__ __device__ bool next(int i, Unit& u) const {
        const long L = (long)i * G + c; if (L >= nwg) return false;
        int wgid = (int)L; { const int q = nwg / NXCD, r = nwg % NXCD, xcd = wgid % NXCD, off = wgid / NXCD; wgid = (xcd < r ? xcd * (q + 1) : r * (q + 1) + (xcd - r) * q) + off; }
        const int nig = WGM * nN, gid = wgid / nig, fm = gid * WGM, gsz = (nM - fm) < WGM ? (nM - fm) : WGM;
        u.pm = fm + ((wgid % nig) % gsz); u.pn = (wgid % nig) / gsz; return true;
    }
    __device__ __forceinline__ void a_ready(const Unit&) const {}
    __device__ __forceinline__ void done(const Unit&) const {}
};

__device__ __forceinline__ unsigned cvt_pk_bf16(float lo, float hi) { unsigned r; asm volatile("v_cvt_pk_bf16_f32 %0, %1, %2" : "=v"(r) : "v"(lo), "v"(hi)); return r; }
typedef float f32x2 __attribute__((ext_vector_type(2)));
__device__ __forceinline__ f32x2 gelu_pk(f32x2 v) {
    const f32x2 av = __builtin_elementwise_abs(v), d = av * 0.2316418882f + 1.0f;
    f32x2 t; t.x = __builtin_amdgcn_rcpf(d.x); t.y = __builtin_amdgcn_rcpf(d.y);
    f32x2 q = t * 0.5307027145f + (-0.7265760135f); q = q * t + 0.7107068705f; q = q * t + (-0.142248368f); q = q * t + 0.127414796f; q = q * t;
    const f32x2 s = (v * v) * (-0.72134752044f);
    f32x2 e; e.x = __builtin_amdgcn_exp2f(s.x); e.y = __builtin_amdgcn_exp2f(s.y);
    const f32x2 m = v * (q * e), r = v - m;
    f32x2 o; o.x = v.x < 0.f ? m.x : r.x; o.y = v.y < 0.f ? m.y : r.y; return o;
}

template <int ACT  > struct EpiBf16 {
    static constexpr bool PERM = true, AFTER_DRAIN = false; static_assert(ACT == 0 || ACT == 1, "EpiBf16: ACT is 0 (none) or 1 (gelu_pk)");
    bf16_t* O; int ldc; const float* bias; int split_cols; size_t split_stride; float scale0;
    __device__ __forceinline__ void operator()(const f32x4 (&acc)[2][2][4][2], const Unit& u, int wr, int wc, int fr, int fq) const {
        const int row0 = u.pm * BM + wr * 64 + fr; int colt = u.pn * BM; bf16_t* base = O;
        float sc = 1.f; if (split_cols) { const int t = colt / split_cols; base += (size_t)t * split_stride; colt -= t * split_cols; if (t == 0) sc = scale0; }
        const int col0 = colt + wc * 32 + 8 * fq, bcol0 = u.pn * BM + wc * 32 + 8 * fq;
        f32x4 bv[2][2];
#pragma unroll
        for (int bj = 0; bj < 2; ++bj)
#pragma unroll
            for (int n = 0; n < 2; ++n) bv[bj][n] = bias ? *(const f32x4*)(bias + bcol0 + bj * HALF + 4 * n) : (f32x4){0.f, 0.f, 0.f, 0.f};
#pragma unroll
        for (int ai = 0; ai < 2; ++ai)
#pragma unroll
            for (int m = 0; m < 4; ++m) { bf16_t* rowp = base + (size_t)(row0 + ai * HALF + m * 16) * ldc + col0;
#pragma unroll
                for (int bj = 0; bj < 2; ++bj) { f32x4 v0 = acc[ai][bj][m][0] + bv[bj][0], v1 = acc[ai][bj][m][1] + bv[bj][1];
                    if (ACT == 1) { f32x2 a = gelu_pk((f32x2){v0[0], v0[1]}), b = gelu_pk((f32x2){v0[2], v0[3]}), c = gelu_pk((f32x2){v1[0], v1[1]}), d = gelu_pk((f32x2){v1[2], v1[3]});
                        v0 = (f32x4){a.x, a.y, b.x, b.y}; v1 = (f32x4){c.x, c.y, d.x, d.y}; }
                    v0 = v0 * sc; v1 = v1 * sc; u32x4 w; w.x = cvt_pk_bf16(v0[0], v0[1]); w.y = cvt_pk_bf16(v0[2], v0[3]); w.z = cvt_pk_bf16(v1[0], v1[1]); w.w = cvt_pk_bf16(v1[2], v1[3]);
                    *(u32x4*)(rowp + bj * HALF) = w; } }
    }
};
struct EpiGlu {
    static constexpr bool PERM = true, AFTER_DRAIN = false;
    bf16_t* P; int ldp, col_y, col_g; const float* bglu;
    __device__ __forceinline__ void operator()(const f32x4 (&acc)[2][2][4][2], const Unit& u, int wr, int wc, int fr, int fq) const {
        const int row0 = u.pm * BM + wr * 64 + fr; const int col0 = u.pn * BM + wc * 32 + 8 * fq;
#pragma unroll
        for (int ai = 0; ai < 2; ++ai)
#pragma unroll
            for (int m = 0; m < 4; ++m) { bf16_t* rowp = P + (size_t)(row0 + ai * HALF + m * 16) * ldp;
#pragma unroll
                for (int bj = 0; bj < 2; ++bj) { const int col = col0 + bj * HALF;
                    const f32x4 b0 = *(const f32x4*)(bglu + col), b1 = *(const f32x4*)(bglu + col + 4);
                    const u32x4 yv = *(const u32x4*)(rowp + col_y + col), gv = *(const u32x4*)(rowp + col_g + col);
                    const f32x4 z0 = acc[ai][bj][m][0] + b0, z1 = acc[ai][bj][m][1] + b1;
                    float z[8] = {z0[0], z0[1], z0[2], z0[3], z1[0], z1[1], z1[2], z1[3]}; float o[8];
#pragma unroll
                    for (int e = 0; e < 8; ++e) { const unsigned yw = yv[e >> 1], gw = gv[e >> 1];
                        const float y = __uint_as_float((e & 1) ? (yw & 0xffff0000u) : (yw << 16)), g = __uint_as_float((e & 1) ? (gw & 0xffff0000u) : (gw << 16));
                        const float sz = __builtin_amdgcn_rcpf(1.0f + __expf(-z[e])), sg = __builtin_amdgcn_rcpf(1.0f + __expf(-g));
                        o[e] = y * sz * g * sg; }
                    u32x4 w; w.x = cvt_pk_bf16(o[0], o[1]); w.y = cvt_pk_bf16(o[2], o[3]); w.z = cvt_pk_bf16(o[4], o[5]); w.w = cvt_pk_bf16(o[6], o[7]);
                    *(u32x4*)(rowp + col_g + col) = w; } }
    }
};
template <class Epi, class Sched, bool ALIGN_EPI = false, bool SP2 = false>
__device__ __forceinline__ void gemm_phase(PG8_LAS unsigned char* lds, const Gemm g, const Sched& S, const Epi& E, int tid_in) {
    const int tid = tid_in, wid = __builtin_amdgcn_readfirstlane(tid >> 6), lane = tid & 63, wr = wid >> 2, wc = wid & 3, fr = lane & 15, fq = lane >> 4;
    const int K = g.K, nt = K / BK;
    unsigned voffA[2], voffB[2];
#pragma unroll
    for (int i = 0; i < 2; ++i) { int R, C; stage_rc(tid * 16 + i * 8192, R, C); const int Rb = Epi::PERM ? ((R & ~31) + perm32(R & 31)) : R;
        voffA[i] = (unsigned)(R * g.lda + C) * 2u; voffB[i] = (unsigned)(Rb * K + C) * 2u; }
    const size_t kstep = (size_t)(BK * 2);
    const size_t hstepB = (size_t)HALF * K * 2, hstepA = (size_t)HALF * g.lda * 2;
    const size_t tstepB = 2 * hstepB, tstepA = 2 * hstepA;
    const unsigned ldsw = (unsigned)wid * 1024u;
    const int aoff = lds_byte(wr * 64 + fr, fq * 8), boff = lds_byte(wc * 32 + fr, fq * 8);
#define PG8_SA(b, h) (((b) * 2 + (h)) * HTB)
#define PG8_SB(b, h) ((4 + (b) * 2 + (h)) * HTB)
#define PG8_STAGE(bufoff, gbase, voff) do { _Pragma("unroll") for (int _i = 0; _i < 2; ++_i) \
        __builtin_amdgcn_global_load_lds((const unsigned*)((const char*)(gbase) + (voff)[_i]), (PG8_LAS unsigned*)(lds + (bufoff) + ldsw + _i * 8192), 16, 0, 0); } while (0)
#define PG8_LDA(dst, b, h) do { _Pragma("unroll") for (int m = 0; m < 4; ++m) _Pragma("unroll") for (int k = 0; k < 2; ++k) dst[m][k] = *(const PG8_LAS bf16x8*)(lds + PG8_SA(b, h) + aoff + m * 2048 + k * 1024); } while (0)
#define PG8_LDB(dst, b, h) do { _Pragma("unroll") for (int n = 0; n < 2; ++n) _Pragma("unroll") for (int k = 0; k < 2; ++k) dst[n][k] = *(const PG8_LAS bf16x8*)(lds + PG8_SB(b, h) + boff + n * 2048 + k * 1024); } while (0)
#define PG8_MMA(ai, bj, At, Bt) do { __builtin_amdgcn_s_setprio(1); _Pragma("unroll") for (int m = 0; m < 4; ++m) _Pragma("unroll") for (int n = 0; n < 2; ++n) _Pragma("unroll") for (int k = 0; k < 2; ++k) \
        acc[ai][bj][m][n] = __builtin_amdgcn_mfma_f32_16x16x32_bf16(Bt[n][k], At[m][k], acc[ai][bj][m][n], 0, 0, 0); __builtin_amdgcn_s_setprio(0); } while (0)
#define PG8_WAIT_V(n) asm volatile("s_waitcnt vmcnt(" #n ")" ::: "memory")
#define PG8_WAIT_L(n) asm volatile("s_waitcnt lgkmcnt(" #n ")" ::: "memory")
#define PG8_BAR __builtin_amdgcn_s_barrier()
#define PG8_SCHED __builtin_amdgcn_sched_barrier(0)
    Unit cur, nxt; int ui = 0;
    if (!S.next(0, cur)) return;
    f32x4 acc[2][2][4][2];
#pragma unroll
    for (int a = 0; a < 2; ++a)
#pragma unroll
        for (int b = 0; b < 2; ++b)
#pragma unroll
            for (int m = 0; m < 4; ++m)
#pragma unroll
                for (int n = 0; n < 2; ++n) acc[a][b][m][n] = (f32x4){0.f, 0.f, 0.f, 0.f};
    bf16x8 At[4][2], B0[2][2], B1[2][2];
    const char* cA = (const char*)g.A + (size_t)cur.pm * tstepA; const char* cB = (const char*)g.Bt + (size_t)cur.pn * tstepB;
    S.a_ready(cur);
    if constexpr (SP2) {
        PG8_STAGE(PG8_SB(0, 0), cB, voffB); PG8_STAGE(PG8_SB(0, 1), cB + hstepB, voffB); PG8_STAGE(PG8_SA(0, 0), cA, voffA); PG8_STAGE(PG8_SA(0, 1), cA + hstepA, voffA);
        if (wr == 1) PG8_BAR;
        PG8_WAIT_V(2); PG8_BAR;
        PG8_STAGE(PG8_SB(1, 0), cB + kstep, voffB); PG8_STAGE(PG8_SA(1, 0), cA + kstep, voffA); PG8_STAGE(PG8_SB(1, 1), cB + hstepB + kstep, voffB);
        PG8_WAIT_V(6); PG8_BAR;
    } else {
        PG8_STAGE(PG8_SB(0, 0), cB, voffB); PG8_STAGE(PG8_SA(0, 0), cA, voffA); PG8_STAGE(PG8_SB(0, 1), cB + hstepB, voffB); PG8_STAGE(PG8_SA(0, 1), cA + hstepA, voffA);
        if (wr == 1) PG8_BAR;
        PG8_WAIT_V(4); PG8_BAR;
        PG8_STAGE(PG8_SB(1, 0), cB + kstep, voffB); PG8_STAGE(PG8_SA(1, 0), cA + kstep, voffA); PG8_STAGE(PG8_SB(1, 1), cB + hstepB + kstep, voffB);
        PG8_WAIT_V(6); PG8_BAR;
    }
    for (;;) {
        const bool has_next = S.next(ui + 1, nxt);
        const char* nA = has_next ? (const char*)g.A + (size_t)nxt.pm * tstepA : cA; const char* nB = has_next ? (const char*)g.Bt + (size_t)nxt.pn * tstepB : cB;
        for (int t = 0; t < nt; t += 2) {
            const bool last = (t == nt - 2);
            const char* a1 = cA + (size_t)(t + 1) * kstep;
            const char* a2 = last ? nA : cA + (size_t)(t + 2) * kstep; const char* b2 = last ? nB : cB + (size_t)(t + 2) * kstep;
            const char* a3 = a2 + kstep; const char* b3 = b2 + kstep;
            if (last && has_next) S.a_ready(nxt);
            if constexpr (SP2) {
            PG8_LDB(B0, 0, 0); PG8_LDB(B1, 0, 1); PG8_SCHED; PG8_LDA(At, 0, 0); PG8_STAGE(PG8_SA(1, 1), a1 + hstepA, voffA);
            PG8_WAIT_V(8); PG8_WAIT_L(0); PG8_BAR; PG8_MMA(0, 0, At, B0); PG8_MMA(0, 1, At, B1); PG8_BAR; PG8_SCHED;
            PG8_LDA(At, 0, 1); PG8_STAGE(PG8_SB(0, 0), b2, voffB); PG8_STAGE(PG8_SB(0, 1), b2 + hstepB, voffB); PG8_STAGE(PG8_SA(0, 0), a2, voffA);
            PG8_WAIT_V(8); PG8_WAIT_L(0); PG8_BAR; PG8_MMA(1, 0, At, B0); PG8_MMA(1, 1, At, B1); PG8_BAR; PG8_SCHED;
            PG8_LDB(B0, 1, 0); PG8_LDB(B1, 1, 1); PG8_SCHED; PG8_LDA(At, 1, 0); PG8_STAGE(PG8_SA(0, 1), a2 + hstepA, voffA);
            PG8_WAIT_V(8); PG8_WAIT_L(0); PG8_BAR; PG8_MMA(0, 0, At, B0); PG8_MMA(0, 1, At, B1); PG8_BAR; PG8_SCHED;
            PG8_LDA(At, 1, 1); PG8_STAGE(PG8_SB(1, 0), b3, voffB); PG8_STAGE(PG8_SB(1, 1), b3 + hstepB, voffB); PG8_STAGE(PG8_SA(1, 0), a3, voffA);
            PG8_WAIT_V(8); PG8_WAIT_L(0); PG8_BAR; PG8_MMA(1, 0, At, B0); PG8_MMA(1, 1, At, B1); PG8_BAR; PG8_SCHED;
            } else {
            PG8_LDB(B0, 0, 0); PG8_SCHED; PG8_LDA(At, 0, 0); PG8_STAGE(PG8_SA(1, 1), a1 + hstepA, voffA);
            PG8_WAIT_L(8); PG8_BAR; PG8_WAIT_L(0); PG8_MMA(0, 0, At, B0); PG8_BAR; PG8_SCHED;
            PG8_LDB(B1, 0, 1); PG8_STAGE(PG8_SB(0, 0), b2, voffB);
            PG8_BAR; PG8_WAIT_L(0); PG8_MMA(0, 1, At, B1); PG8_BAR;
            PG8_LDA(At, 0, 1); PG8_STAGE(PG8_SA(0, 0), a2, voffA);
            PG8_BAR; PG8_WAIT_L(0); PG8_MMA(1, 0, At, B0); PG8_BAR; PG8_SCHED;
            PG8_STAGE(PG8_SB(0, 1), b2 + hstepB, voffB);
            PG8_WAIT_V(6); PG8_BAR; PG8_MMA(1, 1, At, B1); PG8_BAR;
            PG8_LDB(B0, 1, 0); PG8_SCHED; PG8_LDA(At, 1, 0); PG8_STAGE(PG8_SA(0, 1), a2 + hstepA, voffA);
            PG8_WAIT_L(8); PG8_BAR; PG8_WAIT_L(0); PG8_MMA(0, 0, At, B0); PG8_BAR; PG8_SCHED;
            PG8_LDB(B1, 1, 1); PG8_STAGE(PG8_SB(1, 0), b3, voffB);
            PG8_BAR; PG8_WAIT_L(0); PG8_MMA(0, 1, At, B1); PG8_BAR;
            PG8_LDA(At, 1, 1); PG8_STAGE(PG8_SA(1, 0), a3, voffA);
            PG8_BAR; PG8_WAIT_L(0); PG8_MMA(1, 0, At, B0); PG8_BAR; PG8_SCHED;
            PG8_STAGE(PG8_SB(1, 1), b3 + hstepB, voffB);
            PG8_WAIT_V(6); PG8_BAR; PG8_MMA(1, 1, At, B1); PG8_BAR;
            }
        }
        if constexpr (ALIGN_EPI) { if (wr == 0) PG8_BAR; }
        if constexpr (!Epi::AFTER_DRAIN) { E(acc, cur, wr, wc, fr, fq); S.done(cur); }
        if (!has_next) break;
#pragma unroll
        for (int a = 0; a < 2; ++a)
#pragma unroll
            for (int b = 0; b < 2; ++b)
#pragma unroll
                for (int m = 0; m < 4; ++m)
#pragma unroll
                    for (int n = 0; n < 2; ++n) acc[a][b][m][n] = (f32x4){0.f, 0.f, 0.f, 0.f};
        cur = nxt; cA = nA; cB = nB; ++ui;
        if constexpr (ALIGN_EPI) { if (wr == 1) PG8_BAR; }
    }
    PG8_WAIT_V(0);
    if constexpr (!ALIGN_EPI) { if (wr == 0) PG8_BAR; }
    PG8_BAR;
    if constexpr (Epi::AFTER_DRAIN) { E.fused(acc, cur, wr, wc, fr, fq, lds, wid, lane); S.done(cur); }
#undef PG8_SA
#undef PG8_SB
#undef PG8_STAGE
#undef PG8_LDA
#undef PG8_LDB
#undef PG8_MMA
#undef PG8_WAIT_V
#undef PG8_WAIT_L
#undef PG8_BAR
#undef PG8_SCHED
}
}
#define GAS __attribute__((address_space(1)))
#define LAS __attribute__((address_space(3)))
typedef unsigned short bf16;
typedef short bf16x8 __attribute__((ext_vector_type(8)));
typedef float f32x4 __attribute__((ext_vector_type(4)));
typedef float f32x16 __attribute__((ext_vector_type(16)));
typedef unsigned u32x4 __attribute__((ext_vector_type(4)));
typedef unsigned u32x2 __attribute__((ext_vector_type(2)));
typedef short s16x4 __attribute__((ext_vector_type(4)));
typedef GAS unsigned gu32;
constexpr int NWAVES = 8;
constexpr int NBATCH = 4, SEQ = 4096, DM = 1024, TOK = NBATCH * SEQ, NLAYER = 2;
constexpr int NP = 5120, LDP = 5376, WIN_COLS = 5136;
constexpr int C_AQ = 0, C_BV = 1024, C_CG = 1536, C_AK = 2048, C_AV = 2304, C_AG = 2560, C_BQ = 3584, C_BK = 3840, C_BG = 4096, C_CU = 4608, C_GL = 5120;
constexpr float EPS = 1e-6f, LOG2E = 1.4426950408889634f;
constexpr size_t MiB = 1u << 20;
constexpr size_t WS_CTL = 0, CTL_ZERO_BYTES = 64 * 1024;
constexpr int CW_BAR = 1024;
constexpr size_t WS_MOD = 1 * MiB;
constexpr size_t WS_TAB = 1 * MiB + 256 * 1024;
constexpr size_t WS_WLR = 1 * MiB + 384 * 1024;
constexpr size_t WS_WA = 1 * MiB + 448 * 1024;
constexpr size_t WS_BLR = 1 * MiB + 512 * 1024;
constexpr size_t WS_WIN = 2 * MiB, WIN_BYTES = (size_t)NP * DM * 2;
constexpr size_t WS_WOUT = 23 * MiB, WOUT_BYTES = (size_t)DM * 2048 * 2;
constexpr size_t WS_WGLU = 31 * MiB, WGLU_BYTES = (size_t)512 * 512 * 2;
constexpr size_t WS_S5M = 32 * MiB, S5M_BYTES = 8 * MiB;
constexpr size_t S5M_TZ = 0, S5M_BZ = 4 * MiB, S5M_CZ = 6 * MiB;
constexpr size_t WS_H = 48 * MiB;
constexpr size_t WS_GLAE = 48 * MiB;
constexpr size_t WS_GLAD = 56 * MiB;
constexpr size_t WS_S5E = 57 * MiB;
constexpr size_t WS_P = 80 * MiB;
constexpr size_t WS_END = 248 * MiB;
static_assert(WS_WIN + 2 * WIN_BYTES <= WS_WOUT && WS_WOUT + 2 * WOUT_BYTES <= WS_WGLU && WS_WGLU + 2 * WGLU_BYTES <= WS_S5M && WS_S5M + 2 * S5M_BYTES <= WS_H, "ws map");
static_assert(WS_H + (size_t)TOK * DM * 2 <= WS_P && WS_P + (size_t)TOK * LDP * 2 <= WS_END && WS_S5E + 2048 * 128 * 4 <= WS_P, "ws map 2");
constexpr int RING_BYTES = 143360, LDSCTL_OFF = RING_BYTES, MISC_OFF = LDSCTL_OFF + 320, LDS_BYTES = 147456;

#define RLX_AGENT __ATOMIC_RELAXED, __HIP_MEMORY_SCOPE_AGENT
#define LDS_WAIT() asm volatile("s_waitcnt lgkmcnt(0)" ::: "memory")
typedef float f32x2_t __attribute__((ext_vector_type(2))); typedef __bf16 bf16x2_t __attribute__((ext_vector_type(2)));
__device__ __forceinline__ unsigned pk2(float lo, float hi) { f32x2_t v = {lo, hi}; bf16x2_t b = __builtin_convertvector(v, bf16x2_t); return __builtin_bit_cast(unsigned, b); }
__device__ __forceinline__ bf16 f2bf(float f) { return (bf16)(pk2(f, 0.f) & 0xffffu); }
__device__ __forceinline__ float bf2f(bf16 b) { return __uint_as_float((unsigned)b << 16); }
__device__ __forceinline__ float bflo(unsigned w) { return __uint_as_float(w << 16); }
__device__ __forceinline__ float bfhi(unsigned w) { return __uint_as_float(w & 0xffff0000u); }
__device__ __forceinline__ float sigmoidf_(float x) { return __builtin_amdgcn_rcpf(1.0f + __expf(-x)); }
__device__ __forceinline__ float wave_sum(float v) {
#pragma unroll
    for (int o = 1; o < 64; o <<= 1) v += __shfl_xor(v, o);
    return v;
}
#define MFMA16(a, b, c) __builtin_amdgcn_mfma_f32_16x16x32_bf16((a), (b), (c), 0, 0, 0)
#define MFMA32(a, b, c) __builtin_amdgcn_mfma_f32_32x32x16_bf16((a), (b), (c), 0, 0, 0)
#define XB_TMO      128
#define XB_XCNT(j)  (256  + 64 * (j))
#define XB_XSUB(j)  (1280 + 64 * (j))
#define XB_XGEN(j)  (2304 + 64 * (j))
#define XB_TOP      3328
#define XB_TOPGEN   3392
#define XCD_BAR_WORDS 3456
#define XB_SPIN_CAP (1u << 18)

__device__ __forceinline__ unsigned xb_ld(unsigned* p)              { return __hip_atomic_load(p, __ATOMIC_RELAXED, __HIP_MEMORY_SCOPE_AGENT); }
__device__ __forceinline__ unsigned xb_add(unsigned* p, unsigned v) { return __hip_atomic_fetch_add(p, v, __ATOMIC_RELAXED, __HIP_MEMORY_SCOPE_AGENT); }
__device__ __forceinline__ unsigned xb_xcc_id() { return (unsigned)__builtin_amdgcn_s_getreg((3 << 11) | 20) & 0xFu; }
#define XB_SPIN(cond, bar) do { unsigned _sp = 0; while (cond) { __builtin_amdgcn_s_sleep(1); \
    if ((++_sp & 255u) == 0u) { if (xb_ld(&(bar)[XB_TMO])) break; if (_sp > XB_SPIN_CAP) { atomicAdd(&(bar)[XB_TMO], 1u); break; } } } } while (0)

struct XcdBarrier {
    unsigned* bar; unsigned x;
    volatile LAS unsigned* st;
};

__device__ __forceinline__ XcdBarrier xcd_barrier_post(unsigned* bar, volatile LAS unsigned* st) {
    XcdBarrier b; b.bar = bar; b.x = xb_xcc_id(); b.st = st;
    if (threadIdx.x == 0) (void)xb_add(&bar[XB_XCNT(b.x)], 1u);
    return b;
}
__device__ __forceinline__ void xcd_barrier_complete(unsigned* bar, unsigned x, unsigned& nloc, unsigned& nx) {
    const unsigned G = gridDim.x * gridDim.y * gridDim.z;
    unsigned sum, cnt, mine, sp = 0u;
    for (;;) {
        sum = 0u; cnt = 0u; mine = 0u;
#pragma unroll
        for (unsigned j = 0; j < 16; ++j) { const unsigned c = xb_ld(&bar[XB_XCNT(j)]); sum += c; cnt += (c > 0u) ? 1u : 0u; mine = (j == x) ? c : mine; }
        if (sum == G) break;
        __builtin_amdgcn_s_sleep(1);
        if ((++sp & 255u) == 0u) { if (xb_ld(&bar[XB_TMO])) break; if (sp > XB_SPIN_CAP) { atomicAdd(&bar[XB_TMO], 1u); break; } }
    }
    nloc = mine > 0u ? mine : 1u; nx = cnt > 0u ? cnt : 1u;
}

__device__ __forceinline__ void xcd_barrier(const XcdBarrier& b) {
    asm volatile("s_waitcnt vmcnt(0)" ::: "memory");
    __syncthreads();
    if (threadIdx.x == 0) {
        unsigned* bar = b.bar;
        __builtin_amdgcn_s_waitcnt(0);
        unsigned nloc = b.st[0], nx = b.st[1];
        if (nloc == 0u) { xcd_barrier_complete(bar, b.x, nloc, nx); b.st[0] = nloc; b.st[1] = nx; }
        const unsigned old = xb_add(&bar[XB_XSUB(b.x)], 1u);
        const unsigned gen = old / nloc;
        if (old + 1u == (gen + 1u) * nloc) {
            __builtin_amdgcn_fence(__ATOMIC_RELEASE, "agent");
            asm volatile("s_waitcnt vmcnt(0)" ::: "memory");
            const unsigned og = xb_add(&bar[XB_TOP], 1u);
            const unsigned tg = og / nx;
            if (og + 1u == (tg + 1u) * nx) xb_add(&bar[XB_TOPGEN], 1u);
            else XB_SPIN(xb_ld(&bar[XB_TOPGEN]) == tg, bar);
            __builtin_amdgcn_fence(__ATOMIC_ACQUIRE, "agent");
            xb_add(&bar[XB_XGEN(b.x)], 1u);
            asm volatile("s_waitcnt vmcnt(0)" ::: "memory");
        } else {
            XB_SPIN(xb_ld(&bar[XB_XGEN(b.x)]) == gen, bar);
            __builtin_amdgcn_fence(__ATOMIC_ACQUIRE, "agent");
            asm volatile("s_waitcnt vmcnt(0)" ::: "memory");
        }
    }
    __syncthreads();
}
__device__ __forceinline__ int win_srccol(int n0) {
    if (n0 < 1024) return n0;
    if (n0 < 1536) return 3072 + (n0 - 1024);
    if (n0 < 2048) return 4624 + (n0 - 1536);
    if (n0 < 2304) return 1024 + (n0 - 2048);
    if (n0 < 2560) return 1280 + (n0 - 2304);
    if (n0 < 3584) return 1536 + (n0 - 2560);
    if (n0 < 3840) return 2560 + (n0 - 3584);
    if (n0 < 4096) return 2816 + (n0 - 3840);
    if (n0 < 4608) return 3600 + (n0 - 4096);
    return 4112 + (n0 - 4608);
}
constexpr int TR_NB = NP / 32, TR_IL = 16 * TR_NB + 32 * 32 + 8 * 16;
__device__ __forceinline__ void p0_gate_small(const float* const* in, unsigned char* ws, int l, int tid) {
    const float* W = in[6] + (size_t)l * DM * WIN_COLS; bf16* WL = (bf16*)(ws + WS_WLR) + (size_t)l * 16 * 1024; bf16* WA = (bf16*)(ws + WS_WA) + (size_t)l * 256 * 16;
    for (int k = tid; k < 1024; k += 512) { const f32x4* wr = (const f32x4*)(W + (size_t)k * WIN_COLS + 3584); const f32x4 w0 = wr[0], w1 = wr[1], w2 = wr[2], w3 = wr[3];
        const float v[16] = {w0[0], w0[1], w0[2], w0[3], w1[0], w1[1], w1[2], w1[3], w2[0], w2[1], w2[2], w2[3], w3[0], w3[1], w3[2], w3[3]};
#pragma unroll
        for (int r = 0; r < 16; ++r) WL[r * 1024 + k] = f2bf(v[r]); }
    if (tid < 256) { const float* wa = in[8] + (size_t)l * 16 * 256 + tid; float v[16];
#pragma unroll
        for (int r = 0; r < 16; ++r) v[r] = wa[r * 256];
        u32x4 o0, o1; o0.x = pk2(v[0], v[1]); o0.y = pk2(v[2], v[3]); o0.z = pk2(v[4], v[5]); o0.w = pk2(v[6], v[7]); o1.x = pk2(v[8], v[9]); o1.y = pk2(v[10], v[11]); o1.z = pk2(v[12], v[13]); o1.w = pk2(v[14], v[15]);
        *(u32x4*)(WA + tid * 16) = o0; *(u32x4*)(WA + tid * 16 + 8) = o1; }
}
__device__ __forceinline__ void blr_head(LAS unsigned char* lds, const bf16* H, const bf16* WL, bf16* BLR, int wg, int tid, int wid, int lane) {
    const int c16 = lane & 15, q = lane >> 4, mt = wid & 3, kh = wid >> 2;
    const bf16* ap = H + (size_t)(64 * wg + 16 * mt + c16) * DM + 512 * kh + 8 * q; const bf16* bp = WL + (size_t)c16 * 1024 + 512 * kh + 8 * q;
    f32x4 acc = (f32x4){0.f, 0.f, 0.f, 0.f};
    { bf16x8 af[16], bfr[16];
#pragma unroll
      for (int kk = 0; kk < 16; ++kk) { af[kk] = *(const bf16x8*)(ap + 32 * kk); bfr[kk] = *(const bf16x8*)(bp + 32 * kk); }
#pragma unroll
      for (int kk = 0; kk < 16; ++kk) acc = MFMA16(af[kk], bfr[kk], acc); }
    LAS float* part = (LAS float*)lds;
#pragma unroll
    for (int r = 0; r < 4; ++r) part[(kh * 64 + 16 * mt + 4 * q + r) * 16 + c16] = acc[r];
    __syncthreads();
    { const int e0 = 2 * tid; const float s0 = part[e0] + part[1024 + e0], s1 = part[e0 + 1] + part[1024 + e0 + 1];
      *(unsigned*)(BLR + (size_t)64 * wg * 16 + e0) = pk2(s0, s1); }
    __syncthreads();
}
__device__ __forceinline__ void p0_mod_item(LAS unsigned char* lds, const float* c, const float* wmod, const float* bmod, const float* gpre, float* mod, int it, int tid, int wid, int lane) {
    LAS float* sc = (LAS float*)lds; LAS float* part = (LAS float*)(lds + 16384);
    const int l = it / 96, nb = it % 96, col = nb * 32 + (lane & 31), ks = wid * 2 + (lane >> 5);
    const float* wp = wmod + (size_t)l * 1024 * 3072 + col + (size_t)ks * 64 * 3072;
    float w[64];
#pragma unroll
    for (int i = 0; i < 64; ++i) w[i] = __builtin_nontemporal_load(wp + (size_t)i * 3072);
    for (int i = tid; i < 4096; i += 512) { const float cv = c[i]; sc[i] = cv * sigmoidf_(cv); }
    __syncthreads();
    float a0 = 0.f, a1 = 0.f, a2 = 0.f, a3 = 0.f;
#pragma unroll
    for (int i = 0; i < 64; ++i) { const int k = ks * 64 + i; a0 += sc[k] * w[i]; a1 += sc[1024 + k] * w[i]; a2 += sc[2048 + k] * w[i]; a3 += sc[3072 + k] * w[i]; }
    part[(ks * 4 + 0) * 32 + (lane & 31)] = a0; part[(ks * 4 + 1) * 32 + (lane & 31)] = a1; part[(ks * 4 + 2) * 32 + (lane & 31)] = a2; part[(ks * 4 + 3) * 32 + (lane & 31)] = a3;
    __syncthreads();
    if (tid < 128) { const int b = tid >> 5, n = nb * 32 + (tid & 31); float s = 0.f;
#pragma unroll
        for (int k = 0; k < 16; ++k) s += part[(k * 4 + b) * 32 + (tid & 31)];
        s += bmod[l * 3072 + n];
        if (n >= 1024 && n < 2048) s = gpre[l * 1024 + n - 1024] * (1.0f + s);
        mod[(size_t)(l * 4 + b) * 3072 + n] = s; }
    __syncthreads();
}

__device__ __forceinline__ void p0_s5_item(LAS unsigned char* lds, const float* const* in, unsigned char* ws, int l, int g, int tid) {
    LAS float* PWr = (LAS float*)lds; LAS float* PWi = PWr + 17 * 64; LAS float* BTr = PWi + 17 * 64; LAS float* BTi = BTr + 1024;
    LAS float* CRr = BTi + 1024; LAS float* CRi = CRr + 1024; LAS float* KC = CRi + 1024;
    const float* are = in[11] + (size_t)(l * 32 + g) * 64; const float* aim = in[12] + (size_t)(l * 32 + g) * 64;
    const double dt = exp((double)in[13][l * 32 + g]);
    const float* bre = in[14] + (size_t)(l * 32 + g) * 1024; const float* bim = in[15] + (size_t)(l * 32 + g) * 1024;
    const float* cre = in[16] + (size_t)(l * 32 + g) * 1024; const float* cim = in[17] + (size_t)(l * 32 + g) * 1024;
    const float* dd = in[18] + (size_t)l * 512 + g * 16;
    float* tab = (float*)(ws + WS_TAB) + (size_t)(l * 32 + g) * 6 * 64;
    if (tid < 64) { const int p = tid; const double ar = are[p], ai = aim[p];
        const double mag = exp(ar * dt), abr = mag * cos(ai * dt), abi = mag * sin(ai * dt), den = ar * ar + ai * ai, nr = abr - 1.0;
        const double fr = (nr * ar + abi * ai) / den, fi = (abi * ar - nr * ai) / den;
#pragma unroll 4
        for (int h = 0; h < 16; ++h) { const double br = bre[p * 16 + h], bi = bim[p * 16 + h]; BTr[p * 16 + h] = (float)(fr * br - fi * bi); BTi[p * 16 + h] = (float)(fr * bi + fi * br); }
        double pr = 1.0, pi = 0.0;
#pragma unroll 1
        for (int tau = 0; tau <= 16; ++tau) { PWr[tau * 64 + p] = (float)pr; PWi[tau * 64 + p] = (float)pi; const double t = pr * abr - pi * abi; pi = pr * abi + pi * abr; pr = t; }
        double qr = (double)0, qi = (double)0; { qr = 1.0; qi = 0.0; double xr = abr, xi = abi;
#pragma unroll 1
          for (int s2 = 0; s2 < 8; ++s2) { const double t = xr * xr - xi * xi; xi = 2.0 * xr * xi; xr = t;
              if (s2 == 3) { tab[0 * 64 + p] = (float)xr; tab[1 * 64 + p] = (float)xi; }
              if (s2 == 5) { tab[2 * 64 + p] = (float)xr; tab[3 * 64 + p] = (float)xi; }
              if (s2 == 7) { tab[4 * 64 + p] = (float)xr; tab[5 * 64 + p] = (float)xi; } } }
        (void)qr; (void)qi; }
    for (int idx = tid; idx < 1024; idx += 512) { CRr[idx] = cre[idx]; CRi[idx] = cim[idx]; }
    __syncthreads();
    { const int hp = tid & 15, tau = (tid >> 4) & 15, hh = __builtin_amdgcn_readfirstlane(tid >> 8); float acc[8];
#pragma unroll
      for (int j = 0; j < 8; ++j) acc[j] = 0.f;
#pragma unroll 4
      for (int p = 0; p < 64; ++p) { const float pr = PWr[tau * 64 + p], pi = PWi[tau * 64 + p], br = BTr[p * 16 + hp], bi = BTi[p * 16 + hp];
          const float xr = pr * br - pi * bi, xi = pr * bi + pi * br;
#pragma unroll
          for (int j = 0; j < 8; ++j) acc[j] += cre[(8 * hh + j) * 64 + p] * xr - cim[(8 * hh + j) * 64 + p] * xi; }
#pragma unroll
      for (int j = 0; j < 8; ++j) { const int h = 8 * hh + j; float s = acc[j]; if (tau == 0 && h == hp) s += dd[h]; KC[(tau * 16 + h) * 16 + hp] = s; } }
    __syncthreads();
    bf16* Tz = (bf16*)(ws + WS_S5M + (size_t)l * S5M_BYTES + S5M_TZ) + (size_t)g * 65536;
    bf16* Bz = (bf16*)(ws + WS_S5M + (size_t)l * S5M_BYTES + S5M_BZ) + (size_t)g * 32768;
    bf16* Cz = (bf16*)(ws + WS_S5M + (size_t)l * S5M_BYTES + S5M_CZ) + (size_t)g * 32768;
#pragma unroll 1
    for (int i = 0; i < 16; ++i) { const int idx = tid + 512 * i, n = idx >> 5, c = idx & 31, ii = n >> 4, h = n & 15, j = c >> 1, hp0 = 8 * (c & 1); float v[8];
#pragma unroll
        for (int e = 0; e < 8; ++e) v[e] = (j <= ii) ? KC[((ii - j) * 16 + h) * 16 + hp0 + e] : 0.f;
        u32x4 o; o.x = pk2(v[0], v[1]); o.y = pk2(v[2], v[3]); o.z = pk2(v[4], v[5]); o.w = pk2(v[6], v[7]); *(u32x4*)(Tz + (size_t)n * 256 + 8 * c) = o; }
#pragma unroll 1
    for (int i = 0; i < 8; ++i) { const int idx = tid + 512 * i, n = idx >> 5, c = idx & 31, p = n & 63, im = n >> 6, j = c >> 1, hp0 = 8 * (c & 1), tau = 15 - j; float v[8];
        const float pr = PWr[tau * 64 + p], pi = PWi[tau * 64 + p];
#pragma unroll
        for (int e = 0; e < 8; ++e) { const float br = BTr[p * 16 + hp0 + e], bi = BTi[p * 16 + hp0 + e]; v[e] = im ? (pr * bi + pi * br) : (pr * br - pi * bi); }
        u32x4 o; o.x = pk2(v[0], v[1]); o.y = pk2(v[2], v[3]); o.z = pk2(v[4], v[5]); o.w = pk2(v[6], v[7]); *(u32x4*)(Bz + (size_t)n * 256 + 8 * c) = o; }
#pragma unroll 1
    for (int i = 0; i < 8; ++i) { const int idx = tid + 512 * i, n = idx >> 4, c = idx & 15, ii = n >> 4, h = n & 15, im = c >> 3, tau = ii + 1; float v[8];
#pragma unroll
        for (int e = 0; e < 8; ++e) { const int p = (8 * c + e) & 63; const float cr = CRr[h * 64 + p], ci = CRi[h * 64 + p], pr = PWr[tau * 64 + p], pi = PWi[tau * 64 + p];
            v[e] = im ? -(cr * pi + ci * pr) : (cr * pr - ci * pi); }
        u32x4 o; o.x = pk2(v[0], v[1]); o.y = pk2(v[2], v[3]); o.z = pk2(v[4], v[5]); o.w = pk2(v[6], v[7]); *(u32x4*)(Cz + (size_t)n * 128 + 8 * c) = o; }
    __syncthreads();}

__device__ __forceinline__ void p0_mod_phase(LAS unsigned char* lds, const float* const* in, unsigned char* ws, int vcu, int G, int tid, int wid, int lane) {
    for (int it = vcu; it < 192 + NLAYER; it += G) { if (it < 192) p0_mod_item(lds, in[1], in[2], in[3], in[4], (float*)(ws + WS_MOD), it, tid, wid, lane); else p0_gate_small(in, ws, it - 192, tid); }
}
struct TrDesc { const float* src; bf16* dst; int ldw, K; const float* walpha; int acol; };
__device__ __forceinline__ TrDesc tr_decode(const float* const* in, unsigned char* ws, int it) {
    constexpr int I_IN = 16 * TR_NB, I_OUT = 32 * 32, I_L = TR_IL;
    const int l = it / I_L; int r = it % I_L; TrDesc d; d.walpha = nullptr; d.acol = 0;
    if (r < I_IN) { const int nb = r % TR_NB, kb = r / TR_NB, n0 = nb * 32, sc = win_srccol(n0);
        const float* W = in[6] + (size_t)l * DM * WIN_COLS; bf16* WT = (bf16*)(ws + WS_WIN + (size_t)l * WIN_BYTES);
        d.ldw = WIN_COLS; d.K = DM; d.dst = WT + (size_t)n0 * DM + kb * 64;
        d.src = W + (size_t)(kb * 64) * WIN_COLS + sc;
        return d; }
    r -= I_IN;
    if (r < I_OUT) { const int nb = r % 32, kb = r / 32; d.ldw = DM; d.K = 2048; d.src = in[21] + (size_t)l * 2048 * DM + (size_t)(kb * 64) * DM + nb * 32; d.dst = (bf16*)(ws + WS_WOUT + (size_t)l * WOUT_BYTES) + (size_t)(nb * 32) * 2048 + kb * 64; return d; }
    r -= I_OUT;
    { const int nb = r % 16, kb = r / 16; d.ldw = 512; d.K = 512; d.src = in[19] + (size_t)l * 512 * 512 + (size_t)(kb * 64) * 512 + nb * 32; d.dst = (bf16*)(ws + WS_WGLU + (size_t)l * WGLU_BYTES) + (size_t)(nb * 32) * 512 + kb * 64; return d; }
}
__device__ __forceinline__ void tr_load(const TrDesc& d, f32x4 (&v)[8], int lane) {
    const int kr = lane >> 3, c4 = lane & 7;
#pragma unroll
    for (int i = 0; i < 8; ++i) v[i] = __builtin_nontemporal_load((const f32x4*)(d.src + (size_t)(8 * i + kr) * d.ldw + 4 * c4));
}
__device__ __forceinline__ void tr_lds_fill(const TrDesc& d, const f32x4 (&v)[8], LAS float* scr, int lane) {
    if (d.walpha == nullptr) { const int kr = lane >> 3, c4 = lane & 7;
#pragma unroll
        for (int i = 0; i < 8; ++i) { LAS float* q = scr + (8 * i + kr) * 33 + 4 * c4; q[0] = v[i][0]; q[1] = v[i][1]; q[2] = v[i][2]; q[3] = v[i][3]; } }
    else {
        float wa[16];
#pragma unroll
        for (int r = 0; r < 16; ++r) wa[r] = d.walpha[r * 256 + d.acol + (lane & 31)];
#pragma unroll 4
        for (int i = 0; i < 32; ++i) { const int kk = 2 * i + (lane >> 5); const f32x4* wr = (const f32x4*)(d.src + (size_t)kk * d.ldw);
            const f32x4 w0 = wr[0], w1 = wr[1], w2 = wr[2], w3 = wr[3];
            float s = (w0[0] * wa[0] + w0[1] * wa[1]) + (w0[2] * wa[2] + w0[3] * wa[3]); s += (w1[0] * wa[4] + w1[1] * wa[5]) + (w1[2] * wa[6] + w1[3] * wa[7]);
            s += (w2[0] * wa[8] + w2[1] * wa[9]) + (w2[2] * wa[10] + w2[3] * wa[11]); s += (w3[0] * wa[12] + w3[1] * wa[13]) + (w3[2] * wa[14] + w3[3] * wa[15]);
            scr[kk * 33 + (lane & 31)] = s; } }
}
__device__ __forceinline__ void tr_store(const TrDesc& d, LAS float* scr, int lane) {
    const int c = lane & 7;
#pragma unroll
    for (int j = 0; j < 4; ++j) { const int n = (lane >> 3) + 8 * j; const LAS float* s = scr + (8 * c) * 33 + n;
        u32x4 o; o.x = pk2(s[0 * 33], s[1 * 33]); o.y = pk2(s[2 * 33], s[3 * 33]); o.z = pk2(s[4 * 33], s[5 * 33]); o.w = pk2(s[6 * 33], s[7 * 33]);
        *(u32x4*)(d.dst + (size_t)n * d.K + 8 * c) = o; }
}
__device__ __forceinline__ void p1_transposes(LAS unsigned char* lds, const float* const* in, unsigned char* ws, int gw, int NGW, int wid, int lane, int it_lo, int NIT) {
    LAS float* scr = (LAS float*)(lds + wid * 16384);
    int it = it_lo + gw; if (it >= NIT) return;
    TrDesc d = tr_decode(in, ws, it); f32x4 v[8];
    if (d.walpha == nullptr) tr_load(d, v, lane);
    for (;;) {
        tr_lds_fill(d, v, scr, lane);
        const int nx = it + NGW; TrDesc dn = d; const bool more = nx < NIT;
        if (more) { dn = tr_decode(in, ws, nx); if (dn.walpha == nullptr) tr_load(dn, v, lane); }
        LDS_WAIT(); asm volatile("" ::: "memory");
        tr_store(d, scr, lane);
        LDS_WAIT(); asm volatile("" ::: "memory");
        if (!more) break;
        d = dn; it = nx;
    }
}
__device__ __forceinline__ void prenorm_phase(const float* x, const float* mod  , bf16* H, int gw, int NGW, int lane) {
    f32x4 v[4], n1[4], n2[4];
    int m = gw; if (m >= TOK) return;
#pragma unroll
    for (int j = 0; j < 4; ++j) { v[j] = __builtin_nontemporal_load((const f32x4*)(x + (size_t)m * DM + 256 * j + 4 * lane)); n1[j] = v[j]; n2[j] = v[j]; }
    if (m + NGW < TOK) {
#pragma unroll
        for (int j = 0; j < 4; ++j) n1[j] = __builtin_nontemporal_load((const f32x4*)(x + (size_t)(m + NGW) * DM + 256 * j + 4 * lane)); }
    for (; m < TOK; m += NGW) {
        if (m + 2 * NGW < TOK) {
#pragma unroll
            for (int j = 0; j < 4; ++j) n2[j] = __builtin_nontemporal_load((const f32x4*)(x + (size_t)(m + 2 * NGW) * DM + 256 * j + 4 * lane)); }
        const int b = m / SEQ; const float* mb = mod + (size_t)b * 3072; f32x4 ga[4], sh[4]; float ss = 0.f;
#pragma unroll
        for (int j = 0; j < 4; ++j) { ss += (v[j][0] * v[j][0] + v[j][1] * v[j][1]) + (v[j][2] * v[j][2] + v[j][3] * v[j][3]); ga[j] = *(const f32x4*)(mb + 1024 + 256 * j + 4 * lane); sh[j] = *(const f32x4*)(mb + 256 * j + 4 * lane); }
        const float r = rsqrtf(wave_sum(ss) * (1.0f / DM) + EPS);
#pragma unroll
        for (int j = 0; j < 4; ++j) { const f32x4 o = v[j] * r * ga[j] + sh[j]; u32x2 w; w.x = pk2(o[0], o[1]); w.y = pk2(o[2], o[3]); *(u32x2*)(H + (size_t)m * DM + 256 * j + 4 * lane) = w; }
#pragma unroll
        for (int j = 0; j < 4; ++j) { v[j] = n1[j]; n1[j] = n2[j]; }
    }
}
__device__ __forceinline__ void post_phase(const float* xin, float* xout, const bf16* Y, const float* gpost, const float* mod  , bool do_next, const float* gpre_n, const float* mod_n, bf16* Hn,
                                           int vcu, int wid, int lane) {
    const int gw = vcu * NWAVES + wid; const int m0 = gw * 8, b = m0 / SEQ;
    if (m0 >= TOK) return;
    f32x4 gp[4], gt[4];
#pragma unroll
    for (int j = 0; j < 4; ++j) { const int col = 256 * j + 4 * lane; gp[j] = *(const f32x4*)(gpost + col); gt[j] = *(const f32x4*)(mod + (size_t)b * 3072 + 2048 + col); }
    u32x2 yw[4], nyw[4]; f32x4 xv[4], nxv[4];
#pragma unroll
    for (int j = 0; j < 4; ++j) { yw[j] = *(const u32x2*)(Y + (size_t)m0 * DM + 256 * j + 4 * lane); xv[j] = __builtin_nontemporal_load((const f32x4*)(xin + (size_t)m0 * DM + 256 * j + 4 * lane)); nyw[j] = yw[j]; nxv[j] = xv[j]; }
#pragma unroll 1
    for (int i = 0; i < 8; ++i) { const int m = m0 + i; f32x4 y[4]; float ss = 0.f;
        if (i < 7) {
#pragma unroll
            for (int j = 0; j < 4; ++j) { nyw[j] = *(const u32x2*)(Y + (size_t)(m + 1) * DM + 256 * j + 4 * lane); nxv[j] = __builtin_nontemporal_load((const f32x4*)(xin + (size_t)(m + 1) * DM + 256 * j + 4 * lane)); } }
#pragma unroll
        for (int j = 0; j < 4; ++j) { y[j] = (f32x4){bflo(yw[j].x), bfhi(yw[j].x), bflo(yw[j].y), bfhi(yw[j].y)}; ss += (y[j][0] * y[j][0] + y[j][1] * y[j][1]) + (y[j][2] * y[j][2] + y[j][3] * y[j][3]); }
        const float r = rsqrtf(wave_sum(ss) * (1.0f / DM) + EPS); float s2 = 0.f;
#pragma unroll
        for (int j = 0; j < 4; ++j) { xv[j] = xv[j] + gt[j] * (y[j] * r * gp[j]); __builtin_nontemporal_store(xv[j], (f32x4*)(xout + (size_t)m * DM + 256 * j + 4 * lane));
            s2 += (xv[j][0] * xv[j][0] + xv[j][1] * xv[j][1]) + (xv[j][2] * xv[j][2] + xv[j][3] * xv[j][3]); }
        if (do_next) { const float r2 = rsqrtf(wave_sum(s2) * (1.0f / DM) + EPS);
#pragma unroll
            for (int j = 0; j < 4; ++j) { const int col = 256 * j + 4 * lane; const f32x4 ga = *(const f32x4*)(mod_n + (size_t)b * 3072 + 1024 + col), sh = *(const f32x4*)(mod_n + (size_t)b * 3072 + col);
                const f32x4 o = xv[j] * r2 * ga + sh; u32x2 w; w.x = pk2(o[0], o[1]); w.y = pk2(o[2], o[3]); *(u32x2*)(Hn + (size_t)m * DM + 256 * j + 4 * lane) = w; } }
#pragma unroll
        for (int j = 0; j < 4; ++j) { yw[j] = nyw[j]; xv[j] = nxv[j]; }
    }
}
typedef short v4i16_t __attribute__((ext_vector_type(4)));
__device__ __forceinline__ s16x4 vtr(LAS unsigned char* p) { return __builtin_bit_cast(s16x4, __builtin_amdgcn_ds_read_tr16_b64_v4i16((LAS v4i16_t*)p)); }
__device__ __forceinline__ void attn_item(LAS unsigned char* lds, bf16* P, const float* sinks, int item, int tid, int wid, int lane) {
    const int r32 = lane & 31, hi = lane >> 5;
    const int qblk = item & 31, kvh = (item >> 5) & 3, b = item >> 7, q0 = qblk * 128;
    const size_t rowbase = (size_t)b * SEQ;
    LAS unsigned char* Ks = lds; LAS unsigned char* Vs = lds + 32768; LAS float* ost = (LAS float*)(lds + 65536 + wid * 8704);
    { const int kr = tid >> 1, hf = tid & 1, key = q0 - 128 + kr; u32x4 kv[4], vv[4];
      if (key >= 0) { const bf16* src = P + (rowbase + key) * LDP + kvh * 64 + hf * 32;
#pragma unroll
          for (int c = 0; c < 4; ++c) { kv[c] = *(const u32x4*)(src + C_AK + c * 8); vv[c] = *(const u32x4*)(src + C_AV + c * 8); } }
      else {
#pragma unroll
          for (int c = 0; c < 4; ++c) { kv[c] = (u32x4){0u, 0u, 0u, 0u}; vv[c] = (u32x4){0u, 0u, 0u, 0u}; } }
#pragma unroll
      for (int c = 0; c < 4; ++c) { const int ch = hf * 4 + c; *(LAS u32x4*)(Ks + kr * 128 + ((ch ^ (kr & 7)) << 4)) = kv[c]; *(LAS u32x4*)(Vs + kr * 128 + (ch << 4)) = vv[c]; } }
    __syncthreads();
    const int g = wid >> 1, half = wid & 1, head = kvh * 4 + g;
    const float slope2 = exp2f(-0.5f * (float)(head + 1)) * LOG2E, sink2 = sinks[head] * LOG2E;
    const int q16 = (lane & 15) >> 2, p16 = lane & 3, dblk = (lane >> 4) & 1;
#pragma unroll 1
    for (int sb = 0; sb < 2; ++sb) {
        const int qs = q0 + half * 64 + sb * 32, lrow0 = half * 64 + sb * 32;
        const bf16* qp = P + (rowbase + qs + r32) * LDP + C_AQ + head * 64 + hi * 8;
        bf16x8 qf[4];
#pragma unroll
        for (int kk = 0; kk < 4; ++kk) qf[kk] = *(const bf16x8*)(qp + kk * 16);
        f32x16 S[5]; float m = sink2; int e = r32 - 4 * hi; asm volatile("" : "+v"(e)); const float ef = (float)e;
#pragma unroll
        for (int kt = 0; kt < 5; ++kt) { f32x16 acc;
            const bool tile_ok = (qs - 128 + 32 * kt) >= 0;
            if (tile_ok) {
                const float base = -slope2 * ((float)(128 - 32 * kt) + ef);
#pragma unroll
                for (int r = 0; r < 16; ++r) acc[r] = fmaf(slope2, (float)((r & 3) + 8 * (r >> 2)), base);
                const int krow = lrow0 + 32 * kt + r32;
#pragma unroll
                for (int kk = 0; kk < 4; ++kk) { const int ch = 2 * kk + hi; const bf16x8 kf = *(const LAS bf16x8*)(Ks + krow * 128 + ((ch ^ (krow & 7)) << 4)); acc = MFMA32(kf, qf[kk], acc); }
#pragma unroll
                for (int r = 0; r < 16; ++r) { const int cr = (r & 3) + 8 * (r >> 2); float s = acc[r];
                    if (kt == 0) s = (e < cr) ? s : -INFINITY; if (kt == 4) s = (e >= cr) ? s : -INFINITY;
                    S[kt][r] = s; m = fmaxf(m, s); }
            } else {
#pragma unroll
                for (int r = 0; r < 16; ++r) S[kt][r] = -INFINITY;
            }
            __builtin_amdgcn_sched_barrier(0); }
        m = fmaxf(m, __shfl_xor(m, 32));
        float l = 0.f;
#pragma unroll
        for (int kt = 0; kt < 5; ++kt)
#pragma unroll
            for (int r = 0; r < 16; ++r) { const float p = __builtin_amdgcn_exp2f(S[kt][r] - m); S[kt][r] = p; l += p; }
        l += __shfl_xor(l, 32); l += __builtin_amdgcn_exp2f(sink2 - m);
        const float inv_l = 1.0f / l;
        f32x16 o0, o1;
#pragma unroll
        for (int r = 0; r < 16; ++r) { o0[r] = 0.f; o1[r] = 0.f; }
#pragma unroll
        for (int kt = 0; kt < 5; ++kt)
#pragma unroll
            for (int ks = 0; ks < 2; ++ks) { u32x4 pw; pw.x = pk2(S[kt][8 * ks + 0], S[kt][8 * ks + 1]); pw.y = pk2(S[kt][8 * ks + 2], S[kt][8 * ks + 3]); pw.z = pk2(S[kt][8 * ks + 4], S[kt][8 * ks + 5]); pw.w = pk2(S[kt][8 * ks + 6], S[kt][8 * ks + 7]);
                const bf16x8 pa = __builtin_bit_cast(bf16x8, pw);
                LAS unsigned char* vb = Vs + (lrow0 + 32 * kt + 16 * ks + 4 * hi + q16) * 128 + dblk * 32 + p16 * 8;
                const s16x4 a0 = vtr(vb), a1 = vtr(vb + 8 * 128), b0 = vtr(vb + 64), b1 = vtr(vb + 64 + 8 * 128);
                const bf16x8 v0 = __builtin_shufflevector(a0, a1, 0, 1, 2, 3, 4, 5, 6, 7), v1 = __builtin_shufflevector(b0, b1, 0, 1, 2, 3, 4, 5, 6, 7);
                o0 = MFMA32(pa, v0, o0); o1 = MFMA32(pa, v1, o1); __builtin_amdgcn_sched_barrier(0); }
#pragma unroll
        for (int r = 0; r < 16; ++r) { const int qr = (r & 3) + 8 * (r >> 2) + 4 * hi; ost[qr * 68 + r32] = o0[r]; ost[qr * 68 + 32 + r32] = o1[r]; }
        asm volatile("" ::: "memory");
        { const int row = lane >> 1, hf = lane & 1; const float sc = __shfl(inv_l, row);
          bf16* rp = P + (rowbase + qs + row) * LDP + head * 64 + hf * 32;
#pragma unroll
          for (int c = 0; c < 4; ++c) { const u32x4 gv = *(const u32x4*)(rp + C_AG + 8 * c);
              const f32x4 x0 = *(const LAS f32x4*)(ost + row * 68 + hf * 32 + 8 * c), x1 = *(const LAS f32x4*)(ost + row * 68 + hf * 32 + 8 * c + 4);
              float gg[8] = {bflo(gv.x), bfhi(gv.x), bflo(gv.y), bfhi(gv.y), bflo(gv.z), bfhi(gv.z), bflo(gv.w), bfhi(gv.w)};
              float xx[8] = {x0[0], x0[1], x0[2], x0[3], x1[0], x1[1], x1[2], x1[3]};
#pragma unroll
              for (int e = 0; e < 8; ++e) xx[e] = xx[e] * sc * gg[e] * sigmoidf_(gg[e]);
              u32x4 w; w.x = pk2(xx[0], xx[1]); w.y = pk2(xx[2], xx[3]); w.z = pk2(xx[4], xx[5]); w.w = pk2(xx[6], xx[7]);
              *(u32x4*)(rp + C_AQ + 8 * c) = w; } }
        asm volatile("" ::: "memory");
    }
    __syncthreads();
}
constexpr int GL_GLS = 78336;
constexpr int GL_QT = 0, GL_KT = 9216, GL_KH = 18432, GL_AT = 27648, GL_VT = 36864, GL_ST = 55296, GL_PART = 73728, GL_BL = 75776, GL_SS = 76032, GL_RS = 78080, GL_LD = 72;
__device__ __forceinline__ bf16x8 ldsfrag(LAS unsigned char* base, int row, int kof) { return *(const LAS bf16x8*)(base + (row * GL_LD + kof) * 2); }
template <bool OUT>
__device__ __forceinline__ void gla_item(LAS unsigned char* lds, bf16* P, const bf16* BLR, const bf16* WA, const float* balpha, const float* gnorm, float* GE, float* GD, int item, int tid, int wid, int lane) {
    const int c16 = lane & 15, q = lane >> 4;
    const int b = item >> 6, hd = (item >> 4) & 3, seg = item & 15;
    const size_t row0 = (size_t)b * SEQ + seg * 256;
    LAS bf16* QT = (LAS bf16*)(lds + GL_QT); LAS bf16* KT = (LAS bf16*)(lds + GL_KT); LAS bf16* AT = (LAS bf16*)(lds + GL_AT); LAS bf16* ST = (LAS bf16*)(lds + GL_ST);
    LAS float* PART = (LAS float*)(lds + GL_PART); LAS float* BL = (LAS float*)(lds + GL_BL); LAS float* SS = (LAS float*)(lds + GL_SS); LAS float* RS = (LAS float*)(lds + GL_RS);
    f32x4 S[4];
#pragma unroll
    for (int nt = 0; nt < 4; ++nt) S[nt] = (f32x4){0.f, 0.f, 0.f, 0.f};
    if (OUT) {
#pragma unroll 1
        for (int sp = 0; sp < seg; ++sp) { const float* e = GE + (size_t)(item - seg + sp) * 8192; const float* dd = GD + (size_t)(item - seg + sp) * 64;
#pragma unroll
            for (int nt = 0; nt < 4; ++nt) { const float dec = dd[16 * nt + c16];
#pragma unroll
                for (int r = 0; r < 4; ++r) S[nt][r] = S[nt][r] * dec + e[(16 * wid + 4 * q + r) * 64 + 16 * nt + c16]; } } }
    float dtot = 0.f;
    const int d = tid & 63, part = tid >> 6;
    const float ba = balpha[hd * 64 + d];
    LAS float* GLs = (LAS float*)(lds + GL_GLS);
    const int gmt = wid >> 1, gnt0 = 2 * (wid & 1);
    const bf16x8 zero8 = (bf16x8){0, 0, 0, 0, 0, 0, 0, 0};
    bf16x8 waf[2];
    if (!OUT) {
#pragma unroll
        for (int t = 0; t < 2; ++t) { const bf16x8 v = *(const bf16x8*)(WA + (size_t)(hd * 64 + 16 * (gnt0 + t) + c16) * 16 + 8 * (q & 1)); waf[t] = (q < 2) ? v : zero8; } }
#pragma unroll 1
    for (int ch = 0; ch < 4; ++ch) {
        const size_t rowc = row0 + ch * 64;
        if (!OUT) { const bf16x8 v = *(const bf16x8*)(BLR + (rowc + 16 * gmt + c16) * 16 + 8 * (q & 1)); const bf16x8 af = (q < 2) ? v : zero8;
#pragma unroll
            for (int t = 0; t < 2; ++t) { const f32x4 acc = MFMA16(af, waf[t], ((f32x4){0.f, 0.f, 0.f, 0.f}));
#pragma unroll
                for (int r = 0; r < 4; ++r) GLs[(16 * gmt + 4 * q + r) * 64 + 16 * (gnt0 + t) + c16] = acc[r]; }
            __syncthreads(); }
        float bcs[8]; float run = 0.f;
#pragma unroll
        for (int i = 0; i < 8; ++i) { bf16 glb; if (OUT) glb = P[(rowc + part * 8 + i) * LDP + C_GL + hd * 64 + d]; else { glb = f2bf(GLs[(part * 8 + i) * 64 + d]); P[(rowc + part * 8 + i) * LDP + C_GL + hd * 64 + d] = glb; }
            const float x = bf2f(glb) + ba;
            const float la = (fminf(x, 0.f) - __logf(1.0f + __expf(-fabsf(x)))) * 0.0625f; run += la; bcs[i] = run; }
        PART[part * 64 + d] = run;
        __syncthreads();
        float off = 0.f, tot = 0.f;
#pragma unroll
        for (int p = 0; p < 8; ++p) { const float v = PART[p * 64 + d]; tot += v; off += (p < part) ? v : 0.f; }
        if (part == 0) { BL[d] = tot; dtot += tot; }
        const float etot = __expf(tot);
        { float kh[8];
#pragma unroll
          for (int i = 0; i < 8; ++i) { const float bi = off + bcs[i]; const int tok = part * 8 + i; const float kx = bf2f(P[(rowc + tok) * LDP + C_BK + hd * 64 + d]);
              const float eb = __expf(bi), ieb = __builtin_amdgcn_rcpf(eb);
              if (OUT) { const float qx = bf2f(P[(rowc + tok) * LDP + C_BQ + hd * 64 + d]); QT[tok * GL_LD + d] = f2bf(qx * 0.125f * eb); KT[tok * GL_LD + d] = f2bf(kx * ieb); }
              kh[i] = kx * (etot * ieb); }
          u32x4 w; w.x = pk2(kh[0], kh[1]); w.y = pk2(kh[2], kh[3]); w.z = pk2(kh[4], kh[5]); w.w = pk2(kh[6], kh[7]);
          *(LAS u32x4*)(lds + GL_KH + (d * GL_LD + part * 8) * 2) = w; }
        { const int v = tid & 127, tp = tid >> 7; float vv[16];
#pragma unroll
          for (int i = 0; i < 16; ++i) vv[i] = bf2f(P[(rowc + tp * 16 + i) * LDP + C_BV + hd * 128 + v]);
          u32x4 w0, w1; w0.x = pk2(vv[0], vv[1]); w0.y = pk2(vv[2], vv[3]); w0.z = pk2(vv[4], vv[5]); w0.w = pk2(vv[6], vv[7]);
          w1.x = pk2(vv[8], vv[9]); w1.y = pk2(vv[10], vv[11]); w1.z = pk2(vv[12], vv[13]); w1.w = pk2(vv[14], vv[15]);
          *(LAS u32x4*)(lds + GL_VT + (v * GL_LD + tp * 16) * 2) = w0; *(LAS u32x4*)(lds + GL_VT + (v * GL_LD + tp * 16 + 8) * 2) = w1; }
        if (OUT) {
#pragma unroll
            for (int nt = 0; nt < 4; ++nt)
#pragma unroll
                for (int r = 0; r < 4; ++r) ST[(16 * wid + 4 * q + r) * GL_LD + 16 * nt + c16] = f2bf(S[nt][r]); }
        __syncthreads();
        if (OUT) {
            { const int mt = wid >> 1;
#pragma unroll
              for (int t = 0; t < 2; ++t) { const int nt = 2 * (wid & 1) + t; f32x4 acc = (f32x4){0.f, 0.f, 0.f, 0.f};
                  if (nt <= mt) {
#pragma unroll
                      for (int kk = 0; kk < 2; ++kk) acc = MFMA16(ldsfrag(lds + GL_QT, 16 * mt + c16, 32 * kk + 8 * q), ldsfrag(lds + GL_KT, 16 * nt + c16, 32 * kk + 8 * q), acc); }
#pragma unroll
                  for (int r = 0; r < 4; ++r) { const int i = 16 * mt + 4 * q + r, j = 16 * nt + c16; AT[i * GL_LD + j] = f2bf((j <= i) ? acc[r] : 0.f); } } }
            __syncthreads();
            f32x4 o[4];
#pragma unroll
            for (int mt = 0; mt < 4; ++mt) { f32x4 acc = (f32x4){0.f, 0.f, 0.f, 0.f};
#pragma unroll
                for (int kk = 0; kk < 2; ++kk) if (kk == 0 || mt >= 2) acc = MFMA16(ldsfrag(lds + GL_AT, 16 * mt + c16, 32 * kk + 8 * q), ldsfrag(lds + GL_VT, 16 * wid + c16, 32 * kk + 8 * q), acc);
#pragma unroll
                for (int kk = 0; kk < 2; ++kk) acc = MFMA16(ldsfrag(lds + GL_QT, 16 * mt + c16, 32 * kk + 8 * q), ldsfrag(lds + GL_ST, 16 * wid + c16, 32 * kk + 8 * q), acc);
                o[mt] = acc; }
#pragma unroll
            for (int mt = 0; mt < 4; ++mt)
#pragma unroll
                for (int r = 0; r < 4; ++r) { float s = o[mt][r] * o[mt][r]; s += __shfl_xor(s, 1); s += __shfl_xor(s, 2); s += __shfl_xor(s, 4); s += __shfl_xor(s, 8);
                    if (c16 == 0) SS[wid * 64 + 16 * mt + 4 * q + r] = s; }
            __syncthreads();
            if (tid < 64) { float t = 0.f;
#pragma unroll
                for (int w = 0; w < 8; ++w) t += SS[w * 64 + tid];
                RS[tid] = rsqrtf(t * (1.0f / 128.0f) + EPS); }
            __syncthreads();
            const float gn = gnorm[hd * 128 + 16 * wid + c16];
#pragma unroll
            for (int mt = 0; mt < 4; ++mt)
#pragma unroll
                for (int r = 0; r < 4; ++r) { const int i = 16 * mt + 4 * q + r; bf16* rp = P + (rowc + i) * LDP + hd * 128 + 16 * wid + c16; const float bg = bf2f(rp[C_BG]);
                    rp[C_BV] = f2bf(o[mt][r] * RS[i] * gn * bg * sigmoidf_(bg)); }
        }
#pragma unroll
        for (int nt = 0; nt < 4; ++nt) { const float dec = __expf(BL[16 * nt + c16]); f32x4 acc = S[nt] * dec;
#pragma unroll
            for (int kk = 0; kk < 2; ++kk) acc = MFMA16(ldsfrag(lds + GL_VT, 16 * wid + c16, 32 * kk + 8 * q), ldsfrag(lds + GL_KH, 16 * nt + c16, 32 * kk + 8 * q), acc);
            S[nt] = acc; }
        __syncthreads();
    }
    if (!OUT) {
#pragma unroll
        for (int nt = 0; nt < 4; ++nt)
#pragma unroll
            for (int r = 0; r < 4; ++r) GE[(size_t)item * 8192 + (16 * wid + 4 * q + r) * 64 + 16 * nt + c16] = S[nt][r];
        if (part == 0) GD[(size_t)item * 64 + d] = __expf(dtot);
    }
}
#ifndef PH_MASK
#define PH_MASK 0xffff
#endif
__device__ __forceinline__ void cmul_acc(float& hr, float& hi, float ar, float ai, float gr, float gi) { const float nr = ar * hr - ai * hi + gr, ni = ar * hi + ai * hr + gi; hr = nr; hi = ni; }
constexpr int S5_WB = 0, S5_CZ = 67584, S5_HS = 102400, S5_LDW = 264, S5_LDC = 136;
template <bool OUT>
__device__ __forceinline__ void s5_wg_item(LAS unsigned char* lds, bf16* P, const bf16* TzT, const bf16* BzT, const bf16* CzT, const float* tab, float* SE, int item, int tid, int wid, int lane) {
    const int c16 = lane & 15, q = lane >> 4;
    const int b = item >> 6, g = (item >> 1) & 31, seg = 8 * (item & 1) + wid;
    const int id = ((b * 32 + g) << 4) + seg;
    const size_t tok0 = (size_t)b * SEQ + seg * 256;
    LAS unsigned char* wscr = lds + S5_HS + wid * 4352;
    bf16x8 uf[8];
#pragma unroll
    for (int kk = 0; kk < 8; ++kk) uf[kk] = *(const bf16x8*)(P + (tok0 + 16 * c16 + 2 * kk + (q >> 1)) * LDP + C_CU + 16 * g + 8 * (q & 1));
    { const bf16* bz = BzT + (size_t)g * 32768; u32x4 t[8];
#pragma unroll
      for (int i = 0; i < 8; ++i) t[i] = *(const u32x4*)(bz + (size_t)(tid + 512 * i) * 8);
#pragma unroll
      for (int i = 0; i < 8; ++i) { const int pc = tid + 512 * i; *(LAS u32x4*)(lds + S5_WB + (pc >> 5) * (S5_LDW * 2) + (pc & 31) * 16) = t[i]; } }
    __syncthreads();
    f32x4 G[8];
#pragma unroll
    for (int nt = 0; nt < 8; ++nt) { f32x4 acc = (f32x4){0.f, 0.f, 0.f, 0.f};
#pragma unroll
        for (int kk = 0; kk < 8; ++kk) acc = MFMA16(uf[kk], *(const LAS bf16x8*)(lds + S5_WB + ((16 * nt + c16) * S5_LDW + 32 * kk + 8 * q) * 2), acc);
        G[nt] = acc; }
    const float* tg = tab + (size_t)g * 6 * 64;
    float a16r[4], a16i[4], a64r[4], a64i[4];
#pragma unroll
    for (int n4 = 0; n4 < 4; ++n4) { const int p = 16 * n4 + c16; a16r[n4] = tg[0 * 64 + p]; a16i[n4] = tg[1 * 64 + p]; a64r[n4] = tg[2 * 64 + p]; a64i[n4] = tg[3 * 64 + p]; }
    float er[4], ei[4], ir[4], ii[4], cr[4], ci[4];
#pragma unroll
    for (int n4 = 0; n4 < 4; ++n4) { float hr = 0.f, hi = 0.f;
#pragma unroll
        for (int r = 0; r < 4; ++r) cmul_acc(hr, hi, a16r[n4], a16i[n4], G[n4][r], G[n4 + 4][r]);
        er[n4] = hr; ei[n4] = hi; ir[n4] = hr; ii[n4] = hi; }
#pragma unroll
    for (int s = 1; s < 4; ++s)
#pragma unroll
        for (int n4 = 0; n4 < 4; ++n4) { const float vr = __shfl(ir[n4], (lane - 16) & 63), vi = __shfl(ii[n4], (lane - 16) & 63);
            if (q == s) { ir[n4] = a64r[n4] * vr - a64i[n4] * vi + er[n4]; ii[n4] = a64r[n4] * vi + a64i[n4] * vr + ei[n4]; } }
#pragma unroll
    for (int n4 = 0; n4 < 4; ++n4) { const float vr = __shfl(ir[n4], (lane - 16) & 63), vi = __shfl(ii[n4], (lane - 16) & 63); cr[n4] = (q > 0) ? vr : 0.f; ci[n4] = (q > 0) ? vi : 0.f; }
    if (!OUT) {
        if (q == 3) {
#pragma unroll
            for (int n4 = 0; n4 < 4; ++n4) { SE[(size_t)id * 128 + 16 * n4 + c16] = ir[n4]; SE[(size_t)id * 128 + 64 + 16 * n4 + c16] = ii[n4]; } }
        __syncthreads();
        return;
    }
    float hinr[4] = {0.f, 0.f, 0.f, 0.f}, hini[4] = {0.f, 0.f, 0.f, 0.f};
    { float a256r[4], a256i[4];
#pragma unroll
      for (int n4 = 0; n4 < 4; ++n4) { const int p = 16 * n4 + c16; a256r[n4] = tg[4 * 64 + p]; a256i[n4] = tg[5 * 64 + p]; }
#pragma unroll 1
      for (int s0 = 0; s0 < seg; s0 += 4) { float evr[4][4], evi[4][4];
#pragma unroll
          for (int u = 0; u < 4; ++u) { const int sp = (s0 + u < seg) ? s0 + u : seg - 1; const float* e = SE + (size_t)(id - seg + sp) * 128;
#pragma unroll
              for (int n4 = 0; n4 < 4; ++n4) { evr[u][n4] = e[16 * n4 + c16]; evi[u][n4] = e[64 + 16 * n4 + c16]; } }
#pragma unroll
          for (int u = 0; u < 4; ++u) if (s0 + u < seg) {
#pragma unroll
              for (int n4 = 0; n4 < 4; ++n4) cmul_acc(hinr[n4], hini[n4], a256r[n4], a256i[n4], evr[u][n4], evi[u][n4]); } } }
    LAS bf16* Hs = (LAS bf16*)wscr;
#pragma unroll
    for (int n4 = 0; n4 < 4; ++n4) {
        float pr = 1.f, pi = 0.f;
#pragma unroll
        for (int i = 0; i < 3; ++i) if (i < q) { const float nr = pr * a64r[n4] - pi * a64i[n4], ni = pr * a64i[n4] + pi * a64r[n4]; pr = nr; pi = ni; }
        float hr = pr * hinr[n4] - pi * hini[n4] + cr[n4], hi = pr * hini[n4] + pi * hinr[n4] + ci[n4];
#pragma unroll
        for (int r = 0; r < 4; ++r) { Hs[(4 * q + r) * 136 + 16 * n4 + c16] = f2bf(hr); Hs[(4 * q + r) * 136 + 64 + 16 * n4 + c16] = f2bf(hi);
            cmul_acc(hr, hi, a16r[n4], a16i[n4], G[n4][r], G[n4 + 4][r]); } }
    asm volatile("" ::: "memory");
    bf16x8 hf[4];
#pragma unroll
    for (int kk = 0; kk < 4; ++kk) hf[kk] = *(const LAS bf16x8*)(wscr + (c16 * 136 + 32 * kk + 8 * q) * 2);
    const bf16* tz = TzT + (size_t)g * 65536; const bf16* cz = CzT + (size_t)g * 32768;
    unsigned ypk[16][2];
#pragma unroll
    for (int hl = 0; hl < 2; ++hl) {
        __syncthreads();
        { u32x4 t[8], tc[4];
          if (hl == 0) {
#pragma unroll
              for (int i = 0; i < 4; ++i) { const int pc = tid + 512 * i; t[i] = *(const u32x4*)(tz + (size_t)(pc >> 4) * 256 + (pc & 15) * 8); }
          } else {
#pragma unroll
              for (int i = 0; i < 8; ++i) { const int pc = tid + 512 * i; t[i] = *(const u32x4*)(tz + (size_t)(128 + (pc >> 5)) * 256 + (pc & 31) * 8); } }
#pragma unroll
          for (int i = 0; i < 4; ++i) { const int pc = tid + 512 * i; tc[i] = *(const u32x4*)(cz + (size_t)(128 * hl + (pc >> 4)) * 128 + (pc & 15) * 8); }
          if (hl == 0) {
#pragma unroll
              for (int i = 0; i < 4; ++i) { const int pc = tid + 512 * i; *(LAS u32x4*)(lds + S5_WB + (pc >> 4) * (S5_LDW * 2) + (pc & 15) * 16) = t[i]; }
          } else {
#pragma unroll
              for (int i = 0; i < 8; ++i) { const int pc = tid + 512 * i; *(LAS u32x4*)(lds + S5_WB + (pc >> 5) * (S5_LDW * 2) + (pc & 31) * 16) = t[i]; } }
#pragma unroll
          for (int i = 0; i < 4; ++i) { const int pc = tid + 512 * i; *(LAS u32x4*)(lds + S5_CZ + (pc >> 4) * (S5_LDC * 2) + (pc & 15) * 16) = tc[i]; } }
        __syncthreads();
#pragma unroll
        for (int n8 = 0; n8 < 8; ++n8) { const int nt = 8 * hl + n8; f32x4 acc = (f32x4){0.f, 0.f, 0.f, 0.f};
#pragma unroll
            for (int kk = 0; kk < 8; ++kk) if (kk <= (nt >> 1)) acc = MFMA16(uf[kk], *(const LAS bf16x8*)(lds + S5_WB + ((16 * n8 + c16) * S5_LDW + 32 * kk + 8 * q) * 2), acc);
#pragma unroll
            for (int kk = 0; kk < 4; ++kk) acc = MFMA16(hf[kk], *(const LAS bf16x8*)(lds + S5_CZ + ((16 * n8 + c16) * S5_LDC + 32 * kk + 8 * q) * 2), acc);
            float yv[4];
#pragma unroll
            for (int r = 0; r < 4; ++r) { const float y = acc[r], u2 = 1.5957691216057308f * (y + 0.044715f * y * y * y); yv[r] = y * sigmoidf_(u2); }
            ypk[nt][0] = pk2(yv[0], yv[1]); ypk[nt][1] = pk2(yv[2], yv[3]); }
    }
    __syncthreads();
    LAS bf16* Ys = (LAS bf16*)(lds + S5_WB + wid * 8192);
#pragma unroll
    for (int nt = 0; nt < 16; ++nt)
#pragma unroll
        for (int r = 0; r < 4; ++r) Ys[(16 * (4 * q + r) + nt) * 16 + c16] = (bf16)((r & 1) ? (ypk[nt][r >> 1] >> 16) : (ypk[nt][r >> 1] & 0xffffu));
    asm volatile("" ::: "memory");
#pragma unroll
    for (int i = 0; i < 8; ++i) { const int pc = lane + 64 * i, tk = pc >> 1, hf2 = pc & 1;
        *(u32x4*)(P + (tok0 + tk) * LDP + C_CU + 16 * g + 8 * hf2) = *(const LAS u32x4*)(lds + S5_WB + wid * 8192 + pc * 16); }
    __syncthreads();
}

template <bool SECOND>
#ifndef PROBE_TYPE
#define PROBE_TYPE -1
#endif
#define PBX(t) do { if ((t) == PROBE_TYPE) px_t0 = __builtin_amdgcn_s_memrealtime(); } while (0)
#define PEX(t) do { if ((t) == PROBE_TYPE) pacc += __builtin_amdgcn_s_memrealtime() - px_t0; } while (0)
__device__ __forceinline__ void mixers_phase(LAS unsigned char* lds, const float* const* in, unsigned char* ws, bf16* P, int l, int vcu, int G, int tid, int wid, int lane, unsigned long long& pacc) {
    unsigned long long px_t0 = 0; (void)px_t0;
    PBX(10); if (!SECOND && (PH_MASK & 0x100)) for (int it = vcu; it < 256; it += G) attn_item(lds, P, in[7] + l * 16, it, tid, wid, lane);
    PEX(10);
    float* GE = (float*)(ws + WS_GLAE); float* GD = (float*)(ws + WS_GLAD); float* SE = (float*)(ws + WS_S5E);
    const float* balpha = in[9] + l * 256; const float* gnorm = in[10] + l * 512;
    int tid1 = tid; asm volatile("" : "+v"(tid1));
    PBX(SECOND ? 13 : 11); if (PH_MASK & 0x200) for (int it = vcu; it < 256; it += G) gla_item<SECOND>(lds, P, (const bf16*)(ws + WS_BLR), (const bf16*)(ws + WS_WA) + (size_t)l * 256 * 16, balpha, gnorm, GE, GD, it, tid1, wid, tid1 & 63);
    PEX(SECOND ? 13 : 11);
    const bf16* TzT = (const bf16*)(ws + WS_S5M + (size_t)l * S5M_BYTES + S5M_TZ); const bf16* BzT = (const bf16*)(ws + WS_S5M + (size_t)l * S5M_BYTES + S5M_BZ);
    const bf16* CzT = (const bf16*)(ws + WS_S5M + (size_t)l * S5M_BYTES + S5M_CZ); const float* tab = (const float*)(ws + WS_TAB) + (size_t)l * 32 * 6 * 64;
    int tid2 = tid; asm volatile("" : "+v"(tid2));
    PBX(SECOND ? 14 : 12); if (PH_MASK & 0x400) for (int it = vcu; it < 256; it += G) s5_wg_item<SECOND>(lds, P, TzT, BzT, CzT, tab, SE, it, tid2, wid, tid2 & 63);
    PEX(SECOND ? 14 : 12);
}
#ifndef MK_MULTI
#define MK_MULTI 0
#endif
constexpr int N_PHASES = 2 + 6 * NLAYER;
struct Args { const float* in[22]; float* out; unsigned char* ws; int ph_lo, ph_hi; };
__global__ void __launch_bounds__(NWAVES * 64, 2) hybrid_fwd(Args args_) {
    extern __shared__ __attribute__((aligned(16))) unsigned char lds_raw[];
    const int G = gridDim.x; const int bx = blockIdx.x; const int vcu = (G % 8 == 0) ? (bx % 8) * (G / 8) + bx / 8 : bx;
    XcdBarrier bar;
    { LAS unsigned char* lds0 = (LAS unsigned char*)lds_raw;
      volatile LAS unsigned* MISC = (volatile LAS unsigned*)(lds0 + MISC_OFF);
      for (int u = threadIdx.x; u < (LDS_BYTES - LDSCTL_OFF) / 4; u += NWAVES * 64) ((LAS unsigned*)(lds0 + LDSCTL_OFF))[u] = 0u;
      __syncthreads();
      bar.bar = (unsigned*)(args_.ws + WS_CTL) + CW_BAR; bar.x = 0; bar.st = nullptr;
      if (!MK_MULTI) bar = xcd_barrier_post((unsigned*)(args_.ws + WS_CTL) + CW_BAR, MISC + 8); }
    const int lo = args_.ph_lo, hi = args_.ph_hi;
#ifndef PROBE_TYPE
#define PROBE_TYPE -1
#endif
#ifndef PROBE_K
#define PROBE_K 4
#endif
#ifndef PROBE_BLOCK
#define PROBE_BLOCK 0
#endif
    unsigned long long pr_acc = 0, pr_t0 = 0; (void)pr_t0;
#define PB(t) do { if ((t) == PROBE_TYPE) pr_t0 = __builtin_amdgcn_s_memrealtime(); } while (0)
#define PE(t) do { if ((t) == PROBE_TYPE) pr_acc += __builtin_amdgcn_s_memrealtime() - pr_t0; } while (0)
#define IN(k) (lo <= (k) && (k) < hi)
#if MK_MULTI
#define SEAM(k) do { } while (0)
#else
#define SEAM(k) do { if (IN(k) && IN((k) + 1)) xcd_barrier(bar); } while (0)
#endif
#define PHASE_IDS typedef const Args __attribute__((address_space(4)))* kargp_t; kargp_t ap = (kargp_t)__builtin_amdgcn_kernarg_segment_ptr(); asm volatile("" : "+s"(ap)); const Args& args = *(const Args*)ap; \
        int tid = threadIdx.x; asm volatile("" : "+v"(tid)); const int lane = tid & 63, wid = __builtin_amdgcn_readfirstlane(tid >> 6); (void)lane; (void)wid; \
        LAS unsigned char* lds = (LAS unsigned char*)lds_raw; asm volatile("" : "+s"(lds)); unsigned char* ws = args.ws; \
        bf16* const P = (bf16*)(ws + WS_P); bf16* const H = (bf16*)(ws + WS_H); float* const MOD = (float*)(ws + WS_MOD); (void)P; (void)H; (void)MOD;
#ifndef PH_MASK
#define PH_MASK 0xffff
#endif
    PB(0); if (IN(0) && (PH_MASK & 1)) { PHASE_IDS p0_mod_phase(lds, args.in, ws, vcu, G, tid, wid, lane); }
    SEAM(0); PE(0);
    PB(1); if (IN(1) && (PH_MASK & 2)) { PHASE_IDS
        if (G == 256) { if (vcu < 64) { PB(20); p0_s5_item(lds, args.in, ws, vcu >> 5, vcu & 31, tid); PE(20); }
                        else { const int gw = (vcu - 64) * NWAVES + wid; PB(21); p1_transposes(lds, args.in, ws, gw, 192 * NWAVES, wid, lane, 0, NLAYER * TR_IL); __syncthreads(); PE(21); PB(25); prenorm_phase(args.in[0], MOD, H, gw, 192 * NWAVES, lane); __syncthreads(); PE(25); } }
        else { for (int it = vcu; it < 64; it += G) p0_s5_item(lds, args.in, ws, it >> 5, it & 31, tid);
               const int gw = vcu * NWAVES + wid; p1_transposes(lds, args.in, ws, gw, G * NWAVES, wid, lane, 0, NLAYER * TR_IL); prenorm_phase(args.in[0], MOD, H, gw, G * NWAVES, lane); } }
    SEAM(1); PE(1);
#define LAYER(l, base) \
    PB(2); if (IN(base + 0) && (PH_MASK & 4)) { PHASE_IDS \
        pg8::Gemm g{H, (const bf16*)(ws + WS_WIN + (size_t)l * WIN_BYTES), TOK, NP, DM, DM}; pg8::StaticOrder S; S.init(TOK, NP, G, bx); \
        pg8::EpiBf16<0> E{P, LDP, nullptr, 1024, 1024, 0.125f * LOG2E};        \
        PB(40); for (int wg_ = bx; wg_ < TOK / 64; wg_ += G) blr_head(lds, H, (const bf16*)(ws + WS_WLR) + (size_t)l * 16 * 1024, (bf16*)(ws + WS_BLR), wg_, tid, wid, lane); PE(40); \
        pg8::gemm_phase<pg8::EpiBf16<0>, pg8::StaticOrder, true, true>(lds, g, S, E, tid); } \
    SEAM(base + 0); PE(2); \
    PB(3); if (IN(base + 1) && (PH_MASK & 8)) { PHASE_IDS mixers_phase<false>(lds, args.in, ws, P, l, vcu, G, tid, wid, lane, pr_acc); } \
    SEAM(base + 1); PE(3); \
    PB(4); if (IN(base + 2) && (PH_MASK & 8)) { PHASE_IDS mixers_phase<true>(lds, args.in, ws, P, l, vcu, G, tid, wid, lane, pr_acc); } \
    SEAM(base + 2); PE(4); \
    PB(5); if (IN(base + 3) && (PH_MASK & 16)) { PHASE_IDS \
        pg8::Gemm g{P + C_CU, (const bf16*)(ws + WS_WGLU + (size_t)l * WGLU_BYTES), TOK, 512, 512, LDP}; pg8::StaticOrder S; S.init(TOK, 512, G, bx); \
        pg8::EpiGlu E{P, LDP, C_CU, C_CG, args.in[20] + l * 512}; \
        PB(15); if (PH_MASK & 0x800) pg8::gemm_phase<pg8::EpiGlu, pg8::StaticOrder, true, true>(lds, g, S, E, tid); PE(15); PB(16); \
        if (!(PH_MASK & 0x1000)) {} else if (G == 256) { if (bx >= 128) { attn_item(lds, P, args.in[7] + l * 16, 256 + 2 * (bx - 128), tid, wid, lane); attn_item(lds, P, args.in[7] + l * 16, 257 + 2 * (bx - 128), tid, wid, lane); } } \
        else for (int it = 256 + vcu; it < 512; it += G) attn_item(lds, P, args.in[7] + l * 16, it, tid, wid, lane); PE(16); } \
    SEAM(base + 3); PE(5); \
    PB(6); if (IN(base + 4) && (PH_MASK & 32)) { PHASE_IDS \
        pg8::Gemm g{P, (const bf16*)(ws + WS_WOUT + (size_t)l * WOUT_BYTES), TOK, DM, 2048, LDP}; pg8::StaticOrder S; S.init(TOK, DM, G, bx); \
        pg8::EpiBf16<0> E{H, DM, nullptr, 0, 0, 1.f}; \
        pg8::gemm_phase<pg8::EpiBf16<0>, pg8::StaticOrder, true, true>(lds, g, S, E, tid); } \
    SEAM(base + 4); PE(6); \
    PB(7); if (IN(base + 5) && (PH_MASK & 64)) { PHASE_IDS \
        post_phase(l == 0 ? args.in[0] : args.out, args.out, H, args.in[5] + l * DM, MOD + (size_t)l * 4 * 3072, (l + 1 < NLAYER), args.in[4] + (l + 1 < NLAYER ? l + 1 : l) * DM, MOD + (size_t)(l + 1 < NLAYER ? l + 1 : l) * 4 * 3072, H, vcu, wid, lane); } \
    SEAM(base + 5); PE(7);
    LAYER(0, 2)
    LAYER(1, 8)
#undef LAYER
    if (PROBE_TYPE >= 0 && blockIdx.x == PROBE_BLOCK) { const unsigned long long te = __builtin_amdgcn_s_memrealtime(); while (__builtin_amdgcn_s_memrealtime() - te < (unsigned long long)PROBE_K * pr_acc) __builtin_amdgcn_s_sleep(20); }
#undef IN
#undef SEAM
}

extern "C" void kernel_launch(void* const* d_in, const int* in_sizes, int n_in, void* d_out, int out_size, void* d_ws, size_t ws_size, hipStream_t stream) {
    static int grid = 0;
    if (grid == 0) {
        if (n_in != 22 || in_sizes[0] != TOK * DM || out_size != TOK * DM || ws_size < WS_END) { fprintf(stderr, "kernel_launch: unexpected shapes (n_in %d, in0 %d, out %d, ws %zu)\n", n_in, n_in > 0 ? in_sizes[0] : -1, out_size, ws_size); grid = -1; return; }
        int dev = 0, cus = 0;
        if (hipGetDevice(&dev) != hipSuccess || hipDeviceGetAttribute(&cus, hipDeviceAttributeMultiprocessorCount, dev) != hipSuccess) { grid = -1; return; }
        if (hipFuncSetAttribute((const void*)hybrid_fwd, hipFuncAttributeMaxDynamicSharedMemorySize, LDS_BYTES) != hipSuccess) { fprintf(stderr, "kernel_launch: hipFuncSetAttribute failed\n"); grid = -1; return; }
        (void)hipGetLastError();
        grid = cus;
    }
    if (grid < 0) return;
    if (hipMemsetAsync((char*)d_ws + WS_CTL, 0, CTL_ZERO_BYTES, stream) != hipSuccess) { fprintf(stderr, "kernel_launch: memset failed\n"); return; }
    Args a{};
    for (int i = 0; i < 22; ++i) a.in[i] = (const float*)d_in[i];
    a.out = (float*)d_out; a.ws = (unsigned char*)d_ws;
#if MK_MULTI
    for (int ph = 0; ph < N_PHASES; ++ph) { a.ph_lo = ph; a.ph_hi = ph + 1; hipLaunchKernelGGL(hybrid_fwd, dim3(grid), dim3(NWAVES * 64), LDS_BYTES, stream, a); }
#else
    a.ph_lo = 0; a.ph_hi = N_PHASES;
    hipLaunchKernelGGL(hybrid_fwd, dim3(grid), dim3(NWAVES * 64), LDS_BYTES, stream, a);
#endif
    const hipError_t le = hipPeekAtLastError();
    if (le != hipSuccess) fprintf(stderr, "kernel_launch: launch failed: %s\n", hipGetErrorName(le));
}
```

```cpp
#include <hip/hip_runtime.h>
#include <cstdio>
#include <cstdint>
#include <cmath>
#define MK_MULTI 0
namespace pg8 {
#define PG8_LAS __attribute__((address_space(3)))
typedef unsigned short bf16_t;
typedef short bf16x8 __attribute__((ext_vector_type(8)));
typedef float f32x4 __attribute__((ext_vector_type(4)));
typedef unsigned u32x4 __attribute__((ext_vector_type(4)));
constexpr int BM = 256, BK = 64, HALF = 128, HTB = HALF * BK * 2  , STAGE_BYTES = 8 * HTB, NXCD = 8, WGM = 8;

__host__ __device__ __forceinline__ int lds_byte(int r, int c) { const int st = (r >> 4) * 2 + (c >> 5), rr = r & 15, cc = c & 31, ob = rr * 64 + cc * 2; return st * 1024 + (ob ^ (((ob >> 9) & 1) << 5)); }
__host__ __device__ __forceinline__ void stage_rc(int b, int& R, int& C) { const int st = b / 1024, sb = b % 1024, swz = sb ^ (((sb >> 9) & 1) << 5); R = (st >> 1) * 16 + swz / 64; C = (st & 1) * 32 + (swz % 64) / 2; }
__host__ __device__ __forceinline__ int perm32(int rho) { const int n = rho >> 4, i = rho & 15; return 8 * (i >> 2) + 4 * n + (i & 3); }

struct Unit { int pm, pn; };
struct Gemm { const bf16_t* A; const bf16_t* Bt; int M, N, K, lda; };

struct StaticOrder {
    int nM, nN, nwg, G, c;
    __host__ __device__ void init(int M, int N, int G_, int c_) { nM = M / BM; nN = N / BM; nwg = nM * nN; G = G_; c = c_; }
    __host__ __device__ bool next(int i, Unit& u) const {
        const long L = (long)i * G + c; if (L >= nwg) return false;
        int wgid = (int)L; { const int q = nwg / NXCD, r = nwg % NXCD, xcd = wgid % NXCD, off = wgid / NXCD; wgid = (xcd < r ? xcd * (q + 1) : r * (q + 1) + (xcd - r) * q) + off; }
        const int nig = WGM * nN, gid = wgid / nig, fm = gid * WGM, gsz = (nM - fm) < WGM ? (nM - fm) : WGM;
        u.pm = fm + ((wgid % nig) % gsz); u.pn = (wgid % nig) / gsz; return true;
    }
    __device__ __forceinline__ void a_ready(const Unit&) const {}
    __device__ __forceinline__ void done(const Unit&) const {}
};

__device__ __forceinline__ unsigned cvt_pk_bf16(float lo, float hi) { unsigned r; asm volatile("v_cvt_pk_bf16_f32 %0, %1, %2" : "=v"(r) : "v"(lo), "v"(hi)); return r; }
typedef float f32x2 __attribute__((ext_vector_type(2)));
__device__ __forceinline__ f32x2 gelu_pk(f32x2 v) {
    const f32x2 av = __builtin_elementwise_abs(v), d = av * 0.2316418882f + 1.0f;
    f32x2 t; t.x = __builtin_amdgcn_rcpf(d.x); t.y = __builtin_amdgcn_rcpf(d.y);
    f32x2 q = t * 0.5307027145f + (-0.7265760135f); q = q * t + 0.7107068705f; q = q * t + (-0.142248368f); q = q * t + 0.127414796f; q = q * t;
    const f32x2 s = (v * v) * (-0.72134752044f);
    f32x2 e; e.x = __builtin_amdgcn_exp2f(s.x); e.y = __builtin_amdgcn_exp2f(s.y);
    const f32x2 m = v * (q * e), r = v - m;
    f32x2 o; o.x = v.x < 0.f ? m.x : r.x; o.y = v.y < 0.f ? m.y : r.y; return o;
}

template <int ACT  > struct EpiBf16 {
    static constexpr bool PERM = true, AFTER_DRAIN = false; static_assert(ACT == 0 || ACT == 1, "EpiBf16: ACT is 0 (none) or 1 (gelu_pk)");
    bf16_t* O; int ldc; const float* bias; int split_cols; size_t split_stride; float scale0;
    __device__ __forceinline__ void operator()(const f32x4 (&acc)[2][2][4][2], const Unit& u, int wr, int wc, int fr, int fq) const {
        const int row0 = u.pm * BM + wr * 64 + fr; int colt = u.pn * BM; bf16_t* base = O;
        float sc = 1.f; if (split_cols) { const int t = colt / split_cols; base += (size_t)t * split_stride; colt -= t * split_cols; if (t == 0) sc = scale0; }
        const int col0 = colt + wc * 32 + 8 * fq, bcol0 = u.pn * BM + wc * 32 + 8 * fq;
        f32x4 bv[2][2];
#pragma unroll
        for (int bj = 0; bj < 2; ++bj)
#pragma unroll
            for (int n = 0; n < 2; ++n) bv[bj][n] = bias ? *(const f32x4*)(bias + bcol0 + bj * HALF + 4 * n) : (f32x4){0.f, 0.f, 0.f, 0.f};
#pragma unroll
        for (int ai = 0; ai < 2; ++ai)
#pragma unroll
            for (int m = 0; m < 4; ++m) { bf16_t* rowp = base + (size_t)(row0 + ai * HALF + m * 16) * ldc + col0;
#pragma unroll
                for (int bj = 0; bj < 2; ++bj) { f32x4 v0 = acc[ai][bj][m][0] + bv[bj][0], v1 = acc[ai][bj][m][1] + bv[bj][1];
                    if (ACT == 1) { f32x2 a = gelu_pk((f32x2){v0[0], v0[1]}), b = gelu_pk((f32x2){v0[2], v0[3]}), c = gelu_pk((f32x2){v1[0], v1[1]}), d = gelu_pk((f32x2){v1[2], v1[3]});
                        v0 = (f32x4){a.x, a.y, b.x, b.y}; v1 = (f32x4){c.x, c.y, d.x, d.y}; }
                    v0 = v0 * sc; v1 = v1 * sc; u32x4 w; w.x = cvt_pk_bf16(v0[0], v0[1]); w.y = cvt_pk_bf16(v0[2], v0[3]); w.z = cvt_pk_bf16(v1[0], v1[1]); w.w = cvt_pk_bf16(v1[2], v1[3]);
                    *(u32x4*)(rowp + bj * HALF) = w; } }
    }
};
struct EpiGlu {
    static constexpr bool PERM = true, AFTER_DRAIN = false;
    bf16_t* P; int ldp, col_y, col_g; const float* bglu;
    __device__ __forceinline__ void operator()(const f32x4 (&acc)[2][2][4][2], const Unit& u, int wr, int wc, int fr, int fq) const {
        const int row0 = u.pm * BM + wr * 64 + fr; const int col0 = u.pn * BM + wc * 32 + 8 * fq;
#pragma unroll
        for (int ai = 0; ai < 2; ++ai)
#pragma unroll
            for (int m = 0; m < 4; ++m) { bf16_t* rowp = P + (size_t)(row0 + ai * HALF + m * 16) * ldp;
#pragma unroll
                for (int bj = 0; bj < 2; ++bj) { const int col = col0 + bj * HALF;
                    const f32x4 b0 = *(const f32x4*)(bglu + col), b1 = *(const f32x4*)(bglu + col + 4);
                    const u32x4 yv = *(const u32x4*)(rowp + col_y + col), gv = *(const u32x4*)(rowp + col_g + col);
                    const f32x4 z0 = acc[ai][bj][m][0] + b0, z1 = acc[ai][bj][m][1] + b1;
                    float z[8] = {z0[0], z0[1], z0[2], z0[3], z1[0], z1[1], z1[2], z1[3]}; float o[8];
#pragma unroll
                    for (int e = 0; e < 8; ++e) { const unsigned yw = yv[e >> 1], gw = gv[e >> 1];
                        const float y = __uint_as_float((e & 1) ? (yw & 0xffff0000u) : (yw << 16)), g = __uint_as_float((e & 1) ? (gw & 0xffff0000u) : (gw << 16));
                        const float sz = __builtin_amdgcn_rcpf(1.0f + __expf(-z[e])), sg = __builtin_amdgcn_rcpf(1.0f + __expf(-g));
                        o[e] = y * sz * g * sg; }
                    u32x4 w; w.x = cvt_pk_bf16(o[0], o[1]); w.y = cvt_pk_bf16(o[2], o[3]); w.z = cvt_pk_bf16(o[4], o[5]); w.w = cvt_pk_bf16(o[6], o[7]);
                    *(u32x4*)(rowp + col_g + col) = w; } }
    }
};
template <class Epi, class Sched, bool ALIGN_EPI = false, bool SP2 = false>
__device__ __forceinline__ void gemm_phase(PG8_LAS unsigned char* lds, const Gemm g, const Sched& S, const Epi& E, int tid_in) {
    const int tid = tid_in, wid = __builtin_amdgcn_readfirstlane(tid >> 6), lane = tid & 63, wr = wid >> 2, wc = wid & 3, fr = lane & 15, fq = lane >> 4;
    const int K = g.K, nt = K / BK;
    unsigned voffA[2], voffB[2];
#pragma unroll
    for (int i = 0; i < 2; ++i) { int R, C; stage_rc(tid * 16 + i * 8192, R, C); const int Rb = Epi::PERM ? ((R & ~31) + perm32(R & 31)) : R;
        voffA[i] = (unsigned)(R * g.lda + C) * 2u; voffB[i] = (unsigned)(Rb * K + C) * 2u; }
    const size_t kstep = (size_t)(BK * 2);
    const size_t hstepB = (size_t)HALF * K * 2, hstepA = (size_t)HALF * g.lda * 2;
    const size_t tstepB = 2 * hstepB, tstepA = 2 * hstepA;
    const unsigned ldsw = (unsigned)wid * 1024u;
    const int aoff = lds_byte(wr * 64 + fr, fq * 8), boff = lds_byte(wc * 32 + fr, fq * 8);
#define PG8_SA(b, h) (((b) * 2 + (h)) * HTB)
#define PG8_SB(b, h) ((4 + (b) * 2 + (h)) * HTB)
#define PG8_STAGE(bufoff, gbase, voff) do { _Pragma("unroll") for (int _i = 0; _i < 2; ++_i) \
        __builtin_amdgcn_global_load_lds((const unsigned*)((const char*)(gbase) + (voff)[_i]), (PG8_LAS unsigned*)(lds + (bufoff) + ldsw + _i * 8192), 16, 0, 0); } while (0)
#define PG8_LDA(dst, b, h) do { _Pragma("unroll") for (int m = 0; m < 4; ++m) _Pragma("unroll") for (int k = 0; k < 2; ++k) dst[m][k] = *(const PG8_LAS bf16x8*)(lds + PG8_SA(b, h) + aoff + m * 2048 + k * 1024); } while (0)
#define PG8_LDB(dst, b, h) do { _Pragma("unroll") for (int n = 0; n < 2; ++n) _Pragma("unroll") for (int k = 0; k < 2; ++k) dst[n][k] = *(const PG8_LAS bf16x8*)(lds + PG8_SB(b, h) + boff + n * 2048 + k * 1024); } while (0)
#define PG8_MMA(ai, bj, At, Bt) do { __builtin_amdgcn_s_setprio(1); _Pragma("unroll") for (int m = 0; m < 4; ++m) _Pragma("unroll") for (int n = 0; n < 2; ++n) _Pragma("unroll") for (int k = 0; k < 2; ++k) \
        acc[ai][bj][m][n] = __builtin_amdgcn_mfma_f32_16x16x32_bf16(Bt[n][k], At[m][k], acc[ai][bj][m][n], 0, 0, 0); __builtin_amdgcn_s_setprio(0); } while (0)
#define PG8_WAIT_V(n) asm volatile("s_waitcnt vmcnt(" #n ")" ::: "memory")
#define PG8_WAIT_L(n) asm volatile("s_waitcnt lgkmcnt(" #n ")" ::: "memory")
#define PG8_BAR __builtin_amdgcn_s_barrier()
#define PG8_SCHED __builtin_amdgcn_sched_barrier(0)
    Unit cur, nxt; int ui = 0;
    if (!S.next(0, cur)) return;
    f32x4 acc[2][2][4][2];
#pragma unroll
    for (int a = 0; a < 2; ++a)
#pragma unroll
        for (int b = 0; b < 2; ++b)
#pragma unroll
            for (int m = 0; m < 4; ++m)
#pragma unroll
                for (int n = 0; n < 2; ++n) acc[a][b][m][n] = (f32x4){0.f, 0.f, 0.f, 0.f};
    bf16x8 At[4][2], B0[2][2], B1[2][2];
    const char* cA = (const char*)g.A + (size_t)cur.pm * tstepA; const char* cB = (const char*)g.Bt + (size_t)cur.pn * tstepB;
    S.a_ready(cur);
    if constexpr (SP2) {
        PG8_STAGE(PG8_SB(0, 0), cB, voffB); PG8_STAGE(PG8_SB(0, 1), cB + hstepB, voffB); PG8_STAGE(PG8_SA(0, 0), cA, voffA); PG8_STAGE(PG8_SA(0, 1), cA + hstepA, voffA);
        if (wr == 1) PG8_BAR;
        PG8_WAIT_V(2); PG8_BAR;
        PG8_STAGE(PG8_SB(1, 0), cB + kstep, voffB); PG8_STAGE(PG8_SA(1, 0), cA + kstep, voffA); PG8_STAGE(PG8_SB(1, 1), cB + hstepB + kstep, voffB);
        PG8_WAIT_V(6); PG8_BAR;
    } else {
        PG8_STAGE(PG8_SB(0, 0), cB, voffB); PG8_STAGE(PG8_SA(0, 0), cA, voffA); PG8_STAGE(PG8_SB(0, 1), cB + hstepB, voffB); PG8_STAGE(PG8_SA(0, 1), cA + hstepA, voffA);
        if (wr == 1) PG8_BAR;
        PG8_WAIT_V(4); PG8_BAR;
        PG8_STAGE(PG8_SB(1, 0), cB + kstep, voffB); PG8_STAGE(PG8_SA(1, 0), cA + kstep, voffA); PG8_STAGE(PG8_SB(1, 1), cB + hstepB + kstep, voffB);
        PG8_WAIT_V(6); PG8_BAR;
    }
    for (;;) {
        const bool has_next = S.next(ui + 1, nxt);
        const char* nA = has_next ? (const char*)g.A + (size_t)nxt.pm * tstepA : cA; const char* nB = has_next ? (const char*)g.Bt + (size_t)nxt.pn * tstepB : cB;
        for (int t = 0; t < nt; t += 2) {
            const bool last = (t == nt - 2);
            const char* a1 = cA + (size_t)(t + 1) * kstep;
            const char* a2 = last ? nA : cA + (size_t)(t + 2) * kstep; const char* b2 = last ? nB : cB + (size_t)(t + 2) * kstep;
            const char* a3 = a2 + kstep; const char* b3 = b2 + kstep;
            if (last && has_next) S.a_ready(nxt);
            if constexpr (SP2) {
            PG8_LDB(B0, 0, 0); PG8_LDB(B1, 0, 1); PG8_SCHED; PG8_LDA(At, 0, 0); PG8_STAGE(PG8_SA(1, 1), a1 + hstepA, voffA);
            PG8_WAIT_V(8); PG8_WAIT_L(0); PG8_BAR; PG8_MMA(0, 0, At, B0); PG8_MMA(0, 1, At, B1); PG8_BAR; PG8_SCHED;
            PG8_LDA(At, 0, 1); PG8_STAGE(PG8_SB(0, 0), b2, voffB); PG8_STAGE(PG8_SB(0, 1), b2 + hstepB, voffB); PG8_STAGE(PG8_SA(0, 0), a2, voffA);
            PG8_WAIT_V(8); PG8_WAIT_L(0); PG8_BAR; PG8_MMA(1, 0, At, B0); PG8_MMA(1, 1, At, B1); PG8_BAR; PG8_SCHED;
            PG8_LDB(B0, 1, 0); PG8_LDB(B1, 1, 1); PG8_SCHED; PG8_LDA(At, 1, 0); PG8_STAGE(PG8_SA(0, 1), a2 + hstepA, voffA);
            PG8_WAIT_V(8); PG8_WAIT_L(0); PG8_BAR; PG8_MMA(0, 0, At, B0); PG8_MMA(0, 1, At, B1); PG8_BAR; PG8_SCHED;
            PG8_LDA(At, 1, 1); PG8_STAGE(PG8_SB(1, 0), b3, voffB); PG8_STAGE(PG8_SB(1, 1), b3 + hstepB, voffB); PG8_STAGE(PG8_SA(1, 0), a3, voffA);
            PG8_WAIT_V(8); PG8_WAIT_L(0); PG8_BAR; PG8_MMA(1, 0, At, B0); PG8_MMA(1, 1, At, B1); PG8_BAR; PG8_SCHED;
            } else {
            PG8_LDB(B0, 0, 0); PG8_SCHED; PG8_LDA(At, 0, 0); PG8_STAGE(PG8_SA(1, 1), a1 + hstepA, voffA);
            PG8_WAIT_L(8); PG8_BAR; PG8_WAIT_L(0); PG8_MMA(0, 0, At, B0); PG8_BAR; PG8_SCHED;
            PG8_LDB(B1, 0, 1); PG8_STAGE(PG8_SB(0, 0), b2, voffB);
            PG8_BAR; PG8_WAIT_L(0); PG8_MMA(0, 1, At, B1); PG8_BAR;
            PG8_LDA(At, 0, 1); PG8_STAGE(PG8_SA(0, 0), a2, voffA);
            PG8_BAR; PG8_WAIT_L(0); PG8_MMA(1, 0, At, B0); PG8_BAR; PG8_SCHED;
            PG8_STAGE(PG8_SB(0, 1), b2 + hstepB, voffB);
            PG8_WAIT_V(6); PG8_BAR; PG8_MMA(1, 1, At, B1); PG8_BAR;
            PG8_LDB(B0, 1, 0); PG8_SCHED; PG8_LDA(At, 1, 0); PG8_STAGE(PG8_SA(0, 1), a2 + hstepA, voffA);
            PG8_WAIT_L(8); PG8_BAR; PG8_WAIT_L(0); PG8_MMA(0, 0, At, B0); PG8_BAR; PG8_SCHED;
            PG8_LDB(B1, 1, 1); PG8_STAGE(PG8_SB(1, 0), b3, voffB);
            PG8_BAR; PG8_WAIT_L(0); PG8_MMA(0, 1, At, B1); PG8_BAR;
            PG8_LDA(At, 1, 1); PG8_STAGE(PG8_SA(1, 0), a3, voffA);
            PG8_BAR; PG8_WAIT_L(0); PG8_MMA(1, 0, At, B0); PG8_BAR; PG8_SCHED;
            PG8_STAGE(PG8_SB(1, 1), b3 + hstepB, voffB);
            PG8_WAIT_V(6); PG8_BAR; PG8_MMA(1, 1, At, B1); PG8_BAR;
            }
        }
        if constexpr (ALIGN_EPI) { if (wr == 0) PG8_BAR; }
        if constexpr (!Epi::AFTER_DRAIN) { E(acc, cur, wr, wc, fr, fq); S.done(cur); }
        if (!has_next) break;
#pragma unroll
        for (int a = 0; a < 2; ++a)
#pragma unroll
            for (int b = 0; b < 2; ++b)
#pragma unroll
                for (int m = 0; m < 4; ++m)
#pragma unroll
                    for (int n = 0; n < 2; ++n) acc[a][b][m][n] = (f32x4){0.f, 0.f, 0.f, 0.f};
        cur = nxt; cA = nA; cB = nB; ++ui;
        if constexpr (ALIGN_EPI) { if (wr == 1) PG8_BAR; }
    }
    PG8_WAIT_V(0);
    if constexpr (!ALIGN_EPI) { if (wr == 0) PG8_BAR; }
    PG8_BAR;
    if constexpr (Epi::AFTER_DRAIN) { E.fused(acc, cur, wr, wc, fr, fq, lds, wid, lane); S.done(cur); }
#undef PG8_SA
#undef PG8_SB
#undef PG8_STAGE
#undef PG8_LDA
#undef PG8_LDB
#undef PG8_MMA
#undef PG8_WAIT_V
#undef PG8_WAIT_L
#undef PG8_BAR
#undef PG8_SCHED
}
}
#define GAS __attribute__((address_space(1)))
#define LAS __attribute__((address_space(3)))
typedef unsigned short bf16;
typedef short bf16x8 __attribute__((ext_vector_type(8)));
typedef float f32x4 __attribute__((ext_vector_type(4)));
typedef float f32x16 __attribute__((ext_vector_type(16)));
typedef unsigned u32x4 __attribute__((ext_vector_type(4)));
typedef unsigned u32x2 __attribute__((ext_vector_type(2)));
typedef short s16x4 __attribute__((ext_vector_type(4)));
typedef GAS unsigned gu32;
constexpr int NWAVES = 8;
constexpr int NBATCH = 4, SEQ = 4096, DM = 1024, TOK = NBATCH * SEQ, NLAYER = 2;
constexpr int NP = 5120, LDP = 5376, WIN_COLS = 5136;
constexpr int C_AQ = 0, C_BV = 1024, C_CG = 1536, C_AK = 2048, C_AV = 2304, C_AG = 2560, C_BQ = 3584, C_BK = 3840, C_BG = 4096, C_CU = 4608, C_GL = 5120;
constexpr float EPS = 1e-6f, LOG2E = 1.4426950408889634f;
constexpr size_t MiB = 1u << 20;
constexpr size_t WS_CTL = 0, CTL_ZERO_BYTES = 64 * 1024;
constexpr int CW_BAR = 1024;
constexpr size_t WS_MOD = 1 * MiB;
constexpr size_t WS_TAB = 1 * MiB + 256 * 1024;
constexpr size_t WS_WLR = 1 * MiB + 384 * 1024;
constexpr size_t WS_WA = 1 * MiB + 448 * 1024;
constexpr size_t WS_BLR = 1 * MiB + 512 * 1024;
constexpr size_t WS_WIN = 2 * MiB, WIN_BYTES = (size_t)NP * DM * 2;
constexpr size_t WS_WOUT = 23 * MiB, WOUT_BYTES = (size_t)DM * 2048 * 2;
constexpr size_t WS_WGLU = 31 * MiB, WGLU_BYTES = (size_t)512 * 512 * 2;
constexpr size_t WS_S5M = 32 * MiB, S5M_BYTES = 8 * MiB;
constexpr size_t S5M_TZ = 0, S5M_BZ = 4 * MiB, S5M_CZ = 6 * MiB;
constexpr size_t WS_H = 48 * MiB;
constexpr size_t WS_GLAE = 48 * MiB;
constexpr size_t WS_GLAD = 56 * MiB;
constexpr size_t WS_S5E = 57 * MiB;
constexpr size_t WS_P = 80 * MiB;
constexpr size_t WS_END = 248 * MiB;
static_assert(WS_WIN + 2 * WIN_BYTES <= WS_WOUT && WS_WOUT + 2 * WOUT_BYTES <= WS_WGLU && WS_WGLU + 2 * WGLU_BYTES <= WS_S5M && WS_S5M + 2 * S5M_BYTES <= WS_H, "ws map");
static_assert(WS_H + (size_t)TOK * DM * 2 <= WS_P && WS_P + (size_t)TOK * LDP * 2 <= WS_END && WS_S5E + 2048 * 128 * 4 <= WS_P, "ws map 2");
constexpr int RING_BYTES = 143360, LDSCTL_OFF = RING_BYTES, MISC_OFF = LDSCTL_OFF + 320, LDS_BYTES = 147456;

#define RLX_AGENT __ATOMIC_RELAXED, __HIP_MEMORY_SCOPE_AGENT
#define LDS_WAIT() asm volatile("s_waitcnt lgkmcnt(0)" ::: "memory")
typedef float f32x2_t __attribute__((ext_vector_type(2))); typedef __bf16 bf16x2_t __attribute__((ext_vector_type(2)));
__device__ __forceinline__ unsigned pk2(float lo, float hi) { f32x2_t v = {lo, hi}; bf16x2_t b = __builtin_convertvector(v, bf16x2_t); return __builtin_bit_cast(unsigned, b); }
__device__ __forceinline__ bf16 f2bf(float f) { return (bf16)(pk2(f, 0.f) & 0xffffu); }
__device__ __forceinline__ float bf2f(bf16 b) { return __uint_as_float((unsigned)b << 16); }
__device__ __forceinline__ float bflo(unsigned w) { return __uint_as_float(w << 16); }
__device__ __forceinline__ float bfhi(unsigned w) { return __uint_as_float(w & 0xffff0000u); }
__device__ __forceinline__ float sigmoidf_(float x) { return __builtin_amdgcn_rcpf(1.0f + __expf(-x)); }
__device__ __forceinline__ float wave_sum(float v) {
#pragma unroll
    for (int o = 1; o < 64; o <<= 1) v += __shfl_xor(v, o);
    return v;
}
#define MFMA16(a, b, c) __builtin_amdgcn_mfma_f32_16x16x32_bf16((a), (b), (c), 0, 0, 0)
#define MFMA32(a, b, c) __builtin_amdgcn_mfma_f32_32x32x16_bf16((a), (b), (c), 0, 0, 0)
#define XB_TMO      128
#define XB_XCNT(j)  (256  + 64 * (j))
#define XB_XSUB(j)  (1280 + 64 * (j))
#define XB_XGEN(j)  (2304 + 64 * (j))
#define XB_TOP      3328
#define XB_TOPGEN   3392
#define XCD_BAR_WORDS 3456
#define XB_SPIN_CAP (1u << 18)

__device__ __forceinline__ unsigned xb_ld(unsigned* p)              { return __hip_atomic_load(p, __ATOMIC_RELAXED, __HIP_MEMORY_SCOPE_AGENT); }
__device__ __forceinline__ unsigned xb_add(unsigned* p, unsigned v) { return __hip_atomic_fetch_add(p, v, __ATOMIC_RELAXED, __HIP_MEMORY_SCOPE_AGENT); }
__device__ __forceinline__ unsigned xb_xcc_id() { return (unsigned)__builtin_amdgcn_s_getreg((3 << 11) | 20) & 0xFu; }
#define XB_SPIN(cond, bar) do { unsigned _sp = 0; while (cond) { __builtin_amdgcn_s_sleep(1); \
    if ((++_sp & 255u) == 0u) { if (xb_ld(&(bar)[XB_TMO])) break; if (_sp > XB_SPIN_CAP) { atomicAdd(&(bar)[XB_TMO], 1u); break; } } } } while (0)

struct XcdBarrier {
    unsigned* bar; unsigned x;
    volatile LAS unsigned* st;
};

__device__ __forceinline__ XcdBarrier xcd_barrier_post(unsigned* bar, volatile LAS unsigned* st) {
    XcdBarrier b; b.bar = bar; b.x = xb_xcc_id(); b.st = st;
    if (threadIdx.x == 0) (void)xb_add(&bar[XB_XCNT(b.x)], 1u);
    return b;
}
__device__ __forceinline__ void xcd_barrier_complete(unsigned* bar, unsigned x, unsigned& nloc, unsigned& nx) {
    const unsigned G = gridDim.x * gridDim.y * gridDim.z;
    unsigned sum, cnt, mine, sp = 0u;
    for (;;) {
        sum = 0u; cnt = 0u; mine = 0u;
#pragma unroll
        for (unsigned j = 0; j < 16; ++j) { const unsigned c = xb_ld(&bar[XB_XCNT(j)]); sum += c; cnt += (c > 0u) ? 1u : 0u; mine = (j == x) ? c : mine; }
        if (sum == G) break;
        __builtin_amdgcn_s_sleep(1);
        if ((++sp & 255u) == 0u) { if (xb_ld(&bar[XB_TMO])) break; if (sp > XB_SPIN_CAP) { atomicAdd(&bar[XB_TMO], 1u); break; } }
    }
    nloc = mine > 0u ? mine : 1u; nx = cnt > 0u ? cnt : 1u;
}

__device__ __forceinline__ void xcd_barrier(const XcdBarrier& b) {
    asm volatile("s_waitcnt vmcnt(0)" ::: "memory");
    __syncthreads();
    if (threadIdx.x == 0) {
        unsigned* bar = b.bar;
        __builtin_amdgcn_s_waitcnt(0);
        unsigned nloc = b.st[0], nx = b.st[1];
        if (nloc == 0u) { xcd_barrier_complete(bar, b.x, nloc, nx); b.st[0] = nloc; b.st[1] = nx; }
        const unsigned old = xb_add(&bar[XB_XSUB(b.x)], 1u);
        const unsigned gen = old / nloc;
        if (old + 1u == (gen + 1u) * nloc) {
            __builtin_amdgcn_fence(__ATOMIC_RELEASE, "agent");
            asm volatile("s_waitcnt vmcnt(0)" ::: "memory");
            const unsigned og = xb_add(&bar[XB_TOP], 1u);
            const unsigned tg = og / nx;
            if (og + 1u == (tg + 1u) * nx) xb_add(&bar[XB_TOPGEN], 1u);
            else XB_SPIN(xb_ld(&bar[XB_TOPGEN]) == tg, bar);
            __builtin_amdgcn_fence(__ATOMIC_ACQUIRE, "agent");
            xb_add(&bar[XB_XGEN(b.x)], 1u);
            asm volatile("s_waitcnt vmcnt(0)" ::: "memory");
        } else {
            XB_SPIN(xb_ld(&bar[XB_XGEN(b.x)]) == gen, bar);
            __builtin_amdgcn_fence(__ATOMIC_ACQUIRE, "agent");
            asm volatile("s_waitcnt vmcnt(0)" ::: "memory");
        }
    }
    __syncthreads();
}
__device__ __forceinline__ int win_srccol(int n0) {
    if (n0 < 1024) return n0;
    if (n0 < 1536) return 3072 + (n0 - 1024);
    if (n0 < 2048) return 4624 + (n0 - 1536);
    if (n0 < 2304) return 1024 + (n0 - 2048);
    if (n0 < 2560) return 1280 + (n0 - 2304);
    if (n0 < 3584) return 1536 + (n0 - 2560);
    if (n0 < 3840) return 2560 + (n0 - 3584);
    if (n0 < 4096) return 2816 + (n0 - 3840);
    if (n0 < 4608) return 3600 + (n0 - 4096);
    return 4112 + (n0 - 4608);
}
constexpr int TR_NB = NP / 32, TR_IL = 16 * TR_NB + 32 * 32 + 8 * 16;
__device__ __forceinline__ void p0_gate_small(const float* const* in, unsigned char* ws, int l, int tid) {
    const float* W = in[6] + (size_t)l * DM * WIN_COLS; bf16* WL = (bf16*)(ws + WS_WLR) + (size_t)l * 16 * 1024; bf16* WA = (bf16*)(ws + WS_WA) + (size_t)l * 256 * 16;
    for (int k = tid; k < 1024; k += 512) { const f32x4* wr = (const f32x4*)(W + (size_t)k * WIN_COLS + 3584); const f32x4 w0 = wr[0], w1 = wr[1], w2 = wr[2], w3 = wr[3];
        const float v[16] = {w0[0], w0[1], w0[2], w0[3], w1[0], w1[1], w1[2], w1[3], w2[0], w2[1], w2[2], w2[3], w3[0], w3[1], w3[2], w3[3]};
#pragma unroll
        for (int r = 0; r < 16; ++r) WL[r * 1024 + k] = f2bf(v[r]); }
    if (tid < 256) { const float* wa = in[8] + (size_t)l * 16 * 256 + tid; float v[16];
#pragma unroll
        for (int r = 0; r < 16; ++r) v[r] = wa[r * 256];
        u32x4 o0, o1; o0.x = pk2(v[0], v[1]); o0.y = pk2(v[2], v[3]); o0.z = pk2(v[4], v[5]); o0.w = pk2(v[6], v[7]); o1.x = pk2(v[8], v[9]); o1.y = pk2(v[10], v[11]); o1.z = pk2(v[12], v[13]); o1.w = pk2(v[14], v[15]);
        *(u32x4*)(WA + tid * 16) = o0; *(u32x4*)(WA + tid * 16 + 8) = o1; }
}
__device__ __forceinline__ void blr_head(LAS unsigned char* lds, const bf16* H, const bf16* WL, bf16* BLR, int wg, int tid, int wid, int lane) {
    const int c16 = lane & 15, q = lane >> 4, mt = wid & 3, kh = wid >> 2;
    const bf16* ap = H + (size_t)(64 * wg + 16 * mt + c16) * DM + 512 * kh + 8 * q; const bf16* bp = WL + (size_t)c16 * 1024 + 512 * kh + 8 * q;
    f32x4 acc = (f32x4){0.f, 0.f, 0.f, 0.f};
    { bf16x8 af[16], bfr[16];
#pragma unroll
      for (int kk = 0; kk < 16; ++kk) { af[kk] = *(const bf16x8*)(ap + 32 * kk); bfr[kk] = *(const bf16x8*)(bp + 32 * kk); }
#pragma unroll
      for (int kk = 0; kk < 16; ++kk) acc = MFMA16(af[kk], bfr[kk], acc); }
    LAS float* part = (LAS float*)lds;
#pragma unroll
    for (int r = 0; r < 4; ++r) part[(kh * 64 + 16 * mt + 4 * q + r) * 16 + c16] = acc[r];
    __syncthreads();
    { const int e0 = 2 * tid; const float s0 = part[e0] + part[1024 + e0], s1 = part[e0 + 1] + part[1024 + e0 + 1];
      *(unsigned*)(BLR + (size_t)64 * wg * 16 + e0) = pk2(s0, s1); }
    __syncthreads();
}
__device__ __forceinline__ void p0_mod_item(LAS unsigned char* lds, const float* c, const float* wmod, const float* bmod, const float* gpre, float* mod, int it, int tid, int wid, int lane) {
    LAS float* sc = (LAS float*)lds; LAS float* part = (LAS float*)(lds + 16384);
    const int l = it / 96, nb = it % 96, col = nb * 32 + (lane & 31), ks = wid * 2 + (lane >> 5);
    const float* wp = wmod + (size_t)l * 1024 * 3072 + col + (size_t)ks * 64 * 3072;
    float w[64];
#pragma unroll
    for (int i = 0; i < 64; ++i) w[i] = __builtin_nontemporal_load(wp + (size_t)i * 3072);
    for (int i = tid; i < 4096; i += 512) { const float cv = c[i]; sc[i] = cv * sigmoidf_(cv); }
    __syncthreads();
    float a0 = 0.f, a1 = 0.f, a2 = 0.f, a3 = 0.f;
#pragma unroll
    for (int i = 0; i < 64; ++i) { const int k = ks * 64 + i; a0 += sc[k] * w[i]; a1 += sc[1024 + k] * w[i]; a2 += sc[2048 + k] * w[i]; a3 += sc[3072 + k] * w[i]; }
    part[(ks * 4 + 0) * 32 + (lane & 31)] = a0; part[(ks * 4 + 1) * 32 + (lane & 31)] = a1; part[(ks * 4 + 2) * 32 + (lane & 31)] = a2; part[(ks * 4 + 3) * 32 + (lane & 31)] = a3;
    __syncthreads();
    if (tid < 128) { const int b = tid >> 5, n = nb * 32 + (tid & 31); float s = 0.f;
#pragma unroll
        for (int k = 0; k < 16; ++k) s += part[(k * 4 + b) * 32 + (tid & 31)];
        s += bmod[l * 3072 + n];
        if (n >= 1024 && n < 2048) s = gpre[l * 1024 + n - 1024] * (1.0f + s);
        mod[(size_t)(l * 4 + b) * 3072 + n] = s; }
    __syncthreads();
}

__device__ __forceinline__ void p0_s5_item(LAS unsigned char* lds, const float* const* in, unsigned char* ws, int l, int g, int tid) {
    LAS float* PWr = (LAS float*)lds; LAS float* PWi = PWr + 17 * 64; LAS float* BTr = PWi + 17 * 64; LAS float* BTi = BTr + 1024;
    LAS float* CRr = BTi + 1024; LAS float* CRi = CRr + 1024; LAS float* KC = CRi + 1024;
    const float* are = in[11] + (size_t)(l * 32 + g) * 64; const float* aim = in[12] + (size_t)(l * 32 + g) * 64;
    const double dt = exp((double)in[13][l * 32 + g]);
    const float* bre = in[14] + (size_t)(l * 32 + g) * 1024; const float* bim = in[15] + (size_t)(l * 32 + g) * 1024;
    const float* cre = in[16] + (size_t)(l * 32 + g) * 1024; const float* cim = in[17] + (size_t)(l * 32 + g) * 1024;
    const float* dd = in[18] + (size_t)l * 512 + g * 16;
    float* tab = (float*)(ws + WS_TAB) + (size_t)(l * 32 + g) * 6 * 64;
    if (tid < 64) { const int p = tid; const double ar = are[p], ai = aim[p];
        const double mag = exp(ar * dt), abr = mag * cos(ai * dt), abi = mag * sin(ai * dt), den = ar * ar + ai * ai, nr = abr - 1.0;
        const double fr = (nr * ar + abi * ai) / den, fi = (abi * ar - nr * ai) / den;
#pragma unroll 4
        for (int h = 0; h < 16; ++h) { const double br = bre[p * 16 + h], bi = bim[p * 16 + h]; BTr[p * 16 + h] = (float)(fr * br - fi * bi); BTi[p * 16 + h] = (float)(fr * bi + fi * br); }
        double pr = 1.0, pi = 0.0;
#pragma unroll 1
        for (int tau = 0; tau <= 16; ++tau) { PWr[tau * 64 + p] = (float)pr; PWi[tau * 64 + p] = (float)pi; const double t = pr * abr - pi * abi; pi = pr * abi + pi * abr; pr = t; }
        double qr = (double)0, qi = (double)0; { qr = 1.0; qi = 0.0; double xr = abr, xi = abi;
#pragma unroll 1
          for (int s2 = 0; s2 < 8; ++s2) { const double t = xr * xr - xi * xi; xi = 2.0 * xr * xi; xr = t;
              if (s2 == 3) { tab[0 * 64 + p] = (float)xr; tab[1 * 64 + p] = (float)xi; }
              if (s2 == 5) { tab[2 * 64 + p] = (float)xr; tab[3 * 64 + p] = (float)xi; }
              if (s2 == 7) { tab[4 * 64 + p] = (float)xr; tab[5 * 64 + p] = (float)xi; } } }
        (void)qr; (void)qi; }
    for (int idx = tid; idx < 1024; idx += 512) { CRr[idx] = cre[idx]; CRi[idx] = cim[idx]; }
    __syncthreads();
    { const int hp = tid & 15, tau = (tid >> 4) & 15, hh = __builtin_amdgcn_readfirstlane(tid >> 8); float acc[8];
#pragma unroll
      for (int j = 0; j < 8; ++j) acc[j] = 0.f;
#pragma unroll 4
      for (int p = 0; p < 64; ++p) { const float pr = PWr[tau * 64 + p], pi = PWi[tau * 64 + p], br = BTr[p * 16 + hp], bi = BTi[p * 16 + hp];
          const float xr = pr * br - pi * bi, xi = pr * bi + pi * br;
#pragma unroll
          for (int j = 0; j < 8; ++j) acc[j] += cre[(8 * hh + j) * 64 + p] * xr - cim[(8 * hh + j) * 64 + p] * xi; }
#pragma unroll
      for (int j = 0; j < 8; ++j) { const int h = 8 * hh + j; float s = acc[j]; if (tau == 0 && h == hp) s += dd[h]; KC[(tau * 16 + h) * 16 + hp] = s; } }
    __syncthreads();
    bf16* Tz = (bf16*)(ws + WS_S5M + (size_t)l * S5M_BYTES + S5M_TZ) + (size_t)g * 65536;
    bf16* Bz = (bf16*)(ws + WS_S5M + (size_t)l * S5M_BYTES + S5M_BZ) + (size_t)g * 32768;
    bf16* Cz = (bf16*)(ws + WS_S5M + (size_t)l * S5M_BYTES + S5M_CZ) + (size_t)g * 32768;
#pragma unroll 1
    for (int i = 0; i < 16; ++i) { const int idx = tid + 512 * i, n = idx >> 5, c = idx & 31, ii = n >> 4, h = n & 15, j = c >> 1, hp0 = 8 * (c & 1); float v[8];
#pragma unroll
        for (int e = 0; e < 8; ++e) v[e] = (j <= ii) ? KC[((ii - j) * 16 + h) * 16 + hp0 + e] : 0.f;
        u32x4 o; o.x = pk2(v[0], v[1]); o.y = pk2(v[2], v[3]); o.z = pk2(v[4], v[5]); o.w = pk2(v[6], v[7]); *(u32x4*)(Tz + (size_t)n * 256 + 8 * c) = o; }
#pragma unroll 1
    for (int i = 0; i < 8; ++i) { const int idx = tid + 512 * i, n = idx >> 5, c = idx & 31, p = n & 63, im = n >> 6, j = c >> 1, hp0 = 8 * (c & 1), tau = 15 - j; float v[8];
        const float pr = PWr[tau * 64 + p], pi = PWi[tau * 64 + p];
#pragma unroll
        for (int e = 0; e < 8; ++e) { const float br = BTr[p * 16 + hp0 + e], bi = BTi[p * 16 + hp0 + e]; v[e] = im ? (pr * bi + pi * br) : (pr * br - pi * bi); }
        u32x4 o; o.x = pk2(v[0], v[1]); o.y = pk2(v[2], v[3]); o.z = pk2(v[4], v[5]); o.w = pk2(v[6], v[7]); *(u32x4*)(Bz + (size_t)n * 256 + 8 * c) = o; }
#pragma unroll 1
    for (int i = 0; i < 8; ++i) { const int idx = tid + 512 * i, n = idx >> 4, c = idx & 15, ii = n >> 4, h = n & 15, im = c >> 3, tau = ii + 1; float v[8];
#pragma unroll
        for (int e = 0; e < 8; ++e) { const int p = (8 * c + e) & 63; const float cr = CRr[h * 64 + p], ci = CRi[h * 64 + p], pr = PWr[tau * 64 + p], pi = PWi[tau * 64 + p];
            v[e] = im ? -(cr * pi + ci * pr) : (cr * pr - ci * pi); }
        u32x4 o; o.x = pk2(v[0], v[1]); o.y = pk2(v[2], v[3]); o.z = pk2(v[4], v[5]); o.w = pk2(v[6], v[7]); *(u32x4*)(Cz + (size_t)n * 128 + 8 * c) = o; }
    __syncthreads();}

__device__ __forceinline__ void p0_mod_phase(LAS unsigned char* lds, const float* const* in, unsigned char* ws, int vcu, int G, int tid, int wid, int lane) {
    for (int it = vcu; it < 192 + NLAYER; it += G) { if (it < 192) p0_mod_item(lds, in[1], in[2], in[3], in[4], (float*)(ws + WS_MOD), it, tid, wid, lane); else p0_gate_small(in, ws, it - 192, tid); }
}
struct TrDesc { const float* src; bf16* dst; int ldw, K; const float* walpha; int acol; };
__device__ __forceinline__ TrDesc tr_decode(const float* const* in, unsigned char* ws, int it) {
    constexpr int I_IN = 16 * TR_NB, I_OUT = 32 * 32, I_L = TR_IL;
    const int l = it / I_L; int r = it % I_L; TrDesc d; d.walpha = nullptr; d.acol = 0;
    if (r < I_IN) { const int nb = r % TR_NB, kb = r / TR_NB, n0 = nb * 32, sc = win_srccol(n0);
        const float* W = in[6] + (size_t)l * DM * WIN_COLS; bf16* WT = (bf16*)(ws + WS_WIN + (size_t)l * WIN_BYTES);
        d.ldw = WIN_COLS; d.K = DM; d.dst = WT + (size_t)n0 * DM + kb * 64;
        d.src = W + (size_t)(kb * 64) * WIN_COLS + sc;
        return d; }
    r -= I_IN;
    if (r < I_OUT) { const int nb = r % 32, kb = r / 32; d.ldw = DM; d.K = 2048; d.src = in[21] + (size_t)l * 2048 * DM + (size_t)(kb * 64) * DM + nb * 32; d.dst = (bf16*)(ws + WS_WOUT + (size_t)l * WOUT_BYTES) + (size_t)(nb * 32) * 2048 + kb * 64; return d; }
    r -= I_OUT;
    { const int nb = r % 16, kb = r / 16; d.ldw = 512; d.K = 512; d.src = in[19] + (size_t)l * 512 * 512 + (size_t)(kb * 64) * 512 + nb * 32; d.dst = (bf16*)(ws + WS_WGLU + (size_t)l * WGLU_BYTES) + (size_t)(nb * 32) * 512 + kb * 64; return d; }
}
__device__ __forceinline__ void tr_load(const TrDesc& d, f32x4 (&v)[8], int lane) {
    const int kr = lane >> 3, c4 = lane & 7;
#pragma unroll
    for (int i = 0; i < 8; ++i) v[i] = __builtin_nontemporal_load((const f32x4*)(d.src + (size_t)(8 * i + kr) * d.ldw + 4 * c4));
}
__device__ __forceinline__ void tr_lds_fill(const TrDesc& d, const f32x4 (&v)[8], LAS float* scr, int lane) {
    if (d.walpha == nullptr) { const int kr = lane >> 3, c4 = lane & 7;
#pragma unroll
        for (int i = 0; i < 8; ++i) { LAS float* q = scr + (8 * i + kr) * 33 + 4 * c4; q[0] = v[i][0]; q[1] = v[i][1]; q[2] = v[i][2]; q[3] = v[i][3]; } }
    else {
        float wa[16];
#pragma unroll
        for (int r = 0; r < 16; ++r) wa[r] = d.walpha[r * 256 + d.acol + (lane & 31)];
#pragma unroll 4
        for (int i = 0; i < 32; ++i) { const int kk = 2 * i + (lane >> 5); const f32x4* wr = (const f32x4*)(d.src + (size_t)kk * d.ldw);
            const f32x4 w0 = wr[0], w1 = wr[1], w2 = wr[2], w3 = wr[3];
            float s = (w0[0] * wa[0] + w0[1] * wa[1]) + (w0[2] * wa[2] + w0[3] * wa[3]); s += (w1[0] * wa[4] + w1[1] * wa[5]) + (w1[2] * wa[6] + w1[3] * wa[7]);
            s += (w2[0] * wa[8] + w2[1] * wa[9]) + (w2[2] * wa[10] + w2[3] * wa[11]); s += (w3[0] * wa[12] + w3[1] * wa[13]) + (w3[2] * wa[14] + w3[3] * wa[15]);
            scr[kk * 33 + (lane & 31)] = s; } }
}
__device__ __forceinline__ void tr_store(const TrDesc& d, LAS float* scr, int lane) {
    const int c = lane & 7;
#pragma unroll
    for (int j = 0; j < 4; ++j) { const int n = (lane >> 3) + 8 * j; const LAS float* s = scr + (8 * c) * 33 + n;
        u32x4 o; o.x = pk2(s[0 * 33], s[1 * 33]); o.y = pk2(s[2 * 33], s[3 * 33]); o.z = pk2(s[4 * 33], s[5 * 33]); o.w = pk2(s[6 * 33], s[7 * 33]);
        *(u32x4*)(d.dst + (size_t)n * d.K + 8 * c) = o; }
}
__device__ __forceinline__ void p1_transposes(LAS unsigned char* lds, const float* const* in, unsigned char* ws, int gw, int NGW, int wid, int lane, int it_lo, int NIT) {
    LAS float* scr = (LAS float*)(lds + wid * 16384);
    int it = it_lo + gw; if (it >= NIT) return;
    TrDesc d = tr_decode(in, ws, it); f32x4 v[8];
    if (d.walpha == nullptr) tr_load(d, v, lane);
    for (;;) {
        tr_lds_fill(d, v, scr, lane);
        const int nx = it + NGW; TrDesc dn = d; const bool more = nx < NIT;
        if (more) { dn = tr_decode(in, ws, nx); if (dn.walpha == nullptr) tr_load(dn, v, lane); }
        LDS_WAIT(); asm volatile("" ::: "memory");
        tr_store(d, scr, lane);
        LDS_WAIT(); asm volatile("" ::: "memory");
        if (!more) break;
        d = dn; it = nx;
    }
}
__device__ __forceinline__ void prenorm_phase(const float* x, const float* mod  , bf16* H, int gw, int NGW, int lane) {
    f32x4 v[4], n1[4], n2[4];
    int m = gw; if (m >= TOK) return;
#pragma unroll
    for (int j = 0; j < 4; ++j) { v[j] = __builtin_nontemporal_load((const f32x4*)(x + (size_t)m * DM + 256 * j + 4 * lane)); n1[j] = v[j]; n2[j] = v[j]; }
    if (m + NGW < TOK) {
#pragma unroll
        for (int j = 0; j < 4; ++j) n1[j] = __builtin_nontemporal_load((const f32x4*)(x + (size_t)(m + NGW) * DM + 256 * j + 4 * lane)); }
    for (; m < TOK; m += NGW) {
        if (m + 2 * NGW < TOK) {
#pragma unroll
            for (int j = 0; j < 4; ++j) n2[j] = __builtin_nontemporal_load((const f32x4*)(x + (size_t)(m + 2 * NGW) * DM + 256 * j + 4 * lane)); }
        const int b = m / SEQ; const float* mb = mod + (size_t)b * 3072; f32x4 ga[4], sh[4]; float ss = 0.f;
#pragma unroll
        for (int j = 0; j < 4; ++j) { ss += (v[j][0] * v[j][0] + v[j][1] * v[j][1]) + (v[j][2] * v[j][2] + v[j][3] * v[j][3]); ga[j] = *(const f32x4*)(mb + 1024 + 256 * j + 4 * lane); sh[j] = *(const f32x4*)(mb + 256 * j + 4 * lane); }
        const float r = rsqrtf(wave_sum(ss) * (1.0f / DM) + EPS);
#pragma unroll
        for (int j = 0; j < 4; ++j) { const f32x4 o = v[j] * r * ga[j] + sh[j]; u32x2 w; w.x = pk2(o[0], o[1]); w.y = pk2(o[2], o[3]); *(u32x2*)(H + (size_t)m * DM + 256 * j + 4 * lane) = w; }
#pragma unroll
        for (int j = 0; j < 4; ++j) { v[j] = n1[j]; n1[j] = n2[j]; }
    }
}
__device__ __forceinline__ void post_phase(const float* xin, float* xout, const bf16* Y, const float* gpost, const float* mod  , bool do_next, const float* gpre_n, const float* mod_n, bf16* Hn,
                                           int vcu, int wid, int lane) {
    const int gw = vcu * NWAVES + wid; const int m0 = gw * 8, b = m0 / SEQ;
    if (m0 >= TOK) return;
    f32x4 gp[4], gt[4];
#pragma unroll
    for (int j = 0; j < 4; ++j) { const int col = 256 * j + 4 * lane; gp[j] = *(const f32x4*)(gpost + col); gt[j] = *(const f32x4*)(mod + (size_t)b * 3072 + 2048 + col); }
    u32x2 yw[4], nyw[4]; f32x4 xv[4], nxv[4];
#pragma unroll
    for (int j = 0; j < 4; ++j) { yw[j] = *(const u32x2*)(Y + (size_t)m0 * DM + 256 * j + 4 * lane); xv[j] = __builtin_nontemporal_load((const f32x4*)(xin + (size_t)m0 * DM + 256 * j + 4 * lane)); nyw[j] = yw[j]; nxv[j] = xv[j]; }
#pragma unroll 1
    for (int i = 0; i < 8; ++i) { const int m = m0 + i; f32x4 y[4]; float ss = 0.f;
        if (i < 7) {
#pragma unroll
            for (int j = 0; j < 4; ++j) { nyw[j] = *(const u32x2*)(Y + (size_t)(m + 1) * DM + 256 * j + 4 * lane); nxv[j] = __builtin_nontemporal_load((const f32x4*)(xin + (size_t)(m + 1) * DM + 256 * j + 4 * lane)); } }
#pragma unroll
        for (int j = 0; j < 4; ++j) { y[j] = (f32x4){bflo(yw[j].x), bfhi(yw[j].x), bflo(yw[j].y), bfhi(yw[j].y)}; ss += (y[j][0] * y[j][0] + y[j][1] * y[j][1]) + (y[j][2] * y[j][2] + y[j][3] * y[j][3]); }
        const float r = rsqrtf(wave_sum(ss) * (1.0f / DM) + EPS); float s2 = 0.f;
#pragma unroll
        for (int j = 0; j < 4; ++j) { xv[j] = xv[j] + gt[j] * (y[j] * r * gp[j]); __builtin_nontemporal_store(xv[j], (f32x4*)(xout + (size_t)m * DM + 256 * j + 4 * lane));
            s2 += (xv[j][0] * xv[j][0] + xv[j][1] * xv[j][1]) + (xv[j][2] * xv[j][2] + xv[j][3] * xv[j][3]); }
        if (do_next) { const float r2 = rsqrtf(wave_sum(s2) * (1.0f / DM) + EPS);
#pragma unroll
            for (int j = 0; j < 4; ++j) { const int col = 256 * j + 4 * lane; const f32x4 ga = *(const f32x4*)(mod_n + (size_t)b * 3072 + 1024 + col), sh = *(const f32x4*)(mod_n + (size_t)b * 3072 + col);
                const f32x4 o = xv[j] * r2 * ga + sh; u32x2 w; w.x = pk2(o[0], o[1]); w.y = pk2(o[2], o[3]); *(u32x2*)(Hn + (size_t)m * DM + 256 * j + 4 * lane) = w; } }
#pragma unroll
        for (int j = 0; j < 4; ++j) { yw[j] = nyw[j]; xv[j] = nxv[j]; }
    }
}
typedef short v4i16_t __attribute__((ext_vector_type(4)));
__device__ __forceinline__ s16x4 vtr(LAS unsigned char* p) { return __builtin_bit_cast(s16x4, __builtin_amdgcn_ds_read_tr16_b64_v4i16((LAS v4i16_t*)p)); }
__device__ __forceinline__ void attn_item(LAS unsigned char* lds, bf16* P, const float* sinks, int item, int tid, int wid, int lane, unsigned long long& pacc) {
    (void)pacc;
    const int r32 = lane & 31, hi = lane >> 5;
    const int qblk = item & 31, kvh = (item >> 5) & 3, b = item >> 7, q0 = qblk * 128;
    const size_t rowbase = (size_t)b * SEQ;
    LAS unsigned char* Ks = lds; LAS unsigned char* Vs = lds + 32768; LAS float* ost = (LAS float*)(lds + 65536 + wid * 8704);
    { const int kr = tid >> 1, hf = tid & 1, key = q0 - 128 + kr; u32x4 kv[4], vv[4];
      if (key >= 0) { const bf16* src = P + (rowbase + key) * LDP + kvh * 64 + hf * 32;
#pragma unroll
          for (int c = 0; c < 4; ++c) { kv[c] = *(const u32x4*)(src + C_AK + c * 8); vv[c] = *(const u32x4*)(src + C_AV + c * 8); } }
      else {
#pragma unroll
          for (int c = 0; c < 4; ++c) { kv[c] = (u32x4){0u, 0u, 0u, 0u}; vv[c] = (u32x4){0u, 0u, 0u, 0u}; } }
#pragma unroll
      for (int c = 0; c < 4; ++c) { const int ch = hf * 4 + c; *(LAS u32x4*)(Ks + kr * 128 + ((ch ^ (kr & 7)) << 4)) = kv[c]; *(LAS u32x4*)(Vs + kr * 128 + (ch << 4)) = vv[c]; } }
    __syncthreads();
    const int g = wid >> 1, half = wid & 1, head = kvh * 4 + g;
    const float slope2 = exp2f(-0.5f * (float)(head + 1)) * LOG2E, sink2 = sinks[head] * LOG2E;
    const int q16 = (lane & 15) >> 2, p16 = lane & 3, dblk = (lane >> 4) & 1;
#pragma unroll 1
    for (int sb = 0; sb < 2; ++sb) {
        const int qs = q0 + half * 64 + sb * 32, lrow0 = half * 64 + sb * 32;
        const bf16* qp = P + (rowbase + qs + r32) * LDP + C_AQ + head * 64 + hi * 8;
        bf16x8 qf[4];
#pragma unroll
        for (int kk = 0; kk < 4; ++kk) qf[kk] = *(const bf16x8*)(qp + kk * 16);
        f32x16 S[5]; float m = sink2; int e = r32 - 4 * hi; asm volatile("" : "+v"(e)); const float ef = (float)e;
#pragma unroll
        for (int kt = 0; kt < 5; ++kt) { f32x16 acc;
            const bool tile_ok = (qs - 128 + 32 * kt) >= 0;
            if (tile_ok) {
                const float base = -slope2 * ((float)(128 - 32 * kt) + ef);
#pragma unroll
                for (int r = 0; r < 16; ++r) acc[r] = fmaf(slope2, (float)((r & 3) + 8 * (r >> 2)), base);
                const int krow = lrow0 + 32 * kt + r32;
#pragma unroll
                for (int kk = 0; kk < 4; ++kk) { const int ch = 2 * kk + hi; const bf16x8 kf = *(const LAS bf16x8*)(Ks + krow * 128 + ((ch ^ (krow & 7)) << 4)); acc = MFMA32(kf, qf[kk], acc); }
#pragma unroll
                for (int r = 0; r < 16; ++r) { const int cr = (r & 3) + 8 * (r >> 2); float s = acc[r];
                    if (kt == 0) s = (e < cr) ? s : -INFINITY; if (kt == 4) s = (e >= cr) ? s : -INFINITY;
                    S[kt][r] = s; m = fmaxf(m, s); }
            } else {
#pragma unroll
                for (int r = 0; r < 16; ++r) S[kt][r] = -INFINITY;
            }
            }
        m = fmaxf(m, __shfl_xor(m, 32));
        float l = 0.f;
#pragma unroll
        for (int kt = 0; kt < 5; ++kt)
#pragma unroll
            for (int r = 0; r < 16; ++r) { const float p = __builtin_amdgcn_exp2f(S[kt][r] - m); S[kt][r] = p; l += p; }
        l += __shfl_xor(l, 32); l += __builtin_amdgcn_exp2f(sink2 - m);
        const float inv_l = 1.0f / l;
        f32x16 o0, o1;
#pragma unroll
        for (int r = 0; r < 16; ++r) { o0[r] = 0.f; o1[r] = 0.f; }
#pragma unroll
        for (int kt = 0; kt < 5; ++kt)
#pragma unroll
            for (int ks = 0; ks < 2; ++ks) { u32x4 pw; pw.x = pk2(S[kt][8 * ks + 0], S[kt][8 * ks + 1]); pw.y = pk2(S[kt][8 * ks + 2], S[kt][8 * ks + 3]); pw.z = pk2(S[kt][8 * ks + 4], S[kt][8 * ks + 5]); pw.w = pk2(S[kt][8 * ks + 6], S[kt][8 * ks + 7]);
                const bf16x8 pa = __builtin_bit_cast(bf16x8, pw);
                LAS unsigned char* vb = Vs + (lrow0 + 32 * kt + 16 * ks + 4 * hi + q16) * 128 + dblk * 32 + p16 * 8;
                const s16x4 a0 = vtr(vb), a1 = vtr(vb + 8 * 128), b0 = vtr(vb + 64), b1 = vtr(vb + 64 + 8 * 128);
                const bf16x8 v0 = __builtin_shufflevector(a0, a1, 0, 1, 2, 3, 4, 5, 6, 7), v1 = __builtin_shufflevector(b0, b1, 0, 1, 2, 3, 4, 5, 6, 7);
                o0 = MFMA32(pa, v0, o0); o1 = MFMA32(pa, v1, o1); }
#pragma unroll
        for (int r = 0; r < 16; ++r) { const int qr = (r & 3) + 8 * (r >> 2) + 4 * hi; ost[qr * 68 + r32] = o0[r]; ost[qr * 68 + 32 + r32] = o1[r]; }
        asm volatile("" ::: "memory");
        { const int row = lane >> 1, hf = lane & 1; const float sc = __shfl(inv_l, row);
          bf16* rp = P + (rowbase + qs + row) * LDP + head * 64 + hf * 32;
#pragma unroll
          for (int c = 0; c < 4; ++c) { const u32x4 gv = *(const u32x4*)(rp + C_AG + 8 * c);
              const f32x4 x0 = *(const LAS f32x4*)(ost + row * 68 + hf * 32 + 8 * c), x1 = *(const LAS f32x4*)(ost + row * 68 + hf * 32 + 8 * c + 4);
              float gg[8] = {bflo(gv.x), bfhi(gv.x), bflo(gv.y), bfhi(gv.y), bflo(gv.z), bfhi(gv.z), bflo(gv.w), bfhi(gv.w)};
              float xx[8] = {x0[0], x0[1], x0[2], x0[3], x1[0], x1[1], x1[2], x1[3]};
#pragma unroll
              for (int e = 0; e < 8; ++e) xx[e] = xx[e] * sc * gg[e] * sigmoidf_(gg[e]);
              u32x4 w; w.x = pk2(xx[0], xx[1]); w.y = pk2(xx[2], xx[3]); w.z = pk2(xx[4], xx[5]); w.w = pk2(xx[6], xx[7]);
              *(u32x4*)(rp + C_AQ + 8 * c) = w; } }
        asm volatile("" ::: "memory");
    }
    __syncthreads();
}
constexpr int GL_GLS = 78336;
constexpr int GL_QT = 0, GL_KT = 9216, GL_KH = 18432, GL_AT = 27648, GL_VT = 36864, GL_ST = 55296, GL_PART = 73728, GL_BL = 75776, GL_SS = 76032, GL_RS = 78080, GL_LD = 72;
__device__ __forceinline__ bf16x8 ldsfrag(LAS unsigned char* base, int row, int kof) { return *(const LAS bf16x8*)(base + (row * GL_LD + kof) * 2); }
template <bool OUT>
__device__ __forceinline__ void gla_item(LAS unsigned char* lds, bf16* P, const bf16* BLR, const bf16* WA, const float* balpha, const float* gnorm, float* GE, float* GD, int item, int tid, int wid, int lane) {
    const int c16 = lane & 15, q = lane >> 4;
    const int b = item >> 6, hd = (item >> 4) & 3, seg = item & 15;
    const size_t row0 = (size_t)b * SEQ + seg * 256;
    LAS bf16* QT = (LAS bf16*)(lds + GL_QT); LAS bf16* KT = (LAS bf16*)(lds + GL_KT); LAS bf16* AT = (LAS bf16*)(lds + GL_AT); LAS bf16* ST = (LAS bf16*)(lds + GL_ST);
    LAS float* PART = (LAS float*)(lds + GL_PART); LAS float* BL = (LAS float*)(lds + GL_BL); LAS float* SS = (LAS float*)(lds + GL_SS); LAS float* RS = (LAS float*)(lds + GL_RS);
    f32x4 S[4];
#pragma unroll
    for (int nt = 0; nt < 4; ++nt) S[nt] = (f32x4){0.f, 0.f, 0.f, 0.f};
    if (OUT) {
#pragma unroll 1
        for (int sp = 0; sp < seg; ++sp) { const float* e = GE + (size_t)(item - seg + sp) * 8192; const float* dd = GD + (size_t)(item - seg + sp) * 64;
#pragma unroll
            for (int nt = 0; nt < 4; ++nt) { const float dec = dd[16 * nt + c16];
#pragma unroll
                for (int r = 0; r < 4; ++r) S[nt][r] = S[nt][r] * dec + e[(16 * wid + 4 * q + r) * 64 + 16 * nt + c16]; } } }
    float dtot = 0.f;
    const int d = tid & 63, part = tid >> 6;
    const float ba = balpha[hd * 64 + d];
    LAS float* GLs = (LAS float*)(lds + GL_GLS);
    const int gmt = wid >> 1, gnt0 = 2 * (wid & 1);
    const bf16x8 zero8 = (bf16x8){0, 0, 0, 0, 0, 0, 0, 0};
    bf16x8 waf[2];
    if (!OUT) {
#pragma unroll
        for (int t = 0; t < 2; ++t) { const bf16x8 v = *(const bf16x8*)(WA + (size_t)(hd * 64 + 16 * (gnt0 + t) + c16) * 16 + 8 * (q & 1)); waf[t] = (q < 2) ? v : zero8; } }
#pragma unroll 1
    for (int ch = 0; ch < 4; ++ch) {
        const size_t rowc = row0 + ch * 64;
        if (!OUT) { const bf16x8 v = *(const bf16x8*)(BLR + (rowc + 16 * gmt + c16) * 16 + 8 * (q & 1)); const bf16x8 af = (q < 2) ? v : zero8;
#pragma unroll
            for (int t = 0; t < 2; ++t) { const f32x4 acc = MFMA16(af, waf[t], ((f32x4){0.f, 0.f, 0.f, 0.f}));
#pragma unroll
                for (int r = 0; r < 4; ++r) GLs[(16 * gmt + 4 * q + r) * 64 + 16 * (gnt0 + t) + c16] = acc[r]; }
            __syncthreads(); }
        float bcs[8]; float run = 0.f;
#pragma unroll
        for (int i = 0; i < 8; ++i) { bf16 glb; if (OUT) glb = P[(rowc + part * 8 + i) * LDP + C_GL + hd * 64 + d]; else { glb = f2bf(GLs[(part * 8 + i) * 64 + d]); P[(rowc + part * 8 + i) * LDP + C_GL + hd * 64 + d] = glb; }
            const float x = bf2f(glb) + ba;
            const float la = (fminf(x, 0.f) - __logf(1.0f + __expf(-fabsf(x)))) * 0.0625f; run += la; bcs[i] = run; }
        PART[part * 64 + d] = run;
        __syncthreads();
        float off = 0.f, tot = 0.f;
#pragma unroll
        for (int p = 0; p < 8; ++p) { const float v = PART[p * 64 + d]; tot += v; off += (p < part) ? v : 0.f; }
        if (part == 0) { BL[d] = tot; dtot += tot; }
        const float etot = __expf(tot);
        { float kh[8];
#pragma unroll
          for (int i = 0; i < 8; ++i) { const float bi = off + bcs[i]; const int tok = part * 8 + i; const float kx = bf2f(P[(rowc + tok) * LDP + C_BK + hd * 64 + d]);
              const float eb = __expf(bi), ieb = __builtin_amdgcn_rcpf(eb);
              if (OUT) { const float qx = bf2f(P[(rowc + tok) * LDP + C_BQ + hd * 64 + d]); QT[tok * GL_LD + d] = f2bf(qx * 0.125f * eb); KT[tok * GL_LD + d] = f2bf(kx * ieb); }
              kh[i] = kx * (etot * ieb); }
          u32x4 w; w.x = pk2(kh[0], kh[1]); w.y = pk2(kh[2], kh[3]); w.z = pk2(kh[4], kh[5]); w.w = pk2(kh[6], kh[7]);
          *(LAS u32x4*)(lds + GL_KH + (d * GL_LD + part * 8) * 2) = w; }
        { const int v = tid & 127, tp = tid >> 7; float vv[16];
#pragma unroll
          for (int i = 0; i < 16; ++i) vv[i] = bf2f(P[(rowc + tp * 16 + i) * LDP + C_BV + hd * 128 + v]);
          u32x4 w0, w1; w0.x = pk2(vv[0], vv[1]); w0.y = pk2(vv[2], vv[3]); w0.z = pk2(vv[4], vv[5]); w0.w = pk2(vv[6], vv[7]);
          w1.x = pk2(vv[8], vv[9]); w1.y = pk2(vv[10], vv[11]); w1.z = pk2(vv[12], vv[13]); w1.w = pk2(vv[14], vv[15]);
          *(LAS u32x4*)(lds + GL_VT + (v * GL_LD + tp * 16) * 2) = w0; *(LAS u32x4*)(lds + GL_VT + (v * GL_LD + tp * 16 + 8) * 2) = w1; }
        if (OUT) {
#pragma unroll
            for (int nt = 0; nt < 4; ++nt)
#pragma unroll
                for (int r = 0; r < 4; ++r) ST[(16 * wid + 4 * q + r) * GL_LD + 16 * nt + c16] = f2bf(S[nt][r]); }
        __syncthreads();
        if (OUT) {
            { const int mt = wid >> 1;
#pragma unroll
              for (int t = 0; t < 2; ++t) { const int nt = 2 * (wid & 1) + t; f32x4 acc = (f32x4){0.f, 0.f, 0.f, 0.f};
                  if (nt <= mt) {
#pragma unroll
                      for (int kk = 0; kk < 2; ++kk) acc = MFMA16(ldsfrag(lds + GL_QT, 16 * mt + c16, 32 * kk + 8 * q), ldsfrag(lds + GL_KT, 16 * nt + c16, 32 * kk + 8 * q), acc); }
#pragma unroll
                  for (int r = 0; r < 4; ++r) { const int i = 16 * mt + 4 * q + r, j = 16 * nt + c16; AT[i * GL_LD + j] = f2bf((j <= i) ? acc[r] : 0.f); } } }
            __syncthreads();
            f32x4 o[4];
#pragma unroll
            for (int mt = 0; mt < 4; ++mt) { f32x4 acc = (f32x4){0.f, 0.f, 0.f, 0.f};
#pragma unroll
                for (int kk = 0; kk < 2; ++kk) if (kk == 0 || mt >= 2) acc = MFMA16(ldsfrag(lds + GL_AT, 16 * mt + c16, 32 * kk + 8 * q), ldsfrag(lds + GL_VT, 16 * wid + c16, 32 * kk + 8 * q), acc);
#pragma unroll
                for (int kk = 0; kk < 2; ++kk) acc = MFMA16(ldsfrag(lds + GL_QT, 16 * mt + c16, 32 * kk + 8 * q), ldsfrag(lds + GL_ST, 16 * wid + c16, 32 * kk + 8 * q), acc);
                o[mt] = acc; }
#pragma unroll
            for (int mt = 0; mt < 4; ++mt)
#pragma unroll
                for (int r = 0; r < 4; ++r) { float s = o[mt][r] * o[mt][r]; s += __shfl_xor(s, 1); s += __shfl_xor(s, 2); s += __shfl_xor(s, 4); s += __shfl_xor(s, 8);
                    if (c16 == 0) SS[wid * 64 + 16 * mt + 4 * q + r] = s; }
            __syncthreads();
            if (tid < 64) { float t = 0.f;
#pragma unroll
                for (int w = 0; w < 8; ++w) t += SS[w * 64 + tid];
                RS[tid] = rsqrtf(t * (1.0f / 128.0f) + EPS); }
            __syncthreads();
            const float gn = gnorm[hd * 128 + 16 * wid + c16];
#pragma unroll
            for (int mt = 0; mt < 4; ++mt)
#pragma unroll
                for (int r = 0; r < 4; ++r) { const int i = 16 * mt + 4 * q + r; bf16* rp = P + (rowc + i) * LDP + hd * 128 + 16 * wid + c16; const float bg = bf2f(rp[C_BG]);
                    rp[C_BV] = f2bf(o[mt][r] * RS[i] * gn * bg * sigmoidf_(bg)); }
        }
#pragma unroll
        for (int nt = 0; nt < 4; ++nt) { const float dec = __expf(BL[16 * nt + c16]); f32x4 acc = S[nt] * dec;
#pragma unroll
            for (int kk = 0; kk < 2; ++kk) acc = MFMA16(ldsfrag(lds + GL_VT, 16 * wid + c16, 32 * kk + 8 * q), ldsfrag(lds + GL_KH, 16 * nt + c16, 32 * kk + 8 * q), acc);
            S[nt] = acc; }
        __syncthreads();
    }
    if (!OUT) {
#pragma unroll
        for (int nt = 0; nt < 4; ++nt)
#pragma unroll
            for (int r = 0; r < 4; ++r) GE[(size_t)item * 8192 + (16 * wid + 4 * q + r) * 64 + 16 * nt + c16] = S[nt][r];
        if (part == 0) GD[(size_t)item * 64 + d] = __expf(dtot);
    }
}
#ifndef PH_MASK
#define PH_MASK 0xffff
#endif
__device__ __forceinline__ void cmul_acc(float& hr, float& hi, float ar, float ai, float gr, float gi) { const float nr = ar * hr - ai * hi + gr, ni = ar * hi + ai * hr + gi; hr = nr; hi = ni; }
constexpr int S5_WB = 0, S5_CZ = 67584, S5_HS = 102400, S5_LDW = 264, S5_LDC = 136;
template <bool OUT>
__device__ __forceinline__ void s5_wg_item(LAS unsigned char* lds, bf16* P, const bf16* TzT, const bf16* BzT, const bf16* CzT, const float* tab, float* SE, int item, int tid, int wid, int lane) {
    const int c16 = lane & 15, q = lane >> 4;
    const int b = item >> 6, g = (item >> 1) & 31, seg = 8 * (item & 1) + wid;
    const int id = ((b * 32 + g) << 4) + seg;
    const size_t tok0 = (size_t)b * SEQ + seg * 256;
    LAS unsigned char* wscr = lds + S5_HS + wid * 4352;
    bf16x8 uf[8];
#pragma unroll
    for (int kk = 0; kk < 8; ++kk) uf[kk] = *(const bf16x8*)(P + (tok0 + 16 * c16 + 2 * kk + (q >> 1)) * LDP + C_CU + 16 * g + 8 * (q & 1));
    { const bf16* bz = BzT + (size_t)g * 32768; u32x4 t[8];
#pragma unroll
      for (int i = 0; i < 8; ++i) t[i] = *(const u32x4*)(bz + (size_t)(tid + 512 * i) * 8);
#pragma unroll
      for (int i = 0; i < 8; ++i) { const int pc = tid + 512 * i; *(LAS u32x4*)(lds + S5_WB + (pc >> 5) * (S5_LDW * 2) + (pc & 31) * 16) = t[i]; } }
    __syncthreads();
    f32x4 G[8];
#pragma unroll
    for (int nt = 0; nt < 8; ++nt) { f32x4 acc = (f32x4){0.f, 0.f, 0.f, 0.f};
#pragma unroll
        for (int kk = 0; kk < 8; ++kk) acc = MFMA16(uf[kk], *(const LAS bf16x8*)(lds + S5_WB + ((16 * nt + c16) * S5_LDW + 32 * kk + 8 * q) * 2), acc);
        G[nt] = acc; }
    const float* tg = tab + (size_t)g * 6 * 64;
    float a16r[4], a16i[4], a64r[4], a64i[4];
#pragma unroll
    for (int n4 = 0; n4 < 4; ++n4) { const int p = 16 * n4 + c16; a16r[n4] = tg[0 * 64 + p]; a16i[n4] = tg[1 * 64 + p]; a64r[n4] = tg[2 * 64 + p]; a64i[n4] = tg[3 * 64 + p]; }
    float er[4], ei[4], ir[4], ii[4], cr[4], ci[4];
#pragma unroll
    for (int n4 = 0; n4 < 4; ++n4) { float hr = 0.f, hi = 0.f;
#pragma unroll
        for (int r = 0; r < 4; ++r) cmul_acc(hr, hi, a16r[n4], a16i[n4], G[n4][r], G[n4 + 4][r]);
        er[n4] = hr; ei[n4] = hi; ir[n4] = hr; ii[n4] = hi; }
#pragma unroll
    for (int s = 1; s < 4; ++s)
#pragma unroll
        for (int n4 = 0; n4 < 4; ++n4) { const float vr = __shfl(ir[n4], (lane - 16) & 63), vi = __shfl(ii[n4], (lane - 16) & 63);
            if (q == s) { ir[n4] = a64r[n4] * vr - a64i[n4] * vi + er[n4]; ii[n4] = a64r[n4] * vi + a64i[n4] * vr + ei[n4]; } }
#pragma unroll
    for (int n4 = 0; n4 < 4; ++n4) { const float vr = __shfl(ir[n4], (lane - 16) & 63), vi = __shfl(ii[n4], (lane - 16) & 63); cr[n4] = (q > 0) ? vr : 0.f; ci[n4] = (q > 0) ? vi : 0.f; }
    if (!OUT) {
        if (q == 3) {
#pragma unroll
            for (int n4 = 0; n4 < 4; ++n4) { SE[(size_t)id * 128 + 16 * n4 + c16] = ir[n4]; SE[(size_t)id * 128 + 64 + 16 * n4 + c16] = ii[n4]; } }
        __syncthreads();
        return;
    }
    float hinr[4] = {0.f, 0.f, 0.f, 0.f}, hini[4] = {0.f, 0.f, 0.f, 0.f};
    { float a256r[4], a256i[4];
#pragma unroll
      for (int n4 = 0; n4 < 4; ++n4) { const int p = 16 * n4 + c16; a256r[n4] = tg[4 * 64 + p]; a256i[n4] = tg[5 * 64 + p]; }
#pragma unroll 1
      for (int s0 = 0; s0 < seg; s0 += 4) { float evr[4][4], evi[4][4];
#pragma unroll
          for (int u = 0; u < 4; ++u) { const int sp = (s0 + u < seg) ? s0 + u : seg - 1; const float* e = SE + (size_t)(id - seg + sp) * 128;
#pragma unroll
              for (int n4 = 0; n4 < 4; ++n4) { evr[u][n4] = e[16 * n4 + c16]; evi[u][n4] = e[64 + 16 * n4 + c16]; } }
#pragma unroll
          for (int u = 0; u < 4; ++u) if (s0 + u < seg) {
#pragma unroll
              for (int n4 = 0; n4 < 4; ++n4) cmul_acc(hinr[n4], hini[n4], a256r[n4], a256i[n4], evr[u][n4], evi[u][n4]); } } }
    LAS bf16* Hs = (LAS bf16*)wscr;
#pragma unroll
    for (int n4 = 0; n4 < 4; ++n4) {
        float pr = 1.f, pi = 0.f;
#pragma unroll
        for (int i = 0; i < 3; ++i) if (i < q) { const float nr = pr * a64r[n4] - pi * a64i[n4], ni = pr * a64i[n4] + pi * a64r[n4]; pr = nr; pi = ni; }
        float hr = pr * hinr[n4] - pi * hini[n4] + cr[n4], hi = pr * hini[n4] + pi * hinr[n4] + ci[n4];
#pragma unroll
        for (int r = 0; r < 4; ++r) { Hs[(4 * q + r) * 136 + 16 * n4 + c16] = f2bf(hr); Hs[(4 * q + r) * 136 + 64 + 16 * n4 + c16] = f2bf(hi);
            cmul_acc(hr, hi, a16r[n4], a16i[n4], G[n4][r], G[n4 + 4][r]); } }
    asm volatile("" ::: "memory");
    bf16x8 hf[4];
#pragma unroll
    for (int kk = 0; kk < 4; ++kk) hf[kk] = *(const LAS bf16x8*)(wscr + (c16 * 136 + 32 * kk + 8 * q) * 2);
    const bf16* tz = TzT + (size_t)g * 65536; const bf16* cz = CzT + (size_t)g * 32768;
    unsigned ypk[16][2];
#pragma unroll
    for (int hl = 0; hl < 2; ++hl) {
        __syncthreads();
        { u32x4 t[8], tc[4];
          if (hl == 0) {
#pragma unroll
              for (int i = 0; i < 4; ++i) { const int pc = tid + 512 * i; t[i] = *(const u32x4*)(tz + (size_t)(pc >> 4) * 256 + (pc & 15) * 8); }
          } else {
#pragma unroll
              for (int i = 0; i < 8; ++i) { const int pc = tid + 512 * i; t[i] = *(const u32x4*)(tz + (size_t)(128 + (pc >> 5)) * 256 + (pc & 31) * 8); } }
#pragma unroll
          for (int i = 0; i < 4; ++i) { const int pc = tid + 512 * i; tc[i] = *(const u32x4*)(cz + (size_t)(128 * hl + (pc >> 4)) * 128 + (pc & 15) * 8); }
          if (hl == 0) {
#pragma unroll
              for (int i = 0; i < 4; ++i) { const int pc = tid + 512 * i; *(LAS u32x4*)(lds + S5_WB + (pc >> 4) * (S5_LDW * 2) + (pc & 15) * 16) = t[i]; }
          } else {
#pragma unroll
              for (int i = 0; i < 8; ++i) { const int pc = tid + 512 * i; *(LAS u32x4*)(lds + S5_WB + (pc >> 5) * (S5_LDW * 2) + (pc & 31) * 16) = t[i]; } }
#pragma unroll
          for (int i = 0; i < 4; ++i) { const int pc = tid + 512 * i; *(LAS u32x4*)(lds + S5_CZ + (pc >> 4) * (S5_LDC * 2) + (pc & 15) * 16) = tc[i]; } }
        __syncthreads();
#pragma unroll
        for (int n8 = 0; n8 < 8; ++n8) { const int nt = 8 * hl + n8; f32x4 acc = (f32x4){0.f, 0.f, 0.f, 0.f};
#pragma unroll
            for (int kk = 0; kk < 8; ++kk) if (kk <= (nt >> 1)) acc = MFMA16(uf[kk], *(const LAS bf16x8*)(lds + S5_WB + ((16 * n8 + c16) * S5_LDW + 32 * kk + 8 * q) * 2), acc);
#pragma unroll
            for (int kk = 0; kk < 4; ++kk) acc = MFMA16(hf[kk], *(const LAS bf16x8*)(lds + S5_CZ + ((16 * n8 + c16) * S5_LDC + 32 * kk + 8 * q) * 2), acc);
            float yv[4];
#pragma unroll
            for (int r = 0; r < 4; ++r) { const float y = acc[r], u2 = 1.5957691216057308f * (y + 0.044715f * y * y * y); yv[r] = y * sigmoidf_(u2); }
            ypk[nt][0] = pk2(yv[0], yv[1]); ypk[nt][1] = pk2(yv[2], yv[3]); }
    }
    __syncthreads();
    LAS bf16* Ys = (LAS bf16*)(lds + S5_WB + wid * 8192);
#pragma unroll
    for (int nt = 0; nt < 16; ++nt)
#pragma unroll
        for (int r = 0; r < 4; ++r) Ys[(16 * (4 * q + r) + nt) * 16 + c16] = (bf16)((r & 1) ? (ypk[nt][r >> 1] >> 16) : (ypk[nt][r >> 1] & 0xffffu));
    asm volatile("" ::: "memory");
#pragma unroll
    for (int i = 0; i < 8; ++i) { const int pc = lane + 64 * i, tk = pc >> 1, hf2 = pc & 1;
        *(u32x4*)(P + (tok0 + tk) * LDP + C_CU + 16 * g + 8 * hf2) = *(const LAS u32x4*)(lds + S5_WB + wid * 8192 + pc * 16); }
    __syncthreads();
}

template <bool SECOND>
#ifndef PROBE_TYPE
#define PROBE_TYPE -1
#endif
#define PBX(t) do { if ((t) == PROBE_TYPE) px_t0 = __builtin_amdgcn_s_memrealtime(); } while (0)
#define PEX(t) do { if ((t) == PROBE_TYPE) pacc += __builtin_amdgcn_s_memrealtime() - px_t0; } while (0)
__device__ __forceinline__ void mixers_phase(LAS unsigned char* lds, const float* const* in, unsigned char* ws, bf16* P, int l, int vcu, int G, int tid, int wid, int lane, unsigned long long& pacc) {
    unsigned long long px_t0 = 0; (void)px_t0;
    PBX(10); if (!SECOND && (PH_MASK & 0x100)) for (int it = vcu; it < 256; it += G) attn_item(lds, P, in[7] + l * 16, it, tid, wid, lane, pacc);
    PEX(10);
    float* GE = (float*)(ws + WS_GLAE); float* GD = (float*)(ws + WS_GLAD); float* SE = (float*)(ws + WS_S5E);
    const float* balpha = in[9] + l * 256; const float* gnorm = in[10] + l * 512;
    int tid1 = tid; asm volatile("" : "+v"(tid1));
    PBX(SECOND ? 13 : 11); if (PH_MASK & 0x200) for (int it = vcu; it < 256; it += G) gla_item<SECOND>(lds, P, (const bf16*)(ws + WS_BLR), (const bf16*)(ws + WS_WA) + (size_t)l * 256 * 16, balpha, gnorm, GE, GD, it, tid1, wid, tid1 & 63);
    PEX(SECOND ? 13 : 11);
    const bf16* TzT = (const bf16*)(ws + WS_S5M + (size_t)l * S5M_BYTES + S5M_TZ); const bf16* BzT = (const bf16*)(ws + WS_S5M + (size_t)l * S5M_BYTES + S5M_BZ);
    const bf16* CzT = (const bf16*)(ws + WS_S5M + (size_t)l * S5M_BYTES + S5M_CZ); const float* tab = (const float*)(ws + WS_TAB) + (size_t)l * 32 * 6 * 64;
    int tid2 = tid; asm volatile("" : "+v"(tid2));
    PBX(SECOND ? 14 : 12); if (PH_MASK & 0x400) for (int it = vcu; it < 256; it += G) s5_wg_item<SECOND>(lds, P, TzT, BzT, CzT, tab, SE, it, tid2, wid, tid2 & 63);
    PEX(SECOND ? 14 : 12);
}
#ifndef MK_MULTI
#define MK_MULTI 0
#endif
constexpr int N_PHASES = 2 + 6 * NLAYER;
struct Args { const float* in[22]; float* out; unsigned char* ws; int ph_lo, ph_hi; };
__global__ void __launch_bounds__(NWAVES * 64, 2) hybrid_fwd(Args args_) {
    extern __shared__ __attribute__((aligned(16))) unsigned char lds_raw[];
    const int G = gridDim.x; const int bx = blockIdx.x; const int vcu = (G % 8 == 0) ? (bx % 8) * (G / 8) + bx / 8 : bx;
    XcdBarrier bar;
    { LAS unsigned char* lds0 = (LAS unsigned char*)lds_raw;
      volatile LAS unsigned* MISC = (volatile LAS unsigned*)(lds0 + MISC_OFF);
      for (int u = threadIdx.x; u < (LDS_BYTES - LDSCTL_OFF) / 4; u += NWAVES * 64) ((LAS unsigned*)(lds0 + LDSCTL_OFF))[u] = 0u;
      __syncthreads();
      bar.bar = (unsigned*)(args_.ws + WS_CTL) + CW_BAR; bar.x = 0; bar.st = nullptr;
      if (!MK_MULTI) bar = xcd_barrier_post((unsigned*)(args_.ws + WS_CTL) + CW_BAR, MISC + 8); }
    const int lo = args_.ph_lo, hi = args_.ph_hi;
#ifndef PROBE_TYPE
#define PROBE_TYPE -1
#endif
#ifndef PROBE_K
#define PROBE_K 4
#endif
#ifndef PROBE_BLOCK
#define PROBE_BLOCK 0
#endif
    unsigned long long pr_acc = 0, pr_t0 = 0; (void)pr_t0;
#define PB(t) do { if ((t) == PROBE_TYPE) pr_t0 = __builtin_amdgcn_s_memrealtime(); } while (0)
#define PE(t) do { if ((t) == PROBE_TYPE) pr_acc += __builtin_amdgcn_s_memrealtime() - pr_t0; } while (0)
#define IN(k) (lo <= (k) && (k) < hi)
#if MK_MULTI
#define SEAM(k) do { } while (0)
#else
#define SEAM(k) do { if (IN(k) && IN((k) + 1)) xcd_barrier(bar); } while (0)
#endif
#define PHASE_IDS typedef const Args __attribute__((address_space(4)))* kargp_t; kargp_t ap = (kargp_t)__builtin_amdgcn_kernarg_segment_ptr(); asm volatile("" : "+s"(ap)); const Args& args = *(const Args*)ap; \
        int tid = threadIdx.x; asm volatile("" : "+v"(tid)); const int lane = tid & 63, wid = __builtin_amdgcn_readfirstlane(tid >> 6); (void)lane; (void)wid; \
        LAS unsigned char* lds = (LAS unsigned char*)lds_raw; asm volatile("" : "+s"(lds)); unsigned char* ws = args.ws; \
        bf16* const P = (bf16*)(ws + WS_P); bf16* const H = (bf16*)(ws + WS_H); float* const MOD = (float*)(ws + WS_MOD); (void)P; (void)H; (void)MOD;
#ifndef PH_MASK
#define PH_MASK 0xffff
#endif
    PB(0); if (IN(0) && (PH_MASK & 1)) { PHASE_IDS p0_mod_phase(lds, args.in, ws, vcu, G, tid, wid, lane); }
    SEAM(0); PE(0);
    PB(1); if (IN(1) && (PH_MASK & 2)) { PHASE_IDS
        if (G == 256) { if (vcu < 64) { PB(20); p0_s5_item(lds, args.in, ws, vcu >> 5, vcu & 31, tid); PE(20); }
                        else { const int gw = (vcu - 64) * NWAVES + wid; PB(21); p1_transposes(lds, args.in, ws, gw, 192 * NWAVES, wid, lane, 0, NLAYER * TR_IL); __syncthreads(); PE(21); PB(25); prenorm_phase(args.in[0], MOD, H, gw, 192 * NWAVES, lane); __syncthreads(); PE(25); } }
        else { for (int it = vcu; it < 64; it += G) p0_s5_item(lds, args.in, ws, it >> 5, it & 31, tid);
               const int gw = vcu * NWAVES + wid; p1_transposes(lds, args.in, ws, gw, G * NWAVES, wid, lane, 0, NLAYER * TR_IL); prenorm_phase(args.in[0], MOD, H, gw, G * NWAVES, lane); } }
    SEAM(1); PE(1);
#define LAYER(l, base) \
    PB(2); if (IN(base + 0) && (PH_MASK & 4)) { PHASE_IDS \
        pg8::Gemm g{H, (const bf16*)(ws + WS_WIN + (size_t)l * WIN_BYTES), TOK, NP, DM, DM}; pg8::StaticOrder S; S.init(TOK, NP, G, bx); \
        pg8::EpiBf16<0> E{P, LDP, nullptr, 1024, 1024, 0.125f * LOG2E};        \
        PB(40); for (int wg_ = bx; wg_ < TOK / 64; wg_ += G) blr_head(lds, H, (const bf16*)(ws + WS_WLR) + (size_t)l * 16 * 1024, (bf16*)(ws + WS_BLR), wg_, tid, wid, lane); PE(40); \
        pg8::gemm_phase<pg8::EpiBf16<0>, pg8::StaticOrder, true, true>(lds, g, S, E, tid); } \
    SEAM(base + 0); PE(2); \
    PB(3); if (IN(base + 1) && (PH_MASK & 8)) { PHASE_IDS mixers_phase<false>(lds, args.in, ws, P, l, vcu, G, tid, wid, lane, pr_acc); } \
    SEAM(base + 1); PE(3); \
    PB(4); if (IN(base + 2) && (PH_MASK & 8)) { PHASE_IDS mixers_phase<true>(lds, args.in, ws, P, l, vcu, G, tid, wid, lane, pr_acc); } \
    SEAM(base + 2); PE(4); \
    PB(5); if (IN(base + 3) && (PH_MASK & 16)) { PHASE_IDS \
        pg8::Gemm g{P + C_CU, (const bf16*)(ws + WS_WGLU + (size_t)l * WGLU_BYTES), TOK, 512, 512, LDP}; pg8::StaticOrder S; S.init(TOK, 512, G, bx); \
        pg8::EpiGlu E{P, LDP, C_CU, C_CG, args.in[20] + l * 512}; \
        PB(15); if (PH_MASK & 0x800) pg8::gemm_phase<pg8::EpiGlu, pg8::StaticOrder, true, true>(lds, g, S, E, tid); PE(15); PB(16); \
        if (!(PH_MASK & 0x1000)) {} else if (G == 256) { if (bx >= 128) { attn_item(lds, P, args.in[7] + l * 16, 256 + 2 * (bx - 128), tid, wid, lane, pr_acc); attn_item(lds, P, args.in[7] + l * 16, 257 + 2 * (bx - 128), tid, wid, lane, pr_acc); } } \
        else for (int it = 256 + vcu; it < 512; it += G) attn_item(lds, P, args.in[7] + l * 16, it, tid, wid, lane, pr_acc); PE(16); } \
    SEAM(base + 3); PE(5); \
    PB(6); if (IN(base + 4) && (PH_MASK & 32)) { PHASE_IDS \
        pg8::Gemm g{P, (const bf16*)(ws + WS_WOUT + (size_t)l * WOUT_BYTES), TOK, DM, 2048, LDP}; pg8::StaticOrder S; S.init(TOK, DM, G, bx); \
        pg8::EpiBf16<0> E{H, DM, nullptr, 0, 0, 1.f}; \
        pg8::gemm_phase<pg8::EpiBf16<0>, pg8::StaticOrder, true, true>(lds, g, S, E, tid); } \
    SEAM(base + 4); PE(6); \
    PB(7); if (IN(base + 5) && (PH_MASK & 64)) { PHASE_IDS \
        post_phase(l == 0 ? args.in[0] : args.out, args.out, H, args.in[5] + l * DM, MOD + (size_t)l * 4 * 3072, (l + 1 < NLAYER), args.in[4] + (l + 1 < NLAYER ? l + 1 : l) * DM, MOD + (size_t)(l + 1 < NLAYER ? l + 1 : l) * 4 * 3072, H, vcu, wid, lane); } \
    SEAM(base + 5); PE(7);
    LAYER(0, 2)
    LAYER(1, 8)
#undef LAYER
    if (PROBE_TYPE >= 0 && blockIdx.x == PROBE_BLOCK) { const unsigned long long te = __builtin_amdgcn_s_memrealtime(); while (__builtin_amdgcn_s_memrealtime() - te < (unsigned long long)PROBE_K * pr_acc) __builtin_amdgcn_s_sleep(20); }
#undef IN
#undef SEAM
}

extern "C" void kernel_launch(void* const* d_in, const int* in_sizes, int n_in, void* d_out, int out_size, void* d_ws, size_t ws_size, hipStream_t stream) {
    static int grid = 0;
    if (grid == 0) {
        if (n_in != 22 || in_sizes[0] != TOK * DM || out_size != TOK * DM || ws_size < WS_END) { fprintf(stderr, "kernel_launch: unexpected shapes (n_in %d, in0 %d, out %d, ws %zu)\n", n_in, n_in > 0 ? in_sizes[0] : -1, out_size, ws_size); grid = -1; return; }
        int dev = 0, cus = 0;
        if (hipGetDevice(&dev) != hipSuccess || hipDeviceGetAttribute(&cus, hipDeviceAttributeMultiprocessorCount, dev) != hipSuccess) { grid = -1; return; }
        if (hipFuncSetAttribute((const void*)hybrid_fwd, hipFuncAttributeMaxDynamicSharedMemorySize, LDS_BYTES) != hipSuccess) { fprintf(stderr, "kernel_launch: hipFuncSetAttribute failed\n"); grid = -1; return; }
        (void)hipGetLastError();
        grid = cus;
    }
    if (grid < 0) return;
    if (hipMemsetAsync((char*)d_ws + WS_CTL, 0, CTL_ZERO_BYTES, stream) != hipSuccess) { fprintf(stderr, "kernel_launch: memset failed\n"); return; }
    Args a{};
    for (int i = 0; i < 22; ++i) a.in[i] = (const float*)d_in[i];
    a.out = (float*)d_out; a.ws = (unsigned char*)d_ws;
#if MK_MULTI
    for (int ph = 0; ph < N_PHASES; ++ph) { a.ph_lo = ph; a.ph_hi = ph + 1; hipLaunchKernelGGL(hybrid_fwd, dim3(grid), dim3(NWAVES * 64), LDS_BYTES, stream, a); }
#else
    a.ph_lo = 0; a.ph_hi = N_PHASES;
    hipLaunchKernelGGL(hybrid_fwd, dim3(grid), dim3(NWAVES * 64), LDS_BYTES, stream, a);
#endif
    const hipError_t le = hipPeekAtLastError();
    if (le != hipSuccess) fprintf(stderr, "kernel_launch: launch failed: %s\n", hipGetErrorName(le));
}
```
